# Optimizing an MI355X kernel written in HIP

```python
import math
import jax, jax.numpy as jnp
from jax import lax
import numpy as np

D_MODEL = 2048
BATCH = 8
SEQ = 2048
DEPTH = 1

D_HYENA = D_MODEL // 2
HYENA_GROUPS = 8
HYENA_ORDER = 2
HYENA_SHORT = 3
FILTER_EMB = 33
FILTER_ORDER = 64
FAST_DECAY = 0.3
SLOW_DECAY = 1.5
DECAY_TARGET = 1e-2
MOD_SHIFT = 0.0
N_DIR = 2
D_SGU = D_MODEL // 2
SGU_HEADS = 8
SGU_HEAD_DIM = D_SGU // SGU_HEADS
CHUNK = 128
N_BRANCH = 2
D_FF = -(-8 * D_MODEL // (3 * 256)) * 256
D_IN = 3 * D_HYENA + 2 * D_SGU + N_BRANCH * D_MODEL
EPS = 1e-6

kernel_name = "hyena_sgu_gated_hybrid_encoder"

F32 = jnp.float32


def _rmsnorm(x, g):
    x32 = x.astype(F32)
    y = x32 * lax.rsqrt(jnp.mean(x32 * x32, axis=-1, keepdims=True) + EPS)
    return (y * g.astype(F32)).astype(x.dtype)


def _layernorm(x, g, b):
    x32 = x.astype(F32)
    mu = jnp.mean(x32, axis=-1, keepdims=True)
    var = jnp.mean(jnp.square(x32 - mu), axis=-1, keepdims=True)
    y = (x32 - mu) * lax.rsqrt(var + EPS)
    return (y * g.astype(F32) + b.astype(F32)).astype(x.dtype)


def _hyena_filters(L, w1, b1, w2, b2, w3, b3, freq, w4):
    t = jnp.linspace(0.0, 1.0, L, dtype=F32)[:, None]
    bands = (FILTER_EMB - 1) // 2
    w = 2.0 * math.pi * jnp.arange(L, dtype=F32)[:, None] / L
    f = jnp.linspace(1e-4, bands - 1, bands, dtype=F32)[None, :]
    z = jnp.concatenate([t, jnp.cos(f * w), -jnp.sin(f * w)], axis=-1)
    fr = freq.astype(F32)
    h = jnp.sin(fr * (z @ w1.astype(F32) + b1.astype(F32)))
    h = jnp.sin(fr * (h @ w2.astype(F32) + b2.astype(F32)))
    h = jnp.sin(fr * (h @ w3.astype(F32) + b3.astype(F32)))
    h = (h @ w4.astype(F32)).reshape(L, N_DIR, HYENA_ORDER, D_HYENA)
    max_decay = math.log(DECAY_TARGET) / FAST_DECAY
    min_decay = math.log(DECAY_TARGET) / SLOW_DECAY
    deltas = jnp.linspace(min_decay, max_decay, D_HYENA, dtype=F32)
    decay = jnp.exp(-t * jnp.abs(deltas))
    h = h * (decay + MOD_SHIFT)[:, None, None, :]
    h_fwd, h_bwd = h[:, 0], h[:, 1]
    k = jnp.concatenate([h_fwd, jnp.zeros((1, HYENA_ORDER, D_HYENA), F32), h_bwd[:0:-1]], axis=0)
    k = k / jnp.sum(jnp.abs(k), axis=0, keepdims=True)
    return jnp.fft.rfft(k, axis=0)


def _long_conv(z, k_f, bias):
    L = z.shape[1]
    zf = jnp.fft.rfft(z, n=2 * L, axis=1)
    y = jnp.fft.irfft(zf * k_f[None], n=2 * L, axis=1)[:, :L]
    return y + z * bias.astype(F32)


def _hyena_mixer(p, conv_w, conv_b, k_f, bias):
    pp = jnp.pad(p, ((0, 0), (1, 1), (0, 0)))
    p = pp[:, :-2] * conv_w[0] + pp[:, 1:-1] * conv_w[1] + pp[:, 2:] * conv_w[2] + conv_b
    v, x1, x2 = jnp.split(p, 3, axis=-1)
    z = v.astype(F32)
    z = x1.astype(F32) * _long_conv(z, k_f[:, 0], bias[0])
    z = x2.astype(F32) * _long_conv(z, k_f[:, 1], bias[1])
    return z.astype(p.dtype)


def _sgu_mixer(p, ln_g, ln_b, w_s, b_s):
    B, L, _ = p.shape
    u, v = jnp.split(jax.nn.gelu(p, approximate=False), 2, axis=-1)
    v = _layernorm(v, ln_g, ln_b)
    v = v.reshape(B, L // CHUNK, CHUNK, SGU_HEADS, SGU_HEAD_DIM)
    s = jnp.einsum('hpq,bnqhc->bnphc', w_s, v) + b_s.T[None, None, :, :, None]
    return u * s.reshape(B, L, D_SGU)


def setup_inputs(seed: int = 0) -> dict:
    key = jax.random.key(seed)
    ks = jax.random.split(key, 32)

    def nrm(k, shape, scale):
        return jax.random.normal(k, shape, F32) * scale

    return {
        "x": nrm(ks[0], (BATCH, SEQ, D_MODEL), 1.0),
        "norm_mix_g": 1.0 + nrm(ks[1], (DEPTH, D_MODEL), 0.01),
        "w_in": nrm(ks[2], (DEPTH, D_MODEL, D_IN), D_MODEL ** -0.5),
        "short_conv_w": nrm(ks[3], (DEPTH, HYENA_SHORT, 3 * D_HYENA), HYENA_SHORT ** -0.5),
        "short_conv_b": nrm(ks[4], (DEPTH, 3 * D_HYENA), 0.02),
        "filt_w1": nrm(ks[5], (DEPTH, FILTER_EMB, FILTER_ORDER), FILTER_EMB ** -0.5),
        "filt_b1": nrm(ks[6], (DEPTH, FILTER_ORDER), 0.1),
        "filt_w2": nrm(ks[7], (DEPTH, FILTER_ORDER, FILTER_ORDER), FILTER_ORDER ** -0.5),
        "filt_b2": nrm(ks[8], (DEPTH, FILTER_ORDER), 0.1),
        "filt_w3": nrm(ks[9], (DEPTH, FILTER_ORDER, FILTER_ORDER), FILTER_ORDER ** -0.5),
        "filt_b3": nrm(ks[10], (DEPTH, FILTER_ORDER), 0.1),
        "filt_freq": 1.0 + nrm(ks[11], (DEPTH, FILTER_ORDER), 0.01),
        "filt_w4": nrm(ks[12], (DEPTH, FILTER_ORDER, N_DIR * HYENA_ORDER * D_HYENA), FILTER_ORDER ** -0.5),
        "hyena_bias": nrm(ks[13], (DEPTH, HYENA_ORDER, D_HYENA), 0.5),
        "sgu_ln_g": 1.0 + nrm(ks[14], (DEPTH, D_SGU), 0.01),
        "sgu_ln_b": nrm(ks[15], (DEPTH, D_SGU), 0.02),
        "sgu_w_s": nrm(ks[16], (DEPTH, SGU_HEADS, CHUNK, CHUNK), CHUNK ** -0.5),
        "sgu_b_s": 1.0 + nrm(ks[17], (DEPTH, SGU_HEADS, CHUNK), 0.01),
        "w_branch_hyena": nrm(ks[18], (DEPTH, D_HYENA, D_MODEL), D_HYENA ** -0.5),
        "w_branch_sgu": nrm(ks[19], (DEPTH, D_SGU, D_MODEL), D_SGU ** -0.5),
        "w_out": nrm(ks[20], (DEPTH, D_MODEL, D_MODEL), D_MODEL ** -0.5),
        "norm_ffn_g": 1.0 + nrm(ks[21], (DEPTH, D_MODEL), 0.01),
        "w_ffn_in": nrm(ks[22], (DEPTH, D_MODEL, 2 * D_FF), D_MODEL ** -0.5),
        "w_ffn_out": nrm(ks[23], (DEPTH, D_FF, D_MODEL), D_FF ** -0.5),
        "norm_final_g": 1.0 + nrm(ks[24], (D_MODEL,), 0.01),
    }


def reference(x, norm_mix_g, w_in, short_conv_w, short_conv_b, filt_w1, filt_b1, filt_w2, filt_b2,
              filt_w3, filt_b3, filt_freq, filt_w4, hyena_bias, sgu_ln_g, sgu_ln_b, sgu_w_s, sgu_b_s,
              w_branch_hyena, w_branch_sgu, w_out, norm_ffn_g, w_ffn_in, w_ffn_out, norm_final_g):
    L = x.shape[1]
    split_pts = [3 * D_HYENA, 3 * D_HYENA + 2 * D_SGU, 3 * D_HYENA + 2 * D_SGU + D_MODEL]
    for l in range(DEPTH):
        h = _rmsnorm(x, norm_mix_g[l])
        proj = jnp.einsum('bsd,de->bse', h, w_in[l])
        p_hy, p_sgu, g_hy, g_sgu = jnp.split(proj, split_pts, axis=-1)
        k_f = _hyena_filters(L, filt_w1[l], filt_b1[l], filt_w2[l], filt_b2[l],
                             filt_w3[l], filt_b3[l], filt_freq[l], filt_w4[l])
        y_hy = _hyena_mixer(p_hy, short_conv_w[l], short_conv_b[l], k_f, hyena_bias[l])
        y_sgu = _sgu_mixer(p_sgu, sgu_ln_g[l], sgu_ln_b[l], sgu_w_s[l], sgu_b_s[l])
        merged = (jax.nn.sigmoid(g_hy) * jnp.einsum('bsc,cd->bsd', y_hy, w_branch_hyena[l])
                  + jax.nn.sigmoid(g_sgu) * jnp.einsum('bsc,cd->bsd', y_sgu, w_branch_sgu[l]))
        x = x + jnp.einsum('bsd,de->bse', merged, w_out[l])
        h = _rmsnorm(x, norm_ffn_g[l])
        gate, up = jnp.split(jnp.einsum('bsd,df->bsf', h, w_ffn_in[l]), 2, axis=-1)
        x = x + jnp.einsum('bsf,fd->bsd', jax.nn.silu(gate) * up, w_ffn_out[l])
    return _rmsnorm(x, norm_final_g)
```

```cpp
#include <hip/hip_runtime.h>
#include <hip/hip_cooperative_groups.h>
#include <cstdio>
namespace cg = cooperative_groups;

#define LAS __attribute__((address_space(3)))
typedef unsigned short bf16_t;
typedef short bf16x8 __attribute__((ext_vector_type(8)));
typedef float f32x4 __attribute__((ext_vector_type(4)));
typedef float f32x2 __attribute__((ext_vector_type(2)));
typedef unsigned u32x4 __attribute__((ext_vector_type(4)));
typedef unsigned u32x2 __attribute__((ext_vector_type(2)));

constexpr int NTOK = 16384, DM = 2048, DH = 1024, DFF = 5632, SEQ = 2048;
constexpr float EPSV = 1e-6f;
constexpr int NTHR = 512;
#ifndef PHASE_MASK
#define PHASE_MASK 0x3ff
#endif
constexpr int LDS_BYTES = 146432;

constexpr size_t WS_STATS = 0;
constexpr size_t WS_SS1 = 131072;
constexpr size_t WS_SS2 = 196608;
constexpr size_t WS_H3 = 262144;
constexpr size_t WS_BAR = 917504;
constexpr size_t WS_W = 1048576;
constexpr size_t W_IN = WS_W;
constexpr size_t W_BH = W_IN + 37748736;
constexpr size_t W_BS = W_BH + 4194304;
constexpr size_t W_OUT = W_BS + 4194304;
constexpr size_t W_FI = W_OUT + 8388608;
constexpr size_t W_FO = W_FI + 46137344;
constexpr size_t WS_R2 = W_FO + 23068672;
constexpr size_t WS_R3 = WS_R2 + 67108864;
constexpr size_t R3_PT = WS_R3;
constexpr size_t R3_PROJ2 = WS_R3 + 100663296;
constexpr size_t R3_MERGED = WS_R3;
constexpr size_t R3_H2 = WS_R3 + 184549376;
constexpr size_t R3_HID = WS_R3;
constexpr size_t WS_END = WS_R3 + 301989888;

struct Params { const float* in[25]; float* out; unsigned char* ws; int lo, hi; };

__device__ __forceinline__ float bf2f(bf16_t b) { return __uint_as_float(((unsigned)b) << 16); }
__device__ __forceinline__ bf16_t f2bf(float f) { unsigned u = __float_as_uint(f); u += 0x7FFFu + ((u >> 16) & 1u); return (bf16_t)(u >> 16); }
typedef __bf16 bf16x2_t __attribute__((ext_vector_type(2)));
__device__ __forceinline__ unsigned cvt_pk_bf16(float lo, float hi) { f32x2 v = {lo, hi}; bf16x2_t b = __builtin_convertvector(v, bf16x2_t); return __builtin_bit_cast(unsigned, b); }
__device__ __forceinline__ u32x4 pack8(f32x4 a, f32x4 b) { u32x4 w; w.x = cvt_pk_bf16(a[0], a[1]); w.y = cvt_pk_bf16(a[2], a[3]); w.z = cvt_pk_bf16(b[0], b[1]); w.w = cvt_pk_bf16(b[2], b[3]); return w; }
__device__ __forceinline__ void unpack8(u32x4 w, f32x4& a, f32x4& b) {
    a[0] = __uint_as_float(w.x << 16); a[1] = __uint_as_float(w.x & 0xffff0000u); a[2] = __uint_as_float(w.y << 16); a[3] = __uint_as_float(w.y & 0xffff0000u);
    b[0] = __uint_as_float(w.z << 16); b[1] = __uint_as_float(w.z & 0xffff0000u); b[2] = __uint_as_float(w.w << 16); b[3] = __uint_as_float(w.w & 0xffff0000u); }
__device__ __forceinline__ float sigmoidf_(float x) { return __builtin_amdgcn_rcpf(1.0f + __expf(-x)); }
__device__ __forceinline__ f32x2 gelu_pk(f32x2 v) {
    const f32x2 av = __builtin_elementwise_abs(v), d = av * 0.2316418882f + 1.0f;
    f32x2 t; t.x = __builtin_amdgcn_rcpf(d.x); t.y = __builtin_amdgcn_rcpf(d.y);
    f32x2 q = t * 0.5307027145f + (-0.7265760135f); q = q * t + 0.7107068705f; q = q * t + (-0.142248368f); q = q * t + 0.127414796f; q = q * t;
    const f32x2 s = (v * v) * (-0.72134752044f);
    f32x2 e; e.x = __builtin_amdgcn_exp2f(s.x); e.y = __builtin_amdgcn_exp2f(s.y);
    const f32x2 m = v * (q * e), r = v - m;
    f32x2 o; o.x = v.x < 0.f ? m.x : r.x; o.y = v.y < 0.f ? m.y : r.y; return o;
}
__device__ __forceinline__ f32x4 gelu4(f32x4 v) { f32x2 a = gelu_pk((f32x2){v[0], v[1]}), b = gelu_pk((f32x2){v[2], v[3]}); return (f32x4){a.x, a.y, b.x, b.y}; }

namespace pg8 {
constexpr int BM = 256, BK = 64, HALF = 128, HTB = HALF * BK * 2, STAGE_BYTES = 8 * HTB, NXCD = 8, WGM = 8;
__host__ __device__ __forceinline__ int lds_byte(int r, int c) { const int st = (r >> 4) * 2 + (c >> 5), rr = r & 15, cc = c & 31, ob = rr * 64 + cc * 2; return st * 1024 + (ob ^ (((ob >> 9) & 1) << 5)); }
__host__ __device__ __forceinline__ void stage_rc(int b, int& R, int& C) { const int st = b / 1024, sb = b % 1024, swz = sb ^ (((sb >> 9) & 1) << 5); R = (st >> 1) * 16 + swz / 64; C = (st & 1) * 32 + (swz % 64) / 2; }
__host__ __device__ __forceinline__ int perm32(int rho) { const int n = rho >> 4, i = rho & 15; return 8 * (i >> 2) + 4 * n + (i & 3); }
struct Unit { int pm, pn; };
struct Gemm { const bf16_t* A; const bf16_t* Bt; int M, N, K; };
struct StaticOrder {
    int nM, nN, nwg, G, c, rowmode;
    __device__ void init(int M, int N, int G_, int c_) { nM = M / BM; nN = N / BM; nwg = nM * nN; G = G_; c = c_; rowmode = 0; }
    __device__ bool next(int i, Unit& u) const {
        const long L = (long)i * G + c; if (L >= nwg) return false;
        if (rowmode) { u.pm = i * 32 + (c & 7) * 4 + (c >> 6); u.pn = (c >> 3) & 7; return true; }
        int wgid = (int)L; { const int q = nwg / NXCD, r = nwg % NXCD, xcd = wgid % NXCD, off = wgid / NXCD; wgid = (xcd < r ? xcd * (q + 1) : r * (q + 1) + (xcd - r) * q) + off; }
        const int nig = WGM * nN, gid = wgid / nig, fm = gid * WGM, gsz = (nM - fm) < WGM ? (nM - fm) : WGM;
        u.pm = fm + ((wgid % nig) % gsz); u.pn = (wgid % nig) / gsz; return true;
    }
};

template <class Epi>
__device__ __forceinline__ void gemm_phase(LAS unsigned char* lds, const Gemm g, const StaticOrder& S, const Epi& E) {
    const int tid = threadIdx.x, wid = __builtin_amdgcn_readfirstlane(tid >> 6), lane = tid & 63, wr = wid >> 2, wc = wid & 3, fr = lane & 15, fq = lane >> 4;
    const int K = g.K, nt = K / BK;
    unsigned voffA[2], voffB[2];
#pragma unroll
    for (int i = 0; i < 2; ++i) { int R, C; stage_rc(tid * 16 + i * 8192, R, C); const int Rb = Epi::PERM ? ((R & ~31) + perm32(R & 31)) : R;
        voffA[i] = (unsigned)(R * K + C) * 2u; voffB[i] = (unsigned)(Rb * K + C) * 2u; }
    const unsigned kstep = (unsigned)(BK * 2);
    const unsigned hstep = (unsigned)HALF * (unsigned)K * 2u;
    const unsigned tstep = 2u * hstep;
    const __amdgpu_buffer_rsrc_t rs_voffA = __builtin_amdgcn_make_buffer_rsrc((void*)g.A, 0, 0x7fffffff, 0x00020000);
    const __amdgpu_buffer_rsrc_t rs_voffB = __builtin_amdgcn_make_buffer_rsrc((void*)g.Bt, 0, 0x7fffffff, 0x00020000);
    const unsigned ldsw = (unsigned)wid * 1024u;
    const int aoff = lds_byte(wr * 64 + fr, fq * 8), boff = lds_byte(wc * 32 + fr, fq * 8);
#define PG8_SA(b, h) (((b) * 2 + (h)) * HTB)
#define PG8_SB(b, h) ((4 + (b) * 2 + (h)) * HTB)
#define PG8_STAGE(bufoff, gbase, voff) do { _Pragma("unroll") for (int _i = 0; _i < 2; ++_i) \
        __builtin_amdgcn_raw_ptr_buffer_load_lds(rs_##voff, (LAS void*)(lds + (bufoff) + ldsw + _i * 8192), 16, (int)(voff)[_i], (int)(gbase), 0, 0); } while (0)
#define PG8_LDA(dst, b, h) do { _Pragma("unroll") for (int m = 0; m < 4; ++m) _Pragma("unroll") for (int k = 0; k < 2; ++k) dst[m][k] = *(const LAS bf16x8*)(lds + PG8_SA(b, h) + aoff + m * 2048 + k * 1024); } while (0)
#define PG8_LDB(dst, b, h) do { _Pragma("unroll") for (int n = 0; n < 2; ++n) _Pragma("unroll") for (int k = 0; k < 2; ++k) dst[n][k] = *(const LAS bf16x8*)(lds + PG8_SB(b, h) + boff + n * 2048 + k * 1024); } while (0)
#define PG8_MMA(ai, bj, At, Bt) do { __builtin_amdgcn_s_setprio(1); _Pragma("unroll") for (int m = 0; m < 4; ++m) _Pragma("unroll") for (int n = 0; n < 2; ++n) _Pragma("unroll") for (int k = 0; k < 2; ++k) \
        acc[ai][bj][m][n] = __builtin_amdgcn_mfma_f32_16x16x32_bf16(Bt[n][k], At[m][k], acc[ai][bj][m][n], 0, 0, 0); __builtin_amdgcn_s_setprio(0); } while (0)
#define PG8_WAIT_V(n) asm volatile("s_waitcnt vmcnt(" #n ")" ::: "memory")
#define PG8_WAIT_L(n) asm volatile("s_waitcnt lgkmcnt(" #n ")" ::: "memory")
#define PG8_BAR __builtin_amdgcn_s_barrier()
#define PG8_SCHED __builtin_amdgcn_sched_barrier(0)
    Unit cur, nxt; int ui = 0;
    if (!S.next(0, cur)) return;
    f32x4 acc[2][2][4][2];
#pragma unroll
    for (int a = 0; a < 2; ++a)
#pragma unroll
        for (int b = 0; b < 2; ++b)
#pragma unroll
            for (int m = 0; m < 4; ++m)
#pragma unroll
                for (int n = 0; n < 2; ++n) acc[a][b][m][n] = (f32x4){0.f, 0.f, 0.f, 0.f};
    bf16x8 At[4][2], B0[2][2], B1[2][2];
    unsigned cA = (unsigned)cur.pm * tstep, cB = (unsigned)cur.pn * tstep;
    PG8_STAGE(PG8_SB(0, 0), cB, voffB); PG8_STAGE(PG8_SB(0, 1), cB + hstep, voffB); PG8_STAGE(PG8_SA(0, 0), cA, voffA); PG8_STAGE(PG8_SA(0, 1), cA + hstep, voffA);
    if (wr == 1) PG8_BAR;
    PG8_WAIT_V(2); PG8_BAR;
    PG8_STAGE(PG8_SB(1, 0), cB + kstep, voffB); PG8_STAGE(PG8_SA(1, 0), cA + kstep, voffA); PG8_STAGE(PG8_SB(1, 1), cB + hstep + kstep, voffB);
    PG8_WAIT_V(6); PG8_BAR;
    for (;;) {
        const bool has_next = S.next(ui + 1, nxt);
        const unsigned nA = has_next ? (unsigned)nxt.pm * tstep : cA, nB = has_next ? (unsigned)nxt.pn * tstep : cB;
        for (int t = 0; t < nt; t += 2) {
            const bool last = (t == nt - 2);
            const unsigned a1 = cA + (unsigned)(t + 1) * kstep;
            const unsigned a2 = last ? nA : cA + (unsigned)(t + 2) * kstep, b2 = last ? nB : cB + (unsigned)(t + 2) * kstep;
            const unsigned a3 = a2 + kstep, b3 = b2 + kstep;
            PG8_LDB(B0, 0, 0); PG8_LDB(B1, 0, 1); PG8_SCHED; PG8_LDA(At, 0, 0); PG8_STAGE(PG8_SA(1, 1), a1 + hstep, voffA);
            PG8_WAIT_V(8); PG8_WAIT_L(0); PG8_BAR; PG8_MMA(0, 0, At, B0); PG8_MMA(0, 1, At, B1); PG8_BAR; PG8_SCHED;
            PG8_LDA(At, 0, 1); PG8_STAGE(PG8_SB(0, 0), b2, voffB); PG8_STAGE(PG8_SB(0, 1), b2 + hstep, voffB); PG8_STAGE(PG8_SA(0, 0), a2, voffA);
            PG8_WAIT_V(8); PG8_WAIT_L(0); PG8_BAR; PG8_MMA(1, 0, At, B0); PG8_MMA(1, 1, At, B1); PG8_BAR; PG8_SCHED;
            PG8_LDB(B0, 1, 0); PG8_LDB(B1, 1, 1); PG8_SCHED; PG8_LDA(At, 1, 0); PG8_STAGE(PG8_SA(0, 1), a2 + hstep, voffA);
            PG8_WAIT_V(8); PG8_WAIT_L(0); PG8_BAR; PG8_MMA(0, 0, At, B0); PG8_MMA(0, 1, At, B1); PG8_BAR; PG8_SCHED;
            PG8_LDA(At, 1, 1); PG8_STAGE(PG8_SB(1, 0), b3, voffB); PG8_STAGE(PG8_SB(1, 1), b3 + hstep, voffB); PG8_STAGE(PG8_SA(1, 0), a3, voffA);
            PG8_WAIT_V(8); PG8_WAIT_L(0); PG8_BAR; PG8_MMA(1, 0, At, B0); PG8_MMA(1, 1, At, B1); PG8_BAR; PG8_SCHED;
        }
        if (wr == 0) PG8_BAR;
        E(acc, cur, wr, wc, fr, fq);
        if (!has_next) break;
#pragma unroll
        for (int a = 0; a < 2; ++a)
#pragma unroll
            for (int b = 0; b < 2; ++b)
#pragma unroll
                for (int m = 0; m < 4; ++m)
#pragma unroll
                    for (int n = 0; n < 2; ++n) acc[a][b][m][n] = (f32x4){0.f, 0.f, 0.f, 0.f};
        cur = nxt; cA = nA; cB = nB; ++ui;
        if (wr == 1) PG8_BAR;
    }
    PG8_WAIT_V(0);
    PG8_BAR;
#undef PG8_SA
#undef PG8_SB
#undef PG8_STAGE
#undef PG8_LDA
#undef PG8_LDB
#undef PG8_MMA
#undef PG8_WAIT_V
#undef PG8_WAIT_L
#undef PG8_BAR
#undef PG8_SCHED
}
}

typedef f32x4 AccT[2][2][4][2];
#define EROW(ai, m) (u.pm * 256 + (ai) * 128 + wr * 64 + (m) * 16 + fr)
#define ECOL0 (u.pn * 256 + wc * 32 + 8 * fq)

struct Epi1a { static constexpr bool PERM = true; bf16_t* O; int ldc;
    __device__ __forceinline__ void operator()(const AccT& acc, const pg8::Unit& u, int wr, int wc, int fr, int fq) const {
        const int col0 = ECOL0;
#pragma unroll
        for (int ai = 0; ai < 2; ++ai)
#pragma unroll
            for (int m = 0; m < 4; ++m) { bf16_t* rowp = O + (size_t)EROW(ai, m) * ldc + col0;
#pragma unroll
                for (int bj = 0; bj < 2; ++bj) *(u32x4*)(rowp + bj * 128) = pack8(acc[ai][bj][m][0], acc[ai][bj][m][1]); }
    } };
struct Epi1b { static constexpr bool PERM = true; bf16_t* O;
    __device__ __forceinline__ void operator()(const AccT& acc, const pg8::Unit& u, int wr, int wc, int fr, int fq) const {
        const int col0 = ECOL0; const int pn = u.pn;
        if (pn < 8) {
#pragma unroll
            for (int ai = 0; ai < 2; ++ai)
#pragma unroll
                for (int m = 0; m < 4; ++m) { bf16_t* rowp = O + (size_t)EROW(ai, m) * 6144 + col0;
#pragma unroll
                    for (int bj = 0; bj < 2; ++bj) *(u32x4*)(rowp + bj * 128) = pack8(gelu4(acc[ai][bj][m][0]), gelu4(acc[ai][bj][m][1])); }
        } else {
#pragma unroll
            for (int ai = 0; ai < 2; ++ai)
#pragma unroll
                for (int m = 0; m < 4; ++m) { bf16_t* rowp = O + (size_t)EROW(ai, m) * 6144 + col0;
#pragma unroll
                    for (int bj = 0; bj < 2; ++bj) { f32x4 v0 = acc[ai][bj][m][0], v1 = acc[ai][bj][m][1];
#pragma unroll
                        for (int j = 0; j < 4; ++j) { v0[j] = sigmoidf_(v0[j]); v1[j] = sigmoidf_(v1[j]); }
                        *(u32x4*)(rowp + bj * 128) = pack8(v0, v1); } }
        }
    } };
template <bool ADD> struct Epi4 { static constexpr bool PERM = true; bf16_t* O; const bf16_t* gate;
    __device__ __forceinline__ void operator()(const AccT& acc, const pg8::Unit& u, int wr, int wc, int fr, int fq) const {
        const int col0 = ECOL0;
#pragma unroll
        for (int ai = 0; ai < 2; ++ai) {
            u32x4 gt[4][2], pv[4][2];
#pragma unroll
            for (int m = 0; m < 4; ++m) { const int row = EROW(ai, m);
#pragma unroll
                for (int bj = 0; bj < 2; ++bj) { gt[m][bj] = *(const u32x4*)(gate + (size_t)row * 6144 + col0 + bj * 128); if (ADD) pv[m][bj] = *(const u32x4*)(O + (size_t)row * 2048 + col0 + bj * 128); } }
#pragma unroll
            for (int m = 0; m < 4; ++m) { bf16_t* rowp = O + (size_t)EROW(ai, m) * 2048 + col0;
#pragma unroll
                for (int bj = 0; bj < 2; ++bj) { f32x4 g0, g1; unpack8(gt[m][bj], g0, g1);
                    f32x4 v0 = acc[ai][bj][m][0] * g0, v1 = acc[ai][bj][m][1] * g1;
                    if (ADD) { f32x4 p0, p1; unpack8(pv[m][bj], p0, p1); v0 += p0; v1 += p1; }
                    *(u32x4*)(rowp + bj * 128) = pack8(v0, v1); } }
            asm volatile("" ::: "memory"); }
    } };
struct EpiRes { static constexpr bool PERM = true; const float* base; float* X;
    __device__ __forceinline__ void operator()(const AccT& acc, const pg8::Unit& u, int wr, int wc, int fr, int fq) const {
        const int col0 = ECOL0;
#pragma unroll
        for (int ai = 0; ai < 2; ++ai) {
            f32x4 bs[4][2][2];
#pragma unroll
            for (int m = 0; m < 4; ++m) { const size_t off = (size_t)EROW(ai, m) * 2048 + col0;
#pragma unroll
                for (int bj = 0; bj < 2; ++bj) { bs[m][bj][0] = *(const f32x4*)(base + off + bj * 128); bs[m][bj][1] = *(const f32x4*)(base + off + bj * 128 + 4); } }
#pragma unroll
            for (int m = 0; m < 4; ++m) { const size_t off = (size_t)EROW(ai, m) * 2048 + col0;
#pragma unroll
                for (int bj = 0; bj < 2; ++bj) { *(f32x4*)(X + off + bj * 128) = acc[ai][bj][m][0] + bs[m][bj][0]; *(f32x4*)(X + off + bj * 128 + 4) = acc[ai][bj][m][1] + bs[m][bj][1]; } }
            asm volatile("" ::: "memory"); }
    } };
struct Epi7 { static constexpr bool PERM = true; const float* base; float* X; float* ss2; unsigned* cnt; const float* g;
    __device__ __forceinline__ void operator()(AccT& acc, const pg8::Unit& u, int wr, int wc, int fr, int fq) const {
        const int col0 = ECOL0;
#pragma unroll
        for (int ai = 0; ai < 2; ++ai)
#pragma unroll
            for (int mh = 0; mh < 2; ++mh) {
                f32x4 bs[2][2][2];
#pragma unroll
                for (int mm = 0; mm < 2; ++mm) { const size_t off = (size_t)EROW(ai, mh * 2 + mm) * 2048 + col0;
#pragma unroll
                    for (int bj = 0; bj < 2; ++bj) { bs[mm][bj][0] = *(const f32x4*)(base + off + bj * 128); bs[mm][bj][1] = *(const f32x4*)(base + off + bj * 128 + 4); } }
#pragma unroll
                for (int mm = 0; mm < 2; ++mm) { const int m = mh * 2 + mm; const int row = EROW(ai, m); float q = 0.f;
#pragma unroll
                    for (int bj = 0; bj < 2; ++bj) { const f32x4 v0 = acc[ai][bj][m][0] + bs[mm][bj][0], v1 = acc[ai][bj][m][1] + bs[mm][bj][1]; acc[ai][bj][m][0] = v0; acc[ai][bj][m][1] = v1;
                        q += (v0[0] * v0[0] + v0[1] * v0[1]) + (v0[2] * v0[2] + v0[3] * v0[3]) + (v1[0] * v1[0] + v1[1] * v1[1]) + (v1[2] * v1[2] + v1[3] * v1[3]); }
                    q += __shfl_xor(q, 16); q += __shfl_xor(q, 32);
                    if (fq == 0) __hip_atomic_store(ss2 + (size_t)row * 32 + u.pn * 4 + wc, q, __ATOMIC_RELAXED, __HIP_MEMORY_SCOPE_AGENT); }
                asm volatile("" ::: "memory"); }
        asm volatile("s_waitcnt vmcnt(0)" ::: "memory");
        unsigned* cw = cnt + 16 * (u.pm * 2 + wr);
        if ((threadIdx.x & 63) == 0) __hip_atomic_fetch_add(cw, 1u, __ATOMIC_RELAXED, __HIP_MEMORY_SCOPE_AGENT);
        { unsigned spins = 0; while (__hip_atomic_load(cw, __ATOMIC_RELAXED, __HIP_MEMORY_SCOPE_AGENT) < 32u) { __builtin_amdgcn_s_sleep(1); if (++spins > (1u << 22)) break; } }
        f32x4 gv[2][2];
#pragma unroll
        for (int bj = 0; bj < 2; ++bj) { gv[bj][0] = *(const f32x4*)(g + col0 + bj * 128); gv[bj][1] = *(const f32x4*)(g + col0 + bj * 128 + 4); }
#pragma unroll
        for (int ai = 0; ai < 2; ++ai)
#pragma unroll
            for (int m = 0; m < 4; ++m) { const int row = EROW(ai, m); const float* sp = ss2 + (size_t)row * 32 + fq * 8; float pq[8];
#pragma unroll
                for (int k = 0; k < 8; ++k) pq[k] = __hip_atomic_load(sp + k, __ATOMIC_RELAXED, __HIP_MEMORY_SCOPE_AGENT);
                float q = ((pq[0] + pq[1]) + (pq[2] + pq[3])) + ((pq[4] + pq[5]) + (pq[6] + pq[7]));
                q += __shfl_xor(q, 16); q += __shfl_xor(q, 32);
                const float rs = rsqrtf(q * (1.0f / 2048.0f) + EPSV); const size_t off = (size_t)row * 2048 + col0;
#pragma unroll
                for (int bj = 0; bj < 2; ++bj) { *(f32x4*)(X + off + bj * 128) = acc[ai][bj][m][0] * rs * gv[bj][0]; *(f32x4*)(X + off + bj * 128 + 4) = acc[ai][bj][m][1] * rs * gv[bj][1]; } }
    } };
struct Epi5 { static constexpr bool PERM = true; const float* base; float* X; float* ssp; const float* g; bf16_t* Hn;
    __device__ __forceinline__ void operator()(const AccT& acc, const pg8::Unit& u, int wr, int wc, int fr, int fq) const {
        const int col0 = ECOL0;
        f32x4 gv[2][2];
#pragma unroll
        for (int bj = 0; bj < 2; ++bj) { gv[bj][0] = *(const f32x4*)(g + col0 + bj * 128); gv[bj][1] = *(const f32x4*)(g + col0 + bj * 128 + 4); }
#pragma unroll
        for (int ai = 0; ai < 2; ++ai) {
            f32x4 bs[4][2][2];
#pragma unroll
            for (int m = 0; m < 4; ++m) { const size_t off = (size_t)EROW(ai, m) * 2048 + col0;
#pragma unroll
                for (int bj = 0; bj < 2; ++bj) { bs[m][bj][0] = *(const f32x4*)(base + off + bj * 128); bs[m][bj][1] = *(const f32x4*)(base + off + bj * 128 + 4); } }
#pragma unroll
            for (int m = 0; m < 4; ++m) { const int row = EROW(ai, m); const size_t off = (size_t)row * 2048 + col0; float q = 0.f;
#pragma unroll
                for (int bj = 0; bj < 2; ++bj) { const f32x4 v0 = acc[ai][bj][m][0] + bs[m][bj][0], v1 = acc[ai][bj][m][1] + bs[m][bj][1];
                    *(f32x4*)(X + off + bj * 128) = v0; *(f32x4*)(X + off + bj * 128 + 4) = v1;
                    q += (v0[0] * v0[0] + v0[1] * v0[1]) + (v0[2] * v0[2] + v0[3] * v0[3]) + (v1[0] * v1[0] + v1[1] * v1[1]) + (v1[2] * v1[2] + v1[3] * v1[3]);
                    *(u32x4*)(Hn + off + bj * 128) = pack8(v0 * gv[bj][0], v1 * gv[bj][1]); }
                q += __shfl_xor(q, 16); q += __shfl_xor(q, 32);
                if (fq == 0) ssp[(size_t)row * 32 + u.pn * 4 + wc] = q; }
            asm volatile("" ::: "memory"); }
    } };
struct Epi6 { static constexpr bool PERM = true; bf16_t* O; const float* ssp; const LAS float* rsl; int pm0;
    __device__ __forceinline__ void operator()(const AccT& acc, const pg8::Unit& u, int wr, int wc, int fr, int fq) const {
        const int col0 = u.pn * 128 + wc * 32 + 8 * fq;
        const bool tab = (u.pm == pm0);
#pragma unroll
        for (int ai = 0; ai < 2; ++ai)
#pragma unroll
            for (int m = 0; m < 4; ++m) { const int row = EROW(ai, m); float rs;
                if (tab) rs = rsl[ai * 128 + wr * 64 + m * 16 + fr];
                else { const f32x4 p0 = *(const f32x4*)(ssp + (size_t)row * 32 + fq * 8), p1 = *(const f32x4*)(ssp + (size_t)row * 32 + fq * 8 + 4);
                    float q = ((p0[0] + p0[1]) + (p0[2] + p0[3])) + ((p1[0] + p1[1]) + (p1[2] + p1[3]));
                    q += __shfl_xor(q, 16); q += __shfl_xor(q, 32);
                    rs = rsqrtf(q * (1.0f / 2048.0f) + EPSV); }
                f32x4 h0, h1;
#pragma unroll
                for (int j = 0; j < 4; ++j) { const float g0 = acc[ai][0][m][0][j] * rs, u0 = acc[ai][1][m][0][j] * rs, g1 = acc[ai][0][m][1][j] * rs, u1 = acc[ai][1][m][1][j] * rs;
                    h0[j] = g0 * sigmoidf_(g0) * u0; h1[j] = g1 * sigmoidf_(g1) * u1; }
                *(u32x4*)(O + (size_t)row * DFF + col0) = pack8(h0, h1); }
    } };

__device__ __forceinline__ float block_sum(float v, float* red, int tid) {
    for (int o = 32; o >= 1; o >>= 1) v += __shfl_xor(v, o);
    __syncthreads();
    if ((tid & 63) == 0) red[tid >> 6] = v;
    __syncthreads();
    float s = 0.f;
#pragma unroll
    for (int i = 0; i < 8; ++i) s += red[i];
    return s;
}

__device__ __forceinline__ void tr_tile(const float* __restrict__ src, int N, int K, bf16_t* __restrict__ dst, int k0, int n0, int drow0, float* tile, int tid) {
#pragma unroll
    for (int i = 0; i < 2; ++i) { const int kk = (tid >> 4) + i * 32, n4 = (tid & 15) * 4;
        const f32x4 v = *(const f32x4*)(src + (size_t)(k0 + kk) * N + n0 + n4);
        tile[kk * 65 + n4 + 0] = v[0]; tile[kk * 65 + n4 + 1] = v[1]; tile[kk * 65 + n4 + 2] = v[2]; tile[kk * 65 + n4 + 3] = v[3]; }
    __syncthreads();
    const int n = tid >> 3, kg = tid & 7; f32x4 a, b;
#pragma unroll
    for (int j = 0; j < 4; ++j) { a[j] = tile[(kg * 8 + j) * 65 + n]; b[j] = tile[(kg * 8 + 4 + j) * 65 + n]; }
    *(u32x4*)(dst + (size_t)(drow0 + n) * K + k0 + kg * 8) = pack8(a, b);
    __syncthreads();
}

__device__ __forceinline__ float sconv(const bf16_t* __restrict__ row, int b, int s, float w0, float w1, float w2, float bias) {
    const bf16_t* p = row + b * 2048 + s;
    const float c = bf2f(p[0]); const float l = s > 0 ? bf2f(p[-1]) : 0.f; const float r = s < 2047 ? bf2f(p[1]) : 0.f;
    return w0 * l + w1 * c + w2 * r + bias;
}

#define XB_TMO      128
#define XB_XCNT(j)  (256  + 64 * (j))
#define XB_XSUB(j)  (1280 + 64 * (j))
#define XB_XGEN(j)  (2304 + 64 * (j))
#define XB_TOP      3328
#define XB_TOPGEN   3392
#define XCD_BAR_WORDS 3456
#define XB_SPIN_CAP (1u << 22)

__device__ __forceinline__ unsigned xb_ld(unsigned* p)              { return __hip_atomic_load(p, __ATOMIC_RELAXED, __HIP_MEMORY_SCOPE_AGENT); }
__device__ __forceinline__ unsigned xb_add(unsigned* p, unsigned v) { return __hip_atomic_fetch_add(p, v, __ATOMIC_RELAXED, __HIP_MEMORY_SCOPE_AGENT); }
__device__ __forceinline__ unsigned xb_xcc_id() { return (unsigned)__builtin_amdgcn_s_getreg((3 << 11) | 20) & 0xFu; }
#define XB_SPIN(cond, bar) do { unsigned _sp = 0; while (cond) { __builtin_amdgcn_s_sleep(1); \
    if ((++_sp & 255u) == 0u) { if (xb_ld(&(bar)[XB_TMO])) break; if (_sp > XB_SPIN_CAP) { atomicAdd(&(bar)[XB_TMO], 1u); break; } } } } while (0)

struct XcdBarrier {
    unsigned* bar; unsigned x;
    volatile LAS unsigned* st;
};

__device__ __forceinline__ XcdBarrier xcd_barrier_post(unsigned* bar, volatile LAS unsigned* st) {
    XcdBarrier b; b.bar = bar; b.x = xb_xcc_id(); b.st = st;
    if (threadIdx.x == 0) (void)xb_add(&bar[XB_XCNT(b.x)], 1u);
    return b;
}
__device__ __forceinline__ void xcd_barrier_complete(unsigned* bar, unsigned x, unsigned& nloc, unsigned& nx) {
    const unsigned G = gridDim.x * gridDim.y * gridDim.z;
    unsigned sum, cnt, mine, sp = 0u;
    for (;;) {
        sum = 0u; cnt = 0u; mine = 0u;
#pragma unroll
        for (unsigned j = 0; j < 16; ++j) { const unsigned c = xb_ld(&bar[XB_XCNT(j)]); sum += c; cnt += (c > 0u) ? 1u : 0u; mine = (j == x) ? c : mine; }
        if (sum == G) break;
        __builtin_amdgcn_s_sleep(1);
        if ((++sp & 255u) == 0u) { if (xb_ld(&bar[XB_TMO])) break; if (sp > XB_SPIN_CAP) { atomicAdd(&bar[XB_TMO], 1u); break; } }
    }
    nloc = mine > 0u ? mine : 1u; nx = cnt > 0u ? cnt : 1u;
}

__device__ __forceinline__ void xcd_barrier(const XcdBarrier& b) {
    asm volatile("s_waitcnt vmcnt(0)" ::: "memory");
    __syncthreads();
    if (threadIdx.x == 0) {
        unsigned* bar = b.bar;
        __builtin_amdgcn_s_waitcnt(0);
        unsigned nloc = b.st[0], nx = b.st[1];
        if (nloc == 0u) { xcd_barrier_complete(bar, b.x, nloc, nx); b.st[0] = nloc; b.st[1] = nx; }
        const unsigned old = xb_add(&bar[XB_XSUB(b.x)], 1u);
        const unsigned gen = old / nloc;
        if (old + 1u == (gen + 1u) * nloc) {
            __builtin_amdgcn_fence(__ATOMIC_RELEASE, "agent");
            asm volatile("s_waitcnt vmcnt(0)" ::: "memory");
            const unsigned og = xb_add(&bar[XB_TOP], 1u);
            const unsigned tg = og / nx;
            if (og + 1u == (tg + 1u) * nx) xb_add(&bar[XB_TOPGEN], 1u);
            else XB_SPIN(xb_ld(&bar[XB_TOPGEN]) == tg, bar);
            __builtin_amdgcn_fence(__ATOMIC_ACQUIRE, "agent");
            xb_add(&bar[XB_XGEN(b.x)], 1u);
            asm volatile("s_waitcnt vmcnt(0)" ::: "memory");
        } else {
            XB_SPIN(xb_ld(&bar[XB_XGEN(b.x)]) == gen, bar);
            __builtin_amdgcn_fence(__ATOMIC_ACQUIRE, "agent");
            asm volatile("s_waitcnt vmcnt(0)" ::: "memory");
        }
    }
    __syncthreads();
}


__device__ __forceinline__ void my_barrier(unsigned* bar, unsigned target) {
    asm volatile("s_waitcnt vmcnt(0)" ::: "memory");
    __syncthreads();
    if (threadIdx.x == 0) {
        __builtin_amdgcn_fence(__ATOMIC_RELEASE, "agent");
        asm volatile("s_waitcnt vmcnt(0)" ::: "memory");
        __hip_atomic_fetch_add(bar, 1u, __ATOMIC_RELAXED, __HIP_MEMORY_SCOPE_AGENT);
        while (__hip_atomic_load(bar, __ATOMIC_RELAXED, __HIP_MEMORY_SCOPE_AGENT) < target) __builtin_amdgcn_s_sleep(2);
        __builtin_amdgcn_fence(__ATOMIC_ACQUIRE, "agent");
        asm volatile("s_waitcnt vmcnt(0)" ::: "memory");
    }
    __syncthreads();
}

template <bool TOBF> __device__ __forceinline__ void rmsnorm_rows(const float* x, const float* __restrict__ g, bf16_t* ob, float* of, int bid, int G, int wave, int lane) {
    for (int row = bid * 8 + wave; row < NTOK; row += G * 8) {
        const float* xr = x + (size_t)row * DM; f32x4 v[8]; float q = 0.f;
#pragma unroll
        for (int i = 0; i < 8; ++i) { v[i] = *(const f32x4*)(xr + lane * 4 + i * 256); q += (v[i][0] * v[i][0] + v[i][1] * v[i][1]) + (v[i][2] * v[i][2] + v[i][3] * v[i][3]); }
        for (int o = 32; o >= 1; o >>= 1) q += __shfl_xor(q, o);
        const float rs = rsqrtf(q * (1.0f / 2048.0f) + EPSV);
#pragma unroll
        for (int i = 0; i < 8; ++i) { const f32x4 gg = *(const f32x4*)(g + lane * 4 + i * 256); const f32x4 y = v[i] * rs * gg;
            if (TOBF) { u32x2 w; w.x = cvt_pk_bf16(y[0], y[1]); w.y = cvt_pk_bf16(y[2], y[3]); *(u32x2*)(ob + (size_t)row * DM + lane * 4 + i * 256) = w; }
            else *(f32x4*)(of + (size_t)row * DM + lane * 4 + i * 256) = y; }
    }
}


#ifdef SELFCHK
__device__ __forceinline__ unsigned hsh(unsigned x) { x ^= x >> 16; x *= 0x7feb352du; x ^= x >> 15; x *= 0x846ca68bu; x ^= x >> 16; return x; }
__device__ __forceinline__ float wdot(const bf16_t* a, const bf16_t* b, int K, int lane) { float s = 0.f; for (int k = lane; k < K; k += 64) s += bf2f(a[k]) * bf2f(b[k]); for (int o = 32; o >= 1; o >>= 1) s += __shfl_xor(s, o); return s; }
__device__ __forceinline__ void chk_flag(unsigned* flags, bool bad, unsigned bit) { if (__any(bad) && (threadIdx.x & 63) == 0) atomicOr(flags, bit); }
__device__ __forceinline__ bool far(float got, float ref) { return !(fabsf(got - ref) <= 0.02f * fabsf(ref) + 0.02f); }
#define CHK(...) do { __VA_ARGS__ } while (0)
#else
#define CHK(...) do { } while (0)
#endif

__global__ void __launch_bounds__(NTHR, 2) fwd_megakernel(Params P) {
    extern __shared__ __attribute__((aligned(16))) unsigned char smem[];
    cg::grid_group grid = cg::this_grid();
    const int tid = threadIdx.x, lane = tid & 63, wave = tid >> 6;
    const int G = gridDim.x, bid = blockIdx.x;
    unsigned char* ws = P.ws;
    LAS unsigned char* lds = (LAS unsigned char*)smem;
    const int lo = P.lo, hi = P.hi;
#define IN(k) (lo <= (k) && (k) < hi)
#define SEAM(k) do { if ((k) + 1 < hi) { if (lo > (k) + 1000) grid.sync();   xcd_barrier(xb); } } while (0)

    { volatile LAS unsigned* stw = (volatile LAS unsigned*)(lds + 146400); if (tid < 2) stw[tid] = 0u; __syncthreads(); }
    const XcdBarrier xb = xcd_barrier_post((unsigned*)(ws + WS_BAR + 16384), (volatile LAS unsigned*)(lds + 146400));
    float* stats = (float*)(ws + WS_STATS); float* ss1 = (float*)(ws + WS_SS1); float* ss2 = (float*)(ws + WS_SS2); float* h3 = (float*)(ws + WS_H3);
    bf16_t* WinT = (bf16_t*)(ws + W_IN); bf16_t* WbhT = (bf16_t*)(ws + W_BH); bf16_t* WbsT = (bf16_t*)(ws + W_BS); bf16_t* WoutT = (bf16_t*)(ws + W_OUT);
    bf16_t* WfiT = (bf16_t*)(ws + W_FI); bf16_t* WfoT = (bf16_t*)(ws + W_FO);
    bf16_t* Hn = (bf16_t*)(ws + WS_R2); bf16_t* Yhy = (bf16_t*)(ws + WS_R2); bf16_t* Ysgu = (bf16_t*)(ws + WS_R2 + 33554432);
    bf16_t* PT = (bf16_t*)(ws + R3_PT); bf16_t* PROJ2 = (bf16_t*)(ws + R3_PROJ2); bf16_t* MERGED = (bf16_t*)(ws + R3_MERGED); bf16_t* H2 = (bf16_t*)(ws + R3_H2); bf16_t* HID = (bf16_t*)(ws + R3_HID);
    float* SSP = (float*)(ws + WS_R2);
    float* KF = P.out; bf16_t* YT = (bf16_t*)((unsigned char*)P.out + 33554432);

    auto weight_tiles = [&](int t_lo, int t_hi) {
            float* tile = (float*)smem;
            struct TJ { const float* src; bf16_t* dst; int K, N, k0, n0, mode; };
            auto decode = [&](int ti, TJ& j) {
                int li, ntl; j.mode = 0;
                if (ti < 1152) { j.src = P.in[2]; j.dst = WinT; j.K = 2048; j.N = 9216; li = ti; ntl = 36; }
                else if (ti < 1280) { j.src = P.in[18]; j.dst = WbhT; j.K = 1024; j.N = 2048; li = ti - 1152; ntl = 8; }
                else if (ti < 1408) { j.src = P.in[19]; j.dst = WbsT; j.K = 1024; j.N = 2048; li = ti - 1280; ntl = 8; }
                else if (ti < 1664) { j.src = P.in[20]; j.dst = WoutT; j.K = 2048; j.N = 2048; li = ti - 1408; ntl = 8; }
                else if (ti < 3072) { j.src = P.in[22]; j.dst = WfiT; j.K = 2048; j.N = 11264; li = ti - 1664; ntl = 44; j.mode = 1; }
                else { j.src = P.in[23]; j.dst = WfoT; j.K = 5632; j.N = 2048; li = ti - 3072; ntl = 8; }
                j.k0 = (li / ntl) * 64; j.n0 = (li % ntl) * 256; };
            f32x4 v[8]; TJ cur, nxt; int ti = t_lo + bid; bool have = ti < t_hi;
            if (have) { decode(ti, cur);
#pragma unroll
                for (int i = 0; i < 8; ++i) { const int idx = tid + i * NTHR, kk = idx >> 6, n4 = (idx & 63) * 4; v[i] = *(const f32x4*)(cur.src + (size_t)(cur.k0 + kk) * cur.N + cur.n0 + n4); } }
            while (have) {
#pragma unroll
                for (int i = 0; i < 8; ++i) { const int idx = tid + i * NTHR, kk = idx >> 6, n4 = (idx & 63) * 4; *(f32x4*)(tile + kk * 260 + (n4 ^ (((kk >> 3) & 7) << 2))) = v[i]; }
                __syncthreads();
                const int nti = ti + G; const bool hn = nti < t_hi;
                if (hn) { decode(nti, nxt);
#pragma unroll
                    for (int i = 0; i < 8; ++i) { const int idx = tid + i * NTHR, kk = idx >> 6, n4 = (idx & 63) * 4; v[i] = *(const f32x4*)(nxt.src + (size_t)(nxt.k0 + kk) * nxt.N + nxt.n0 + n4); } }
#pragma unroll
                for (int i = 0; i < 4; ++i) { const int item = tid + i * NTHR, n = item >> 3, kg = item & 7; f32x4 a, b;
#pragma unroll
                    for (int j = 0; j < 4; ++j) { a[j] = tile[(kg * 8 + j) * 260 + (n ^ (kg << 2))]; b[j] = tile[(kg * 8 + 4 + j) * 260 + (n ^ (kg << 2))]; }
                    int drow = cur.n0 + n;
                    if (cur.mode == 1) { const int up = drow >= DFF; const int jj = up ? drow - DFF : drow; drow = 256 * (jj >> 7) + (up ? 128 : 0) + (jj & 127); }
                    *(u32x4*)(cur.dst + (size_t)drow * cur.K + cur.k0 + kg * 8) = pack8(a, b); }
                __syncthreads();
                ti = nti; have = hn; cur = nxt;
            }
        __syncthreads();
    };
    if (((PHASE_MASK >> 0) & 1) && IN(0)) {
        weight_tiles(0, 1152);
        rmsnorm_rows<true>(P.in[0], P.in[1], Hn, nullptr, bid, G, wave, lane);
        {
            float* zf = (float*)smem; float* ha = zf + 8 * 40; float* hb = ha + 8 * 64;
            const float* w1 = P.in[5]; const float* b1 = P.in[6]; const float* w2 = P.in[7]; const float* b2 = P.in[8]; const float* w3 = P.in[9]; const float* b3 = P.in[10]; const float* fq_ = P.in[11];
            for (int pg = bid; pg < 256; pg += G) {
                const int pos = pg * 8 + wave;
                __syncthreads();
                if (lane < 33) {
                    float z;
                    if (lane == 0) z = (float)pos / 2047.0f;
                    else { const int mband = (lane - 1) & 15; const float f = 1e-4f + (float)mband * ((15.0f - 1e-4f) / 15.0f); const float w = (6.2831855f * (float)pos) / 2048.0f; const float a = f * w;
                        z = lane < 17 ? __cosf(a) : -__sinf(a); }
                    zf[wave * 40 + lane] = z;
                }
                __syncthreads();
                const float fr = fq_[lane];
                float a = b1[lane];
#pragma unroll 3
                for (int i = 0; i < 33; ++i) a += zf[wave * 40 + i] * w1[i * 64 + lane];
                ha[wave * 64 + lane] = __sinf(fr * a);
                __syncthreads();
                a = b2[lane];
#pragma unroll 8
                for (int i = 0; i < 64; ++i) a += ha[wave * 64 + i] * w2[i * 64 + lane];
                hb[wave * 64 + lane] = __sinf(fr * a);
                __syncthreads();
                a = b3[lane];
#pragma unroll 8
                for (int i = 0; i < 64; ++i) a += hb[wave * 64 + i] * w3[i * 64 + lane];
                h3[pos * 64 + lane] = __sinf(fr * a);
            }
            __syncthreads();
        }
        SEAM(0);
    }

    if (((PHASE_MASK >> 1) & 1) && IN(1)) {
        CHK(
            { const unsigned sid = bid * 8 + wave; unsigned* flags = (unsigned*)(ws + WS_BAR + 64); bool bad = false;
              { const int n = hsh(sid * 7 + 1) % 9216, k = (hsh(sid * 7 + 2) + lane) % 2048; bad |= WinT[(size_t)n * 2048 + k] != f2bf(P.in[2][(size_t)k * 9216 + n]); }
              { const int j = hsh(sid * 7 + 3) % 5632, k = (hsh(sid * 7 + 4) + lane) % 2048; const int rg = 256 * (j >> 7) + (j & 127);
                bad |= WfiT[(size_t)rg * 2048 + k] != f2bf(P.in[22][(size_t)k * 11264 + j]); bad |= WfiT[(size_t)(rg + 128) * 2048 + k] != f2bf(P.in[22][(size_t)k * 11264 + 5632 + j]); }
              { const int n = hsh(sid * 7 + 5) % 2048, k = (hsh(sid * 7 + 6) + lane) % 5632; bad |= WfoT[(size_t)n * 5632 + k] != f2bf(P.in[23][(size_t)k * 2048 + n]); }
              { const int n = hsh(sid * 7 + 5) % 2048, k = (hsh(sid * 7 + 6) + lane) % 1024; bad |= WbhT[(size_t)n * 1024 + k] != f2bf(P.in[18][(size_t)k * 2048 + n]); bad |= WbsT[(size_t)n * 1024 + k] != f2bf(P.in[19][(size_t)k * 2048 + n]); }
              { const int n = hsh(sid * 7 + 5) % 2048, k = (hsh(sid * 7 + 6) + lane) % 2048; bad |= WoutT[(size_t)n * 2048 + k] != f2bf(P.in[20][(size_t)k * 2048 + n]); }
              chk_flag(flags, bad, 1u); }
        );
        {
            const float* w4 = P.in[12]; float* Wl = (float*)smem;
            for (int cb = bid; cb < 256; cb += G) {
                __syncthreads();
                for (int idx = tid; idx < 1024; idx += NTHR) { const int cc = idx & 15, j = idx >> 4; Wl[cc * 64 + j] = w4[(size_t)j * 4096 + cb * 16 + cc]; }
                __syncthreads();
                for (int pp2 = 0; pp2 < 2; ++pp2) {
                    const int pos0 = (wave * 4 + pp2 * 2) * 64 + lane, pos1 = pos0 + 64;
                    float h0[64], h1[64];
#pragma unroll
                    for (int j4 = 0; j4 < 16; ++j4) { const f32x4 t0 = *(const f32x4*)(h3 + pos0 * 64 + j4 * 4), t1 = *(const f32x4*)(h3 + pos1 * 64 + j4 * 4);
#pragma unroll
                        for (int k = 0; k < 4; ++k) { h0[j4 * 4 + k] = t0[k]; h1[j4 * 4 + k] = t1[k]; } }
                    const float tt0 = (float)pos0 / 2047.0f, tt1 = (float)pos1 / 2047.0f;
                    for (int cc = 0; cc < 16; ++cc) {
                        const int col = cb * 16 + cc; const int dir = col >> 11, o = (col >> 10) & 1, c = col & 1023;
                        float a0 = 0.f, a1 = 0.f;
#pragma unroll
                        for (int j4 = 0; j4 < 16; ++j4) { const f32x4 w = *(const f32x4*)(Wl + cc * 64 + j4 * 4);
#pragma unroll
                            for (int k = 0; k < 4; ++k) { a0 += h0[j4 * 4 + k] * w[k]; a1 += h1[j4 * 4 + k] * w[k]; } }
                        const float ad = 3.0701134573f + (float)c * ((15.3505672866f - 3.0701134573f) / 1023.0f);
                        const float v0 = a0 * __expf(-tt0 * ad), v1 = a1 * __expf(-tt1 * ad);
                        float* kr = KF + (size_t)(o * 1024 + c) * 4096;
                        if (dir == 0) { kr[2048 + pos0] = v0; kr[2048 + pos1] = v1; }
                        else { if (pos0 >= 1) kr[2048 - pos0] = v0; else kr[0] = 0.f; kr[2048 - pos1] = v1; }
                    }
                }
            }
            __syncthreads();
        }
        {
            pg8::Gemm g{WinT, Hn, 3072, NTOK, DM}; pg8::StaticOrder S; S.init(3072, NTOK, G, bid);
            Epi1a E{PT, NTOK}; pg8::gemm_phase<Epi1a>(lds, g, S, E);
        }
        {
            pg8::Gemm g{Hn, WinT + (size_t)3072 * DM, NTOK, 6144, DM}; pg8::StaticOrder S; S.init(NTOK, 6144, G, bid);
            Epi1b E{PROJ2}; pg8::gemm_phase<Epi1b>(lds, g, S, E);
        }
        SEAM(1);
    }

    if (((PHASE_MASK >> 2) & 1) && IN(2)) {
        CHK(
            { const unsigned sid = bid * 8 + wave; unsigned* flags = (unsigned*)(ws + WS_BAR + 64);
              { const int ch = hsh(sid * 5 + 11) % 3072, tok = hsh(sid * 5 + 12) % 8192; const float ref = wdot(WinT + (size_t)ch * 2048, Hn + (size_t)tok * 2048, 2048, lane);
                chk_flag(flags, far(bf2f(PT[(size_t)ch * NTOK + tok]), ref), 2u); }
              { const int col = hsh(sid * 5 + 13) % 6144, tok = hsh(sid * 5 + 14) % 8192; const float r0 = wdot(Hn + (size_t)tok * 2048, WinT + (size_t)(3072 + col) * 2048, 2048, lane);
                const float ref = col < 2048 ? 0.5f * r0 * (1.0f + erff(r0 * 0.70710678f)) : 1.0f / (1.0f + expf(-r0));
                chk_flag(flags, far(bf2f(PROJ2[(size_t)tok * 6144 + col]), ref), 4u); } }
        );
        if (bid & 1) weight_tiles(1152, 3776);
        {
            unsigned char* Z1 = smem;
            unsigned char* Z2 = smem + 34816;
            unsigned char* KS = smem + 69632;
            bf16_t* KR = (bf16_t*)(smem + 137472);
            float* red = (float*)(smem + 145696);
            const float* scw = P.in[3]; const float* scb = P.in[4]; const float* hbias = P.in[13];
            for (int i = tid; i < 1024; i += NTHR) { const int buf = i >> 9, w = i & 511; const int off = (w < 256 ? 0 : 66 * 512 - 1024) + w * 4; *(unsigned*)((buf ? Z2 : Z1) + off) = 0u; }
            const int pp = wave & 1, gg = wave >> 1, li = lane & 15, lq = lane >> 4, bb = li & 7, jsel = li >> 3;
            const unsigned boff = (unsigned)(jsel * 512 + bb * 64 + ((lq ^ ((bb >> 2) << 1)) * 16));
            const int rcp_ = 7 - (li & 7); const int ksl = rcp_ * 8448 + 48 * (rcp_ & 3) + 2 * (2040 - 16 * pp - 8 * (li >> 3) + 8 * lq);
            float kv[8];
            if (bid < DH) { const float* kr0 = KF + (size_t)bid * 4096;
#pragma unroll
                for (int j = 0; j < 8; ++j) kv[j] = kr0[tid + j * NTHR]; }
            for (int c = bid; c < DH; c += G) {
                __syncthreads();
                {   const float w0 = scw[c], w1 = scw[3072 + c], w2 = scw[6144 + c], bs = scb[c];
                    for (int ch = tid; ch < 2048; ch += NTHR) { const int b = ch >> 8, s = (ch & 255) * 8; const bf16_t* src = PT + (size_t)c * NTOK + b * 2048 + s;
                        f32x4 fa, fb; unpack8(*(const u32x4*)src, fa, fb); const float fl = s > 0 ? bf2f(src[-1]) : 0.f, fr_ = s + 8 < 2048 ? bf2f(src[8]) : 0.f;
                        f32x4 oa, ob;
                        oa[0] = w0 * fl + w1 * fa[0] + w2 * fa[1] + bs; oa[1] = w0 * fa[0] + w1 * fa[1] + w2 * fa[2] + bs; oa[2] = w0 * fa[1] + w1 * fa[2] + w2 * fa[3] + bs; oa[3] = w0 * fa[2] + w1 * fa[3] + w2 * fb[0] + bs;
                        ob[0] = w0 * fa[3] + w1 * fb[0] + w2 * fb[1] + bs; ob[1] = w0 * fb[0] + w1 * fb[1] + w2 * fb[2] + bs; ob[2] = w0 * fb[1] + w1 * fb[2] + w2 * fb[3] + bs; ob[3] = w0 * fb[2] + w1 * fb[3] + w2 * fr_ + bs;
                        const int J = s >> 5, chunk = (s & 31) >> 3;
                        *(u32x4*)(Z1 + ((J + 2) * 8 + b) * 64 + ((chunk ^ ((b >> 2) << 1)) * 16)) = pack8(oa, ob); } }
                for (int o = 0; o < 2; ++o) {
                    float part = 0.f;
#pragma unroll
                    for (int j = 0; j < 8; ++j) { part += fabsf(kv[j]); KR[4095 - (tid + j * NTHR)] = f2bf(kv[j]); }
                    if (tid < 8) KR[4096 + tid] = 0;
                    const float scale = 1.0f / block_sum(part, red, tid);
                    {   const u32x4 c0 = *(const u32x4*)(KR + tid * 8), c1 = *(const u32x4*)(KR + tid * 8 + 8);
                        const unsigned D[8] = {c0.x, c0.y, c0.z, c0.w, c1.x, c1.y, c1.z, c1.w};
#pragma unroll
                        for (int r = 0; r < 8; ++r) { u32x4 w; const int sft = r >> 1;
                            if (r & 1) { w.x = __builtin_amdgcn_alignbit(D[sft + 1], D[sft], 16); w.y = __builtin_amdgcn_alignbit(D[sft + 2], D[sft + 1], 16); w.z = __builtin_amdgcn_alignbit(D[sft + 3], D[sft + 2], 16); w.w = __builtin_amdgcn_alignbit(D[sft + 4], D[sft + 3], 16); }
                            else { w.x = D[sft]; w.y = D[sft + 1]; w.z = D[sft + 2]; w.w = D[sft + 3]; }
                            *(u32x4*)(KS + r * 8448 + 48 * (r & 3) + tid * 16) = w; } }
                    __syncthreads();
                    {
                        const int nc = o == 0 ? c : c + G, no = o == 0 ? 1 : 0;
                        if (nc < DH) { const float* krn = KF + (size_t)(no * 1024 + nc) * 4096;
#pragma unroll
                            for (int j = 0; j < 8; ++j) kv[j] = krn[tid + j * NTHR]; } }
                    const unsigned char* Zin = o ? Z2 : Z1;
                    const int chx = (o == 0 ? 1024 : 2048) + c;
                    u32x2 xwv[8]; unsigned short xlv[8], xrv[8];
#pragma unroll
                    for (int a = 0; a < 8; ++a) { const int I = pp + 2 * (16 * gg + 2 * a + jsel); const int t0 = 16 * I + 4 * lq; const bf16_t* src = PT + (size_t)chx * NTOK + bb * 2048 + t0;
                        xwv[a] = *(const u32x2*)src; xlv[a] = t0 > 0 ? src[-1] : (unsigned short)0; xrv[a] = t0 + 4 < 2048 ? src[4] : (unsigned short)0; }
                    f32x4 acc[8];
#pragma unroll
                    for (int a = 0; a < 8; ++a) acc[a] = (f32x4){0.f, 0.f, 0.f, 0.f};
#define HY_LA(E) (*(const bf16x8*)(KS + ksl - 64 * (E)))
#define HY_LBJ(J0) (*(const bf16x8*)(Zin + (((J0) >= -1 && (J0) <= 63) ? ((J0) + 2) : 0) * 512 + boff))
                    {
                        bf16x8 bE[8], bO[8];
                        const int e0 = 16 * gg - 63;
#pragma unroll
                        for (int a2 = 0; a2 < 8; ++a2) { bE[a2] = HY_LBJ(16 * gg + 2 * a2 - e0); bO[a2] = HY_LBJ(16 * gg + 2 * a2 - e0 - 1); }
                        bf16x8 af = HY_LA(e0);
                        for (int eb = e0; eb < e0 + 80; eb += 16) {
#pragma unroll
                            for (int k = 0; k < 8; ++k) {
                                const bf16x8 afo = HY_LA(eb + 2 * k + 1);
#pragma unroll
                                for (int a2 = 0; a2 < 8; ++a2) acc[a2] = __builtin_amdgcn_mfma_f32_16x16x32_bf16(af, bE[(a2 - k) & 7], acc[a2], 0, 0, 0);
                                bE[(7 - k) & 7] = HY_LBJ(16 * gg - (eb + 2 * k + 2));
                                af = HY_LA(eb + 2 * k + 2);
#pragma unroll
                                for (int a2 = 0; a2 < 8; ++a2) acc[a2] = __builtin_amdgcn_mfma_f32_16x16x32_bf16(afo, bO[(a2 - k) & 7], acc[a2], 0, 0, 0);
                                bO[(7 - k) & 7] = HY_LBJ(16 * gg - (eb + 2 * k + 3));
                            }
                        }
                    }
#undef HY_LA
#undef HY_LBJ
                    const float bo = hbias[o * 1024 + c];
                    const float w0 = scw[chx], w1 = scw[3072 + chx], w2 = scw[6144 + chx], bs = scb[chx];
#pragma unroll
                    for (int a = 0; a < 8; ++a) { const int I = pp + 2 * (16 * gg + 2 * a + jsel); const int t0 = 16 * I + 4 * lq;
                        const int zaddr = ((t0 >> 5) + 2) * 512 + bb * 64 + ((((t0 & 31) >> 3) ^ ((bb >> 2) << 1)) * 16) + (t0 & 7) * 2;
                        const u32x2 zw = *(const u32x2*)(Zin + zaddr);
                        const float z0 = __uint_as_float(zw.x << 16), z1 = __uint_as_float(zw.x & 0xffff0000u), z2 = __uint_as_float(zw.y << 16), z3 = __uint_as_float(zw.y & 0xffff0000u);
                        const u32x2 xw = xwv[a];
                        const float x0 = __uint_as_float(xw.x << 16), x1 = __uint_as_float(xw.x & 0xffff0000u), x2 = __uint_as_float(xw.y << 16), x3 = __uint_as_float(xw.y & 0xffff0000u);
                        const float xl = bf2f(xlv[a]), xr = bf2f(xrv[a]);
                        const float r0 = (w0 * xl + w1 * x0 + w2 * x1 + bs) * (acc[a][0] * scale + z0 * bo), r1 = (w0 * x0 + w1 * x1 + w2 * x2 + bs) * (acc[a][1] * scale + z1 * bo);
                        const float r2 = (w0 * x1 + w1 * x2 + w2 * x3 + bs) * (acc[a][2] * scale + z2 * bo), r3 = (w0 * x2 + w1 * x3 + w2 * xr + bs) * (acc[a][3] * scale + z3 * bo);
                        u32x2 w; w.x = cvt_pk_bf16(r0, r1); w.y = cvt_pk_bf16(r2, r3);
                        if (o == 0) *(u32x2*)(Z2 + zaddr) = w; else *(u32x2*)(YT + (size_t)c * NTOK + bb * 2048 + t0) = w; }
                    __syncthreads();
                }
            }
        }
        {
            bf16_t* Wl = (bf16_t*)smem;
            bf16_t* Vl = (bf16_t*)(smem + 36864);
            float* stl = (float*)(smem + 73728);
            const float* lng = P.in[14]; const float* lnb = P.in[15]; const float* w_s = P.in[16]; const float* b_s = P.in[17];
            const int li = lane & 15, lq = lane >> 4;
            for (int item = bid; item < 256; item += G) {
              const int bn = item >> 1, tok0 = bn * 128;
              __syncthreads();
              for (int qb = 0; qb < 4; ++qb) {
                  u32x4 raw[4][2];
#pragma unroll
                  for (int k = 0; k < 4; ++k) { const bf16_t* vp = PROJ2 + (size_t)(tok0 + wave * 16 + qb * 4 + k) * 6144 + 1024 + lane * 16; raw[k][0] = *(const u32x4*)vp; raw[k][1] = *(const u32x4*)(vp + 8); }
#pragma unroll
                  for (int k = 0; k < 4; ++k) { const int q = wave * 16 + qb * 4 + k;
                      f32x4 a0, a1, a2, a3; unpack8(raw[k][0], a0, a1); unpack8(raw[k][1], a2, a3);
                      float sm = 0.f, sq = 0.f;
#pragma unroll
                      for (int j = 0; j < 4; ++j) { sm += (a0[j] + a1[j]) + (a2[j] + a3[j]); sq += (a0[j] * a0[j] + a1[j] * a1[j]) + (a2[j] * a2[j] + a3[j] * a3[j]); }
                      for (int o = 32; o >= 1; o >>= 1) { sm += __shfl_xor(sm, o); sq += __shfl_xor(sq, o); }
                      if (lane == 0) { const float mean = sm * (1.0f / 1024.0f); const float var = sq * (1.0f / 1024.0f) - mean * mean; stl[2 * q] = mean; stl[2 * q + 1] = rsqrtf(var + EPSV); } }
              }
              for (int hh = 0; hh < 4; ++hh) {
                const int h = (item & 1) * 4 + hh;
                __syncthreads();
                for (int ch = tid; ch < 2048; ch += NTHR) {
                    { const int p = ch >> 4, q8 = (ch & 15) * 8; const float* wp = w_s + (size_t)h * 16384 + p * 128 + q8;
                      *(u32x4*)(Wl + p * 144 + q8) = pack8(*(const f32x4*)wp, *(const f32x4*)(wp + 4)); }
                    { const int q = ch >> 4, c8 = (ch & 15) * 8; const float sm = stl[2 * q], rstd = stl[2 * q + 1];
                      f32x4 va, vb; unpack8(*(const u32x4*)(PROJ2 + (size_t)(tok0 + q) * 6144 + 1024 + h * 128 + c8), va, vb);
                      const f32x4 ga = *(const f32x4*)(lng + h * 128 + c8), gb = *(const f32x4*)(lng + h * 128 + c8 + 4), ba = *(const f32x4*)(lnb + h * 128 + c8), bb_ = *(const f32x4*)(lnb + h * 128 + c8 + 4);
                      va = (va - sm) * rstd * ga + ba; vb = (vb - sm) * rstd * gb + bb_;
#pragma unroll
                      for (int j = 0; j < 4; ++j) { Vl[(c8 + j) * 144 + q] = f2bf(va[j]); Vl[(c8 + 4 + j) * 144 + q] = f2bf(vb[j]); } }
                }
                __syncthreads();
                f32x4 acc[8];
#pragma unroll
                for (int ct = 0; ct < 8; ++ct) acc[ct] = (f32x4){0.f, 0.f, 0.f, 0.f};
#pragma unroll
                for (int kk = 0; kk < 4; ++kk) { const bf16x8 wf = *(const bf16x8*)(Wl + (wave * 16 + li) * 144 + kk * 32 + lq * 8);
#pragma unroll
                    for (int ct = 0; ct < 8; ++ct) { const bf16x8 vf = *(const bf16x8*)(Vl + (ct * 16 + li) * 144 + kk * 32 + lq * 8);
                        acc[ct] = __builtin_amdgcn_mfma_f32_16x16x32_bf16(vf, wf, acc[ct], 0, 0, 0); } }
                {   const int p = wave * 16 + li, tok = tok0 + p; const float bs = b_s[h * 128 + p];
#pragma unroll
                    for (int ct = 0; ct < 8; ++ct) { const int cc = h * 128 + ct * 16 + lq * 4; const u32x2 uw = *(const u32x2*)(PROJ2 + (size_t)tok * 6144 + cc);
                        const float u0 = __uint_as_float(uw.x << 16), u1 = __uint_as_float(uw.x & 0xffff0000u), u2 = __uint_as_float(uw.y << 16), u3 = __uint_as_float(uw.y & 0xffff0000u);
                        u32x2 w; w.x = cvt_pk_bf16(u0 * (acc[ct][0] + bs), u1 * (acc[ct][1] + bs)); w.y = cvt_pk_bf16(u2 * (acc[ct][2] + bs), u3 * (acc[ct][3] + bs));
                        *(u32x2*)(Ysgu + (size_t)tok * 1024 + cc) = w; } }
              }
            }
            __syncthreads();
        }
        if (!(bid & 1)) weight_tiles(1152, 3776);
        SEAM(2);
    }

    if (((PHASE_MASK >> 3) & 1) && IN(3)) {
        auto ytrans = [&]() {
        bf16_t* tile = (bf16_t*)smem;
        u32x4 v[4]; int ti = bid; bool have = ti < 1024;
        if (have) { const int c0 = (ti & 15) * 64, t0 = (ti >> 4) * 256;
#pragma unroll
            for (int i = 0; i < 4; ++i) { const int idx = tid + i * NTHR, cr = idx >> 5, tg = idx & 31; v[i] = *(const u32x4*)(YT + (size_t)(c0 + cr) * NTOK + t0 + tg * 8); } }
        while (have) {
            const int c0 = (ti & 15) * 64, t0 = (ti >> 4) * 256;
#pragma unroll
            for (int i = 0; i < 4; ++i) { const int idx = tid + i * NTHR, cr = idx >> 5, tg = idx & 31; *(u32x4*)(tile + cr * 264 + tg * 8) = v[i]; }
            __syncthreads();
            const int nti = ti + G; const bool hn = nti < 1024;
            if (hn) { const int nc0 = (nti & 15) * 64, nt0 = (nti >> 4) * 256;
#pragma unroll
                for (int i = 0; i < 4; ++i) { const int idx = tid + i * NTHR, cr = idx >> 5, tg = idx & 31; v[i] = *(const u32x4*)(YT + (size_t)(nc0 + cr) * NTOK + nt0 + tg * 8); } }
#pragma unroll
            for (int i = 0; i < 4; ++i) { const int item = tid + i * NTHR, tr = item >> 3, cg8 = item & 7; unsigned short e[8];
#pragma unroll
                for (int j = 0; j < 8; ++j) e[j] = tile[(cg8 * 8 + j) * 264 + tr];
                u32x4 w; w.x = e[0] | ((unsigned)e[1] << 16); w.y = e[2] | ((unsigned)e[3] << 16); w.z = e[4] | ((unsigned)e[5] << 16); w.w = e[6] | ((unsigned)e[7] << 16);
                *(u32x4*)(Yhy + (size_t)(t0 + tr) * 1024 + c0 + cg8 * 8) = w; }
            __syncthreads();
            ti = nti; have = hn;
        }
        };
        if (bid & 1) ytrans();
        {   pg8::Gemm g{Ysgu, WbsT, NTOK, DM, DH}; pg8::StaticOrder S; S.init(NTOK, DM, G, bid);
            Epi4<false> E{MERGED, PROJ2 + 4096}; pg8::gemm_phase<Epi4<false>>(lds, g, S, E); }
        if (!(bid & 1)) ytrans();
        SEAM(3);
    }
#ifdef DBG_CUT3
    {
        for (size_t i = (size_t)bid * NTHR + tid; i < (size_t)NTOK * 2048; i += (size_t)G * NTHR) { const int row = (int)(i >> 11), c = (int)(i & 2047);
            P.out[i] = c < 1024 ? bf2f(Yhy[(size_t)row * 1024 + c]) : bf2f(Ysgu[(size_t)row * 1024 + c - 1024]); }
        return;
    }
#endif
    if (((PHASE_MASK >> 4) & 1) && IN(4)) {
        {   pg8::Gemm g{Yhy, WbhT, NTOK, DM, DH}; pg8::StaticOrder S; S.init(NTOK, DM, G, bid);
            Epi4<true> E{MERGED, PROJ2 + 2048}; pg8::gemm_phase<Epi4<true>>(lds, g, S, E); }
        SEAM(4);
    }

    if (((PHASE_MASK >> 5) & 1) && IN(5)) {
        pg8::Gemm g{MERGED, WoutT, NTOK, DM, DM}; pg8::StaticOrder S; S.init(NTOK, DM, G, bid);
        Epi5 E{P.in[0], P.out, SSP, P.in[21], H2}; pg8::gemm_phase<Epi5>(lds, g, S, E);
        SEAM(5);
    }
    if (((PHASE_MASK >> 6) & 1) && IN(6)) {
        pg8::Gemm g{H2, WfiT, NTOK, 2 * DFF, DM}; pg8::StaticOrder S; S.init(NTOK, 2 * DFF, G, bid);
        pg8::Unit u0; S.next(0, u0);
        {   float* rst = (float*)(smem + 131072);
            for (int r = tid; r < 256; r += NTHR) { const float* sp = SSP + (size_t)(u0.pm * 256 + r) * 32; float q4[4];
#pragma unroll
                for (int k = 0; k < 4; ++k) { const f32x4 p0 = *(const f32x4*)(sp + k * 8), p1 = *(const f32x4*)(sp + k * 8 + 4); q4[k] = ((p0[0] + p0[1]) + (p0[2] + p0[3])) + ((p1[0] + p1[1]) + (p1[2] + p1[3])); }
                rst[r] = rsqrtf(((q4[0] + q4[1]) + (q4[2] + q4[3])) * (1.0f / 2048.0f) + EPSV); }
            __syncthreads(); }
        Epi6 E{HID, SSP, (const LAS float*)(smem + 131072), u0.pm}; pg8::gemm_phase<Epi6>(lds, g, S, E);
        SEAM(6);
    }
    const bool fuse78 = (G == 256);
    if (((PHASE_MASK >> 7) & 1) && IN(7)) {
        pg8::Gemm g{HID, WfoT, NTOK, DM, DFF}; pg8::StaticOrder S; S.init(NTOK, DM, G, bid);
        if (fuse78) { S.rowmode = 1; Epi7 E{P.out, P.out, (float*)(ws + WS_R2 + 4194304), (unsigned*)(ws + WS_BAR + 1024), P.in[24]}; pg8::gemm_phase<Epi7>(lds, g, S, E); }
        else { EpiRes E{P.out, P.out}; pg8::gemm_phase<EpiRes>(lds, g, S, E); SEAM(7); }
    }
    if (((PHASE_MASK >> 8) & 1) && IN(8) && !fuse78) {
        rmsnorm_rows<false>(P.out, P.in[24], nullptr, P.out, bid, G, wave, lane);
    }
#undef IN
#undef SEAM
}

extern "C" void kernel_launch(void* const* d_in, const int* in_sizes, int n_in, void* d_out, int out_size, void* d_ws, size_t ws_size, hipStream_t stream) {
    static int grid_blocks = 0;
    if (grid_blocks == 0) {
        if (n_in != 25 || out_size != NTOK * DM || ws_size < WS_END) { fprintf(stderr, "kernel_launch: unexpected shapes n_in %d out %d ws %zu (need %zu)\n", n_in, out_size, ws_size, (size_t)WS_END); grid_blocks = -1; return; }
        int dev = 0, cus = 0, per_cu = 0;
        hipGetDevice(&dev);
        hipDeviceGetAttribute(&cus, hipDeviceAttributeMultiprocessorCount, dev);
        if (hipFuncSetAttribute((const void*)fwd_megakernel, hipFuncAttributeMaxDynamicSharedMemorySize, LDS_BYTES) != hipSuccess) { fprintf(stderr, "kernel_launch: hipFuncSetAttribute failed\n"); grid_blocks = -1; return; }
        if (hipOccupancyMaxActiveBlocksPerMultiprocessor(&per_cu, (const void*)fwd_megakernel, NTHR, LDS_BYTES) != hipSuccess || per_cu < 1) { fprintf(stderr, "kernel_launch: occupancy query gave %d\n", per_cu); per_cu = 1; }
        (void)hipGetLastError();
        grid_blocks = cus * per_cu;
    }
    if (grid_blocks < 0) return;
    if (hipMemsetAsync((char*)d_ws + WS_BAR, 0, 32768, stream) != hipSuccess) { fprintf(stderr, "kernel_launch: memset failed\n"); return; }
    Params p{};
    for (int i = 0; i < 25; ++i) p.in[i] = (const float*)d_in[i];
    p.out = (float*)d_out; p.ws = (unsigned char*)d_ws; p.lo = 0; p.hi = 9;
    void* args[] = {&p};
    hipError_t e = hipLaunchCooperativeKernel((const void*)fwd_megakernel, dim3(grid_blocks), dim3(NTHR), args, LDS_BYTES, stream);
    if (e != hipSuccess) fprintf(stderr, "cooperative launch failed: %s (grid %d)\n", hipGetErrorString(e), grid_blocks);
}
```

```cpp
#include <hip/hip_runtime.h>
#include <hip/hip_cooperative_groups.h>
#include <cstdio>
namespace cg = cooperative_groups;

#define LAS __attribute__((address_space(3)))
typedef unsigned short bf16_t;
typedef short bf16x8 __attribute__((ext_vector_type(8)));
typedef float f32x4 __attribute__((ext_vector_type(4)));
typedef float f32x2 __attribute__((ext_vector_type(2)));
typedef unsigned u32x4 __attribute__((ext_vector_type(4)));
typedef unsigned u32x2 __attribute__((ext_vector_type(2)));

constexpr int NTOK = 16384, DM = 2048, DH = 1024, DFF = 5632, SEQ = 2048;
constexpr float EPSV = 1e-6f;
constexpr int NTHR = 512;
#ifndef PHASE_MASK
#define PHASE_MASK 0x3ff
#endif
constexpr int LDS_BYTES = 146432;

constexpr size_t WS_STATS = 0;
constexpr size_t WS_SS1 = 131072;
constexpr size_t WS_SS2 = 196608;
constexpr size_t WS_H3 = 262144;
constexpr size_t WS_BAR = 917504;
constexpr size_t WS_W = 1048576;
constexpr size_t W_IN = WS_W;
constexpr size_t W_BH = W_IN + 37748736;
constexpr size_t W_BS = W_BH + 4194304;
constexpr size_t W_OUT = W_BS + 4194304;
constexpr size_t W_FI = W_OUT + 8388608;
constexpr size_t W_FO = W_FI + 46137344;
constexpr size_t WS_R2 = W_FO + 23068672;
constexpr size_t WS_R3 = WS_R2 + 67108864;
constexpr size_t R3_PT = WS_R3;
constexpr size_t R3_PROJ2 = WS_R3 + 100663296;
constexpr size_t R3_MERGED = WS_R3;
constexpr size_t R3_H2 = WS_R3 + 184549376;
constexpr size_t R3_HID = WS_R3;
constexpr size_t WS_END = WS_R3 + 301989888;

struct Params { const float* in[25]; float* out; unsigned char* ws; int lo, hi; };

__device__ __forceinline__ float bf2f(bf16_t b) { return __uint_as_float(((unsigned)b) << 16); }
__device__ __forceinline__ bf16_t f2bf(float f) { unsigned u = __float_as_uint(f); u += 0x7FFFu + ((u >> 16) & 1u); return (bf16_t)(u >> 16); }
typedef __bf16 bf16x2_t __attribute__((ext_vector_type(2)));
__device__ __forceinline__ unsigned cvt_pk_bf16(float lo, float hi) { f32x2 v = {lo, hi}; bf16x2_t b = __builtin_convertvector(v, bf16x2_t); return __builtin_bit_cast(unsigned, b); }
__device__ __forceinline__ u32x4 pack8(f32x4 a, f32x4 b) { u32x4 w; w.x = cvt_pk_bf16(a[0], a[1]); w.y = cvt_pk_bf16(a[2], a[3]); w.z = cvt_pk_bf16(b[0], b[1]); w.w = cvt_pk_bf16(b[2], b[3]); return w; }
__device__ __forceinline__ void unpack8(u32x4 w, f32x4& a, f32x4& b) {
    a[0] = __uint_as_float(w.x << 16); a[1] = __uint_as_float(w.x & 0xffff0000u); a[2] = __uint_as_float(w.y << 16); a[3] = __uint_as_float(w.y & 0xffff0000u);
    b[0] = __uint_as_float(w.z << 16); b[1] = __uint_as_float(w.z & 0xffff0000u); b[2] = __uint_as_float(w.w << 16); b[3] = __uint_as_float(w.w & 0xffff0000u); }
__device__ __forceinline__ float sigmoidf_(float x) { return __builtin_amdgcn_rcpf(1.0f + __expf(-x)); }
__device__ __forceinline__ f32x2 gelu_pk(f32x2 v) {
    const f32x2 av = __builtin_elementwise_abs(v), d = av * 0.2316418882f + 1.0f;
    f32x2 t; t.x = __builtin_amdgcn_rcpf(d.x); t.y = __builtin_amdgcn_rcpf(d.y);
    f32x2 q = t * 0.5307027145f + (-0.7265760135f); q = q * t + 0.7107068705f; q = q * t + (-0.142248368f); q = q * t + 0.127414796f; q = q * t;
    const f32x2 s = (v * v) * (-0.72134752044f);
    f32x2 e; e.x = __builtin_amdgcn_exp2f(s.x); e.y = __builtin_amdgcn_exp2f(s.y);
    const f32x2 m = v * (q * e), r = v - m;
    f32x2 o; o.x = v.x < 0.f ? m.x : r.x; o.y = v.y < 0.f ? m.y : r.y; return o;
}
__device__ __forceinline__ f32x4 gelu4(f32x4 v) { f32x2 a = gelu_pk((f32x2){v[0], v[1]}), b = gelu_pk((f32x2){v[2], v[3]}); return (f32x4){a.x, a.y, b.x, b.y}; }

namespace pg8 {
constexpr int BM = 256, BK = 64, HALF = 128, HTB = HALF * BK * 2, STAGE_BYTES = 8 * HTB, NXCD = 8, WGM = 8;
__host__ __device__ __forceinline__ int lds_byte(int r, int c) { const int st = (r >> 4) * 2 + (c >> 5), rr = r & 15, cc = c & 31, ob = rr * 64 + cc * 2; return st * 1024 + (ob ^ (((ob >> 9) & 1) << 5)); }
__host__ __device__ __forceinline__ void stage_rc(int b, int& R, int& C) { const int st = b / 1024, sb = b % 1024, swz = sb ^ (((sb >> 9) & 1) << 5); R = (st >> 1) * 16 + swz / 64; C = (st & 1) * 32 + (swz % 64) / 2; }
__host__ __device__ __forceinline__ int perm32(int rho) { const int n = rho >> 4, i = rho & 15; return 8 * (i >> 2) + 4 * n + (i & 3); }
struct Unit { int pm, pn; };
struct Gemm { const bf16_t* A; const bf16_t* Bt; int M, N, K; };
struct StaticOrder {
    int nM, nN, nwg, G, c, rowmode;
    __device__ void init(int M, int N, int G_, int c_) { nM = M / BM; nN = N / BM; nwg = nM * nN; G = G_; c = c_; rowmode = 0; }
    __device__ bool next(int i, Unit& u) const {
        const long L = (long)i * G + c; if (L >= nwg) return false;
        if (rowmode) { u.pm = i * 32 + (c & 7) * 4 + (c >> 6); u.pn = (c >> 3) & 7; return true; }
        int wgid = (int)L; { const int q = nwg / NXCD, r = nwg % NXCD, xcd = wgid % NXCD, off = wgid / NXCD; wgid = (xcd < r ? xcd * (q + 1) : r * (q + 1) + (xcd - r) * q) + off; }
        const int nig = WGM * nN, gid = wgid / nig, fm = gid * WGM, gsz = (nM - fm) < WGM ? (nM - fm) : WGM;
        u.pm = fm + ((wgid % nig) % gsz); u.pn = (wgid % nig) / gsz; return true;
    }
};

template <class Epi>
__device__ __forceinline__ void gemm_phase(LAS unsigned char* lds, const Gemm g, const StaticOrder& S, const Epi& E) {
    const int tid = threadIdx.x, wid = __builtin_amdgcn_readfirstlane(tid >> 6), lane = tid & 63, wr = wid >> 2, wc = wid & 3, fr = lane & 15, fq = lane >> 4;
    const int K = g.K, nt = K / BK;
    unsigned voffA[2], voffB[2];
#pragma unroll
    for (int i = 0; i < 2; ++i) { int R, C; stage_rc(tid * 16 + i * 8192, R, C); const int Rb = Epi::PERM ? ((R & ~31) + perm32(R & 31)) : R;
        voffA[i] = (unsigned)(R * K + C) * 2u; voffB[i] = (unsigned)(Rb * K + C) * 2u; }
    const size_t kstep = (size_t)(BK * 2);
    const size_t hstep = (size_t)HALF * K * 2;
    const size_t tstep = 2 * hstep;
    const unsigned ldsw = (unsigned)wid * 1024u;
    const int aoff = lds_byte(wr * 64 + fr, fq * 8), boff = lds_byte(wc * 32 + fr, fq * 8);
#define PG8_SA(b, h) (((b) * 2 + (h)) * HTB)
#define PG8_SB(b, h) ((4 + (b) * 2 + (h)) * HTB)
#define PG8_STAGE(bufoff, gbase, voff) do { _Pragma("unroll") for (int _i = 0; _i < 2; ++_i) \
        __builtin_amdgcn_global_load_lds((const unsigned*)((const char*)(gbase) + (voff)[_i]), (LAS unsigned*)(lds + (bufoff) + ldsw + _i * 8192), 16, 0, 0); } while (0)
#define PG8_LDA(dst, b, h) do { _Pragma("unroll") for (int m = 0; m < 4; ++m) _Pragma("unroll") for (int k = 0; k < 2; ++k) dst[m][k] = *(const LAS bf16x8*)(lds + PG8_SA(b, h) + aoff + m * 2048 + k * 1024); } while (0)
#define PG8_LDB(dst, b, h) do { _Pragma("unroll") for (int n = 0; n < 2; ++n) _Pragma("unroll") for (int k = 0; k < 2; ++k) dst[n][k] = *(const LAS bf16x8*)(lds + PG8_SB(b, h) + boff + n * 2048 + k * 1024); } while (0)
#define PG8_MMA(ai, bj, At, Bt) do { __builtin_amdgcn_s_setprio(1); _Pragma("unroll") for (int m = 0; m < 4; ++m) _Pragma("unroll") for (int n = 0; n < 2; ++n) _Pragma("unroll") for (int k = 0; k < 2; ++k) \
        acc[ai][bj][m][n] = __builtin_amdgcn_mfma_f32_16x16x32_bf16(Bt[n][k], At[m][k], acc[ai][bj][m][n], 0, 0, 0); __builtin_amdgcn_s_setprio(0); } while (0)
#define PG8_WAIT_V(n) asm volatile("s_waitcnt vmcnt(" #n ")" ::: "memory")
#define PG8_WAIT_L(n) asm volatile("s_waitcnt lgkmcnt(" #n ")" ::: "memory")
#define PG8_BAR __builtin_amdgcn_s_barrier()
#define PG8_SCHED __builtin_amdgcn_sched_barrier(0)
    Unit cur, nxt; int ui = 0;
    if (!S.next(0, cur)) return;
    f32x4 acc[2][2][4][2];
#pragma unroll
    for (int a = 0; a < 2; ++a)
#pragma unroll
        for (int b = 0; b < 2; ++b)
#pragma unroll
            for (int m = 0; m < 4; ++m)
#pragma unroll
                for (int n = 0; n < 2; ++n) acc[a][b][m][n] = (f32x4){0.f, 0.f, 0.f, 0.f};
    bf16x8 At[4][2], B0[2][2], B1[2][2];
    const char* cA = (const char*)g.A + (size_t)cur.pm * tstep; const char* cB = (const char*)g.Bt + (size_t)cur.pn * tstep;
    PG8_STAGE(PG8_SB(0, 0), cB, voffB); PG8_STAGE(PG8_SB(0, 1), cB + hstep, voffB); PG8_STAGE(PG8_SA(0, 0), cA, voffA); PG8_STAGE(PG8_SA(0, 1), cA + hstep, voffA);
    if (wr == 1) PG8_BAR;
    PG8_WAIT_V(2); PG8_BAR;
    PG8_STAGE(PG8_SB(1, 0), cB + kstep, voffB); PG8_STAGE(PG8_SA(1, 0), cA + kstep, voffA); PG8_STAGE(PG8_SB(1, 1), cB + hstep + kstep, voffB);
    PG8_WAIT_V(6); PG8_BAR;
    for (;;) {
        const bool has_next = S.next(ui + 1, nxt);
        const char* nA = has_next ? (const char*)g.A + (size_t)nxt.pm * tstep : cA; const char* nB = has_next ? (const char*)g.Bt + (size_t)nxt.pn * tstep : cB;
        for (int t = 0; t < nt; t += 2) {
            const bool last = (t == nt - 2);
            const char* a1 = cA + (size_t)(t + 1) * kstep;
            const char* a2 = last ? nA : cA + (size_t)(t + 2) * kstep; const char* b2 = last ? nB : cB + (size_t)(t + 2) * kstep;
            const char* a3 = a2 + kstep; const char* b3 = b2 + kstep;
            PG8_LDB(B0, 0, 0); PG8_LDB(B1, 0, 1); PG8_SCHED; PG8_LDA(At, 0, 0); PG8_STAGE(PG8_SA(1, 1), a1 + hstep, voffA);
            PG8_WAIT_V(8); PG8_WAIT_L(0); PG8_BAR; PG8_MMA(0, 0, At, B0); PG8_MMA(0, 1, At, B1); PG8_BAR; PG8_SCHED;
            PG8_LDA(At, 0, 1); PG8_STAGE(PG8_SB(0, 0), b2, voffB); PG8_STAGE(PG8_SB(0, 1), b2 + hstep, voffB); PG8_STAGE(PG8_SA(0, 0), a2, voffA);
            PG8_WAIT_V(8); PG8_WAIT_L(0); PG8_BAR; PG8_MMA(1, 0, At, B0); PG8_MMA(1, 1, At, B1); PG8_BAR; PG8_SCHED;
            PG8_LDB(B0, 1, 0); PG8_LDB(B1, 1, 1); PG8_SCHED; PG8_LDA(At, 1, 0); PG8_STAGE(PG8_SA(0, 1), a2 + hstep, voffA);
            PG8_WAIT_V(8); PG8_WAIT_L(0); PG8_BAR; PG8_MMA(0, 0, At, B0); PG8_MMA(0, 1, At, B1); PG8_BAR; PG8_SCHED;
            PG8_LDA(At, 1, 1); PG8_STAGE(PG8_SB(1, 0), b3, voffB); PG8_STAGE(PG8_SB(1, 1), b3 + hstep, voffB); PG8_STAGE(PG8_SA(1, 0), a3, voffA);
            PG8_WAIT_V(8); PG8_WAIT_L(0); PG8_BAR; PG8_MMA(1, 0, At, B0); PG8_MMA(1, 1, At, B1); PG8_BAR; PG8_SCHED;
        }
        if (wr == 0) PG8_BAR;
        E(acc, cur, wr, wc, fr, fq);
        if (!has_next) break;
#pragma unroll
        for (int a = 0; a < 2; ++a)
#pragma unroll
            for (int b = 0; b < 2; ++b)
#pragma unroll
                for (int m = 0; m < 4; ++m)
#pragma unroll
                    for (int n = 0; n < 2; ++n) acc[a][b][m][n] = (f32x4){0.f, 0.f, 0.f, 0.f};
        cur = nxt; cA = nA; cB = nB; ++ui;
        if (wr == 1) PG8_BAR;
    }
    PG8_WAIT_V(0);
    PG8_BAR;
#undef PG8_SA
#undef PG8_SB
#undef PG8_STAGE
#undef PG8_LDA
#undef PG8_LDB
#undef PG8_MMA
#undef PG8_WAIT_V
#undef PG8_WAIT_L
#undef PG8_BAR
#undef PG8_SCHED
}
}

typedef f32x4 AccT[2][2][4][2];
#define EROW(ai, m) (u.pm * 256 + (ai) * 128 + wr * 64 + (m) * 16 + fr)
#define ECOL0 (u.pn * 256 + wc * 32 + 8 * fq)

struct Epi1a { static constexpr bool PERM = true; bf16_t* O; int ldc;
    __device__ __forceinline__ void operator()(const AccT& acc, const pg8::Unit& u, int wr, int wc, int fr, int fq) const {
        const int col0 = ECOL0;
#pragma unroll
        for (int ai = 0; ai < 2; ++ai)
#pragma unroll
            for (int m = 0; m < 4; ++m) { bf16_t* rowp = O + (size_t)EROW(ai, m) * ldc + col0;
#pragma unroll
                for (int bj = 0; bj < 2; ++bj) *(u32x4*)(rowp + bj * 128) = pack8(acc[ai][bj][m][0], acc[ai][bj][m][1]); }
    } };
struct Epi1b { static constexpr bool PERM = true; bf16_t* O;
    __device__ __forceinline__ void operator()(const AccT& acc, const pg8::Unit& u, int wr, int wc, int fr, int fq) const {
        const int col0 = ECOL0; const int pn = u.pn;
        if (pn < 8) {
#pragma unroll
            for (int ai = 0; ai < 2; ++ai)
#pragma unroll
                for (int m = 0; m < 4; ++m) { bf16_t* rowp = O + (size_t)EROW(ai, m) * 6144 + col0;
#pragma unroll
                    for (int bj = 0; bj < 2; ++bj) *(u32x4*)(rowp + bj * 128) = pack8(gelu4(acc[ai][bj][m][0]), gelu4(acc[ai][bj][m][1])); }
        } else {
#pragma unroll
            for (int ai = 0; ai < 2; ++ai)
#pragma unroll
                for (int m = 0; m < 4; ++m) { bf16_t* rowp = O + (size_t)EROW(ai, m) * 6144 + col0;
#pragma unroll
                    for (int bj = 0; bj < 2; ++bj) { f32x4 v0 = acc[ai][bj][m][0], v1 = acc[ai][bj][m][1];
#pragma unroll
                        for (int j = 0; j < 4; ++j) { v0[j] = sigmoidf_(v0[j]); v1[j] = sigmoidf_(v1[j]); }
                        *(u32x4*)(rowp + bj * 128) = pack8(v0, v1); } }
        }
    } };
template <bool ADD> struct Epi4 { static constexpr bool PERM = true; bf16_t* O; const bf16_t* gate;
    __device__ __forceinline__ void operator()(const AccT& acc, const pg8::Unit& u, int wr, int wc, int fr, int fq) const {
        const int col0 = ECOL0;
#pragma unroll
        for (int ai = 0; ai < 2; ++ai) {
            u32x4 gt[4][2], pv[4][2];
#pragma unroll
            for (int m = 0; m < 4; ++m) { const int row = EROW(ai, m);
#pragma unroll
                for (int bj = 0; bj < 2; ++bj) { gt[m][bj] = *(const u32x4*)(gate + (size_t)row * 6144 + col0 + bj * 128); if (ADD) pv[m][bj] = *(const u32x4*)(O + (size_t)row * 2048 + col0 + bj * 128); } }
#pragma unroll
            for (int m = 0; m < 4; ++m) { bf16_t* rowp = O + (size_t)EROW(ai, m) * 2048 + col0;
#pragma unroll
                for (int bj = 0; bj < 2; ++bj) { f32x4 g0, g1; unpack8(gt[m][bj], g0, g1);
                    f32x4 v0 = acc[ai][bj][m][0] * g0, v1 = acc[ai][bj][m][1] * g1;
                    if (ADD) { f32x4 p0, p1; unpack8(pv[m][bj], p0, p1); v0 += p0; v1 += p1; }
                    *(u32x4*)(rowp + bj * 128) = pack8(v0, v1); } }
            asm volatile("" ::: "memory"); }
    } };
struct EpiRes { static constexpr bool PERM = true; const float* base; float* X;
    __device__ __forceinline__ void operator()(const AccT& acc, const pg8::Unit& u, int wr, int wc, int fr, int fq) const {
        const int col0 = ECOL0;
#pragma unroll
        for (int ai = 0; ai < 2; ++ai) {
            f32x4 bs[4][2][2];
#pragma unroll
            for (int m = 0; m < 4; ++m) { const size_t off = (size_t)EROW(ai, m) * 2048 + col0;
#pragma unroll
                for (int bj = 0; bj < 2; ++bj) { bs[m][bj][0] = *(const f32x4*)(base + off + bj * 128); bs[m][bj][1] = *(const f32x4*)(base + off + bj * 128 + 4); } }
#pragma unroll
            for (int m = 0; m < 4; ++m) { const size_t off = (size_t)EROW(ai, m) * 2048 + col0;
#pragma unroll
                for (int bj = 0; bj < 2; ++bj) { *(f32x4*)(X + off + bj * 128) = acc[ai][bj][m][0] + bs[m][bj][0]; *(f32x4*)(X + off + bj * 128 + 4) = acc[ai][bj][m][1] + bs[m][bj][1]; } }
            asm volatile("" ::: "memory"); }
    } };
struct Epi7 { static constexpr bool PERM = true; const float* base; float* X; float* ss2; unsigned* cnt; const float* g;
    __device__ __forceinline__ void operator()(AccT& acc, const pg8::Unit& u, int wr, int wc, int fr, int fq) const {
        const int col0 = ECOL0;
#pragma unroll
        for (int ai = 0; ai < 2; ++ai)
#pragma unroll
            for (int mh = 0; mh < 2; ++mh) {
                f32x4 bs[2][2][2];
#pragma unroll
                for (int mm = 0; mm < 2; ++mm) { const size_t off = (size_t)EROW(ai, mh * 2 + mm) * 2048 + col0;
#pragma unroll
                    for (int bj = 0; bj < 2; ++bj) { bs[mm][bj][0] = *(const f32x4*)(base + off + bj * 128); bs[mm][bj][1] = *(const f32x4*)(base + off + bj * 128 + 4); } }
#pragma unroll
                for (int mm = 0; mm < 2; ++mm) { const int m = mh * 2 + mm; const int row = EROW(ai, m); float q = 0.f;
#pragma unroll
                    for (int bj = 0; bj < 2; ++bj) { const f32x4 v0 = acc[ai][bj][m][0] + bs[mm][bj][0], v1 = acc[ai][bj][m][1] + bs[mm][bj][1]; acc[ai][bj][m][0] = v0; acc[ai][bj][m][1] = v1;
                        q += (v0[0] * v0[0] + v0[1] * v0[1]) + (v0[2] * v0[2] + v0[3] * v0[3]) + (v1[0] * v1[0] + v1[1] * v1[1]) + (v1[2] * v1[2] + v1[3] * v1[3]); }
                    q += __shfl_xor(q, 16); q += __shfl_xor(q, 32);
                    if (fq == 0) __hip_atomic_store(ss2 + (size_t)row * 32 + u.pn * 4 + wc, q, __ATOMIC_RELAXED, __HIP_MEMORY_SCOPE_AGENT); }
                asm volatile("" ::: "memory"); }
        asm volatile("s_waitcnt vmcnt(0)" ::: "memory");
        unsigned* cw = cnt + 16 * (u.pm * 2 + wr);
        if ((threadIdx.x & 63) == 0) __hip_atomic_fetch_add(cw, 1u, __ATOMIC_RELAXED, __HIP_MEMORY_SCOPE_AGENT);
        { unsigned spins = 0; while (__hip_atomic_load(cw, __ATOMIC_RELAXED, __HIP_MEMORY_SCOPE_AGENT) < 32u) { __builtin_amdgcn_s_sleep(1); if (++spins > (1u << 22)) break; } }
        f32x4 gv[2][2];
#pragma unroll
        for (int bj = 0; bj < 2; ++bj) { gv[bj][0] = *(const f32x4*)(g + col0 + bj * 128); gv[bj][1] = *(const f32x4*)(g + col0 + bj * 128 + 4); }
#pragma unroll
        for (int ai = 0; ai < 2; ++ai)
#pragma unroll
            for (int m = 0; m < 4; ++m) { const int row = EROW(ai, m); const float* sp = ss2 + (size_t)row * 32 + fq * 8; float pq[8];
#pragma unroll
                for (int k = 0; k < 8; ++k) pq[k] = __hip_atomic_load(sp + k, __ATOMIC_RELAXED, __HIP_MEMORY_SCOPE_AGENT);
                float q = ((pq[0] + pq[1]) + (pq[2] + pq[3])) + ((pq[4] + pq[5]) + (pq[6] + pq[7]));
                q += __shfl_xor(q, 16); q += __shfl_xor(q, 32);
                const float rs = rsqrtf(q * (1.0f / 2048.0f) + EPSV); const size_t off = (size_t)row * 2048 + col0;
#pragma unroll
                for (int bj = 0; bj < 2; ++bj) { *(f32x4*)(X + off + bj * 128) = acc[ai][bj][m][0] * rs * gv[bj][0]; *(f32x4*)(X + off + bj * 128 + 4) = acc[ai][bj][m][1] * rs * gv[bj][1]; } }
    } };
struct Epi5 { static constexpr bool PERM = true; const float* base; float* X; float* ssp; const float* g; bf16_t* Hn;
    __device__ __forceinline__ void operator()(const AccT& acc, const pg8::Unit& u, int wr, int wc, int fr, int fq) const {
        const int col0 = ECOL0;
        f32x4 gv[2][2];
#pragma unroll
        for (int bj = 0; bj < 2; ++bj) { gv[bj][0] = *(const f32x4*)(g + col0 + bj * 128); gv[bj][1] = *(const f32x4*)(g + col0 + bj * 128 + 4); }
#pragma unroll
        for (int ai = 0; ai < 2; ++ai) {
            f32x4 bs[4][2][2];
#pragma unroll
            for (int m = 0; m < 4; ++m) { const size_t off = (size_t)EROW(ai, m) * 2048 + col0;
#pragma unroll
                for (int bj = 0; bj < 2; ++bj) { bs[m][bj][0] = *(const f32x4*)(base + off + bj * 128); bs[m][bj][1] = *(const f32x4*)(base + off + bj * 128 + 4); } }
#pragma unroll
            for (int m = 0; m < 4; ++m) { const int row = EROW(ai, m); const size_t off = (size_t)row * 2048 + col0; float q = 0.f;
#pragma unroll
                for (int bj = 0; bj < 2; ++bj) { const f32x4 v0 = acc[ai][bj][m][0] + bs[m][bj][0], v1 = acc[ai][bj][m][1] + bs[m][bj][1];
                    *(f32x4*)(X + off + bj * 128) = v0; *(f32x4*)(X + off + bj * 128 + 4) = v1;
                    q += (v0[0] * v0[0] + v0[1] * v0[1]) + (v0[2] * v0[2] + v0[3] * v0[3]) + (v1[0] * v1[0] + v1[1] * v1[1]) + (v1[2] * v1[2] + v1[3] * v1[3]);
                    *(u32x4*)(Hn + off + bj * 128) = pack8(v0 * gv[bj][0], v1 * gv[bj][1]); }
                q += __shfl_xor(q, 16); q += __shfl_xor(q, 32);
                if (fq == 0) ssp[(size_t)row * 32 + u.pn * 4 + wc] = q; }
            asm volatile("" ::: "memory"); }
    } };
struct Epi6 { static constexpr bool PERM = true; bf16_t* O; const float* ssp; const LAS float* rsl; int pm0;
    __device__ __forceinline__ void operator()(const AccT& acc, const pg8::Unit& u, int wr, int wc, int fr, int fq) const {
        const int col0 = u.pn * 128 + wc * 32 + 8 * fq;
        float rsv[2][4];
        if (u.pm == pm0) {
#pragma unroll
            for (int ai = 0; ai < 2; ++ai)
#pragma unroll
                for (int m = 0; m < 4; ++m) rsv[ai][m] = rsl[ai * 128 + wr * 64 + m * 16 + fr];
        } else {
#pragma unroll
            for (int ai = 0; ai < 2; ++ai)
#pragma unroll
                for (int m = 0; m < 4; ++m) { const int row = EROW(ai, m);
                    const f32x4 p0 = *(const f32x4*)(ssp + (size_t)row * 32 + fq * 8), p1 = *(const f32x4*)(ssp + (size_t)row * 32 + fq * 8 + 4);
                    float q = ((p0[0] + p0[1]) + (p0[2] + p0[3])) + ((p1[0] + p1[1]) + (p1[2] + p1[3]));
                    q += __shfl_xor(q, 16); q += __shfl_xor(q, 32);
                    rsv[ai][m] = rsqrtf(q * (1.0f / 2048.0f) + EPSV); }
        }
#pragma unroll
        for (int ai = 0; ai < 2; ++ai)
#pragma unroll
            for (int m = 0; m < 4; ++m) { const int row = EROW(ai, m); const float rs = rsv[ai][m];
                f32x4 h0, h1;
#pragma unroll
                for (int j = 0; j < 4; ++j) { const float g0 = acc[ai][0][m][0][j] * rs, u0 = acc[ai][1][m][0][j] * rs, g1 = acc[ai][0][m][1][j] * rs, u1 = acc[ai][1][m][1][j] * rs;
                    h0[j] = g0 * sigmoidf_(g0) * u0; h1[j] = g1 * sigmoidf_(g1) * u1; }
                *(u32x4*)(O + (size_t)row * DFF + col0) = pack8(h0, h1); }
    } };

__device__ __forceinline__ float block_sum(float v, float* red, int tid) {
    for (int o = 32; o >= 1; o >>= 1) v += __shfl_xor(v, o);
    __syncthreads();
    if ((tid & 63) == 0) red[tid >> 6] = v;
    __syncthreads();
    float s = 0.f;
#pragma unroll
    for (int i = 0; i < 8; ++i) s += red[i];
    return s;
}

__device__ __forceinline__ void tr_tile(const float* __restrict__ src, int N, int K, bf16_t* __restrict__ dst, int k0, int n0, int drow0, float* tile, int tid) {
#pragma unroll
    for (int i = 0; i < 2; ++i) { const int kk = (tid >> 4) + i * 32, n4 = (tid & 15) * 4;
        const f32x4 v = *(const f32x4*)(src + (size_t)(k0 + kk) * N + n0 + n4);
        tile[kk * 65 + n4 + 0] = v[0]; tile[kk * 65 + n4 + 1] = v[1]; tile[kk * 65 + n4 + 2] = v[2]; tile[kk * 65 + n4 + 3] = v[3]; }
    __syncthreads();
    const int n = tid >> 3, kg = tid & 7; f32x4 a, b;
#pragma unroll
    for (int j = 0; j < 4; ++j) { a[j] = tile[(kg * 8 + j) * 65 + n]; b[j] = tile[(kg * 8 + 4 + j) * 65 + n]; }
    *(u32x4*)(dst + (size_t)(drow0 + n) * K + k0 + kg * 8) = pack8(a, b);
    __syncthreads();
}

__device__ __forceinline__ float sconv(const bf16_t* __restrict__ row, int b, int s, float w0, float w1, float w2, float bias) {
    const bf16_t* p = row + b * 2048 + s;
    const float c = bf2f(p[0]); const float l = s > 0 ? bf2f(p[-1]) : 0.f; const float r = s < 2047 ? bf2f(p[1]) : 0.f;
    return w0 * l + w1 * c + w2 * r + bias;
}

#define XB_TMO      128
#define XB_XCNT(j)  (256  + 64 * (j))
#define XB_XSUB(j)  (1280 + 64 * (j))
#define XB_XGEN(j)  (2304 + 64 * (j))
#define XB_TOP      3328
#define XB_TOPGEN   3392
#define XCD_BAR_WORDS 3456
#define XB_SPIN_CAP (1u << 22)

__device__ __forceinline__ unsigned xb_ld(unsigned* p)              { return __hip_atomic_load(p, __ATOMIC_RELAXED, __HIP_MEMORY_SCOPE_AGENT); }
__device__ __forceinline__ unsigned xb_add(unsigned* p, unsigned v) { return __hip_atomic_fetch_add(p, v, __ATOMIC_RELAXED, __HIP_MEMORY_SCOPE_AGENT); }
__device__ __forceinline__ unsigned xb_xcc_id() { return (unsigned)__builtin_amdgcn_s_getreg((3 << 11) | 20) & 0xFu; }
#define XB_SPIN(cond, bar) do { unsigned _sp = 0; while (cond) { __builtin_amdgcn_s_sleep(1); \
    if ((++_sp & 255u) == 0u) { if (xb_ld(&(bar)[XB_TMO])) break; if (_sp > XB_SPIN_CAP) { atomicAdd(&(bar)[XB_TMO], 1u); break; } } } } while (0)

struct XcdBarrier {
    unsigned* bar; unsigned x;
    volatile LAS unsigned* st;
};

__device__ __forceinline__ XcdBarrier xcd_barrier_post(unsigned* bar, volatile LAS unsigned* st) {
    XcdBarrier b; b.bar = bar; b.x = xb_xcc_id(); b.st = st;
    if (threadIdx.x == 0) (void)xb_add(&bar[XB_XCNT(b.x)], 1u);
    return b;
}
__device__ __forceinline__ void xcd_barrier_complete(unsigned* bar, unsigned x, unsigned& nloc, unsigned& nx) {
    const unsigned G = gridDim.x * gridDim.y * gridDim.z;
    unsigned sum, cnt, mine, sp = 0u;
    for (;;) {
        sum = 0u; cnt = 0u; mine = 0u;
#pragma unroll
        for (unsigned j = 0; j < 16; ++j) { const unsigned c = xb_ld(&bar[XB_XCNT(j)]); sum += c; cnt += (c > 0u) ? 1u : 0u; mine = (j == x) ? c : mine; }
        if (sum == G) break;
        __builtin_amdgcn_s_sleep(1);
        if ((++sp & 255u) == 0u) { if (xb_ld(&bar[XB_TMO])) break; if (sp > XB_SPIN_CAP) { atomicAdd(&bar[XB_TMO], 1u); break; } }
    }
    nloc = mine > 0u ? mine : 1u; nx = cnt > 0u ? cnt : 1u;
}

__device__ __forceinline__ void xcd_barrier(const XcdBarrier& b) {
    asm volatile("s_waitcnt vmcnt(0)" ::: "memory");
    __syncthreads();
    if (threadIdx.x == 0) {
        unsigned* bar = b.bar;
        __builtin_amdgcn_s_waitcnt(0);
        unsigned nloc = b.st[0], nx = b.st[1];
        if (nloc == 0u) { xcd_barrier_complete(bar, b.x, nloc, nx); b.st[0] = nloc; b.st[1] = nx; }
        const unsigned old = xb_add(&bar[XB_XSUB(b.x)], 1u);
        const unsigned gen = old / nloc;
        if (old + 1u == (gen + 1u) * nloc) {
            __builtin_amdgcn_fence(__ATOMIC_RELEASE, "agent");
            asm volatile("s_waitcnt vmcnt(0)" ::: "memory");
            const unsigned og = xb_add(&bar[XB_TOP], 1u);
            const unsigned tg = og / nx;
            if (og + 1u == (tg + 1u) * nx) xb_add(&bar[XB_TOPGEN], 1u);
            else XB_SPIN(xb_ld(&bar[XB_TOPGEN]) == tg, bar);
            __builtin_amdgcn_fence(__ATOMIC_ACQUIRE, "agent");
            xb_add(&bar[XB_XGEN(b.x)], 1u);
            asm volatile("s_waitcnt vmcnt(0)" ::: "memory");
        } else {
            XB_SPIN(xb_ld(&bar[XB_XGEN(b.x)]) == gen, bar);
            __builtin_amdgcn_fence(__ATOMIC_ACQUIRE, "agent");
            asm volatile("s_waitcnt vmcnt(0)" ::: "memory");
        }
    }
    __syncthreads();
}


__device__ __forceinline__ void my_barrier(unsigned* bar, unsigned target) {
    asm volatile("s_waitcnt vmcnt(0)" ::: "memory");
    __syncthreads();
    if (threadIdx.x == 0) {
        __builtin_amdgcn_fence(__ATOMIC_RELEASE, "agent");
        asm volatile("s_waitcnt vmcnt(0)" ::: "memory");
        __hip_atomic_fetch_add(bar, 1u, __ATOMIC_RELAXED, __HIP_MEMORY_SCOPE_AGENT);
        while (__hip_atomic_load(bar, __ATOMIC_RELAXED, __HIP_MEMORY_SCOPE_AGENT) < target) __builtin_amdgcn_s_sleep(2);
        __builtin_amdgcn_fence(__ATOMIC_ACQUIRE, "agent");
        asm volatile("s_waitcnt vmcnt(0)" ::: "memory");
    }
    __syncthreads();
}

template <bool TOBF> __device__ __forceinline__ void rmsnorm_rows(const float* x, const float* __restrict__ g, bf16_t* ob, float* of, int bid, int G, int wave, int lane) {
    for (int row = bid * 8 + wave; row < NTOK; row += G * 8) {
        const float* xr = x + (size_t)row * DM; f32x4 v[8]; float q = 0.f;
#pragma unroll
        for (int i = 0; i < 8; ++i) { v[i] = *(const f32x4*)(xr + lane * 4 + i * 256); q += (v[i][0] * v[i][0] + v[i][1] * v[i][1]) + (v[i][2] * v[i][2] + v[i][3] * v[i][3]); }
        for (int o = 32; o >= 1; o >>= 1) q += __shfl_xor(q, o);
        const float rs = rsqrtf(q * (1.0f / 2048.0f) + EPSV);
#pragma unroll
        for (int i = 0; i < 8; ++i) { const f32x4 gg = *(const f32x4*)(g + lane * 4 + i * 256); const f32x4 y = v[i] * rs * gg;
            if (TOBF) { u32x2 w; w.x = cvt_pk_bf16(y[0], y[1]); w.y = cvt_pk_bf16(y[2], y[3]); *(u32x2*)(ob + (size_t)row * DM + lane * 4 + i * 256) = w; }
            else *(f32x4*)(of + (size_t)row * DM + lane * 4 + i * 256) = y; }
    }
}


#ifdef SELFCHK
__device__ __forceinline__ unsigned hsh(unsigned x) { x ^= x >> 16; x *= 0x7feb352du; x ^= x >> 15; x *= 0x846ca68bu; x ^= x >> 16; return x; }
__device__ __forceinline__ float wdot(const bf16_t* a, const bf16_t* b, int K, int lane) { float s = 0.f; for (int k = lane; k < K; k += 64) s += bf2f(a[k]) * bf2f(b[k]); for (int o = 32; o >= 1; o >>= 1) s += __shfl_xor(s, o); return s; }
__device__ __forceinline__ void chk_flag(unsigned* flags, bool bad, unsigned bit) { if (__any(bad) && (threadIdx.x & 63) == 0) atomicOr(flags, bit); }
__device__ __forceinline__ bool far(float got, float ref) { return !(fabsf(got - ref) <= 0.02f * fabsf(ref) + 0.02f); }
#define CHK(...) do { __VA_ARGS__ } while (0)
#else
#define CHK(...) do { } while (0)
#endif

__global__ void __launch_bounds__(NTHR, 2) fwd_megakernel(Params P) {
    extern __shared__ __attribute__((aligned(16))) unsigned char smem[];
    cg::grid_group grid = cg::this_grid();
    const int tid = threadIdx.x, lane = tid & 63, wave = tid >> 6;
    const int G = gridDim.x, bid = blockIdx.x;
    unsigned char* ws = P.ws;
    LAS unsigned char* lds = (LAS unsigned char*)smem;
    const int lo = P.lo, hi = P.hi;
#define IN(k) (lo <= (k) && (k) < hi)
#define SEAM(k) do { if ((k) + 1 < hi) { if (lo > (k) + 1000) grid.sync();   xcd_barrier(xb); } } while (0)

    { volatile LAS unsigned* stw = (volatile LAS unsigned*)(lds + 146400); if (tid < 2) stw[tid] = 0u; __syncthreads(); }
    const XcdBarrier xb = xcd_barrier_post((unsigned*)(ws + WS_BAR + 16384), (volatile LAS unsigned*)(lds + 146400));
    float* stats = (float*)(ws + WS_STATS); float* ss1 = (float*)(ws + WS_SS1); float* ss2 = (float*)(ws + WS_SS2); float* h3 = (float*)(ws + WS_H3);
    bf16_t* WinT = (bf16_t*)(ws + W_IN); bf16_t* WbhT = (bf16_t*)(ws + W_BH); bf16_t* WbsT = (bf16_t*)(ws + W_BS); bf16_t* WoutT = (bf16_t*)(ws + W_OUT);
    bf16_t* WfiT = (bf16_t*)(ws + W_FI); bf16_t* WfoT = (bf16_t*)(ws + W_FO);
    bf16_t* Hn = (bf16_t*)(ws + WS_R2); bf16_t* Yhy = (bf16_t*)(ws + WS_R2); bf16_t* Ysgu = (bf16_t*)(ws + WS_R2 + 33554432);
    bf16_t* PT = (bf16_t*)(ws + R3_PT); bf16_t* PROJ2 = (bf16_t*)(ws + R3_PROJ2); bf16_t* MERGED = (bf16_t*)(ws + R3_MERGED); bf16_t* H2 = (bf16_t*)(ws + R3_H2); bf16_t* HID = (bf16_t*)(ws + R3_HID);
    float* SSP = (float*)(ws + WS_R2);
    float* KF = P.out; bf16_t* YT = (bf16_t*)((unsigned char*)P.out + 33554432);

    auto weight_tiles = [&](int t_lo, int t_hi) {
            float* tile = (float*)smem;
            struct TJ { const float* src; bf16_t* dst; int K, N, k0, n0, mode; };
            auto decode = [&](int ti, TJ& j) {
                int li, ntl; j.mode = 0;
                if (ti < 1152) { j.src = P.in[2]; j.dst = WinT; j.K = 2048; j.N = 9216; li = ti; ntl = 36; }
                else if (ti < 1280) { j.src = P.in[18]; j.dst = WbhT; j.K = 1024; j.N = 2048; li = ti - 1152; ntl = 8; }
                else if (ti < 1408) { j.src = P.in[19]; j.dst = WbsT; j.K = 1024; j.N = 2048; li = ti - 1280; ntl = 8; }
                else if (ti < 1664) { j.src = P.in[20]; j.dst = WoutT; j.K = 2048; j.N = 2048; li = ti - 1408; ntl = 8; }
                else if (ti < 3072) { j.src = P.in[22]; j.dst = WfiT; j.K = 2048; j.N = 11264; li = ti - 1664; ntl = 44; j.mode = 1; }
                else { j.src = P.in[23]; j.dst = WfoT; j.K = 5632; j.N = 2048; li = ti - 3072; ntl = 8; }
                j.k0 = (li / ntl) * 64; j.n0 = (li % ntl) * 256; };
            f32x4 v[8]; TJ cur, nxt; int ti = t_lo + bid; bool have = ti < t_hi;
            if (have) { decode(ti, cur);
#pragma unroll
                for (int i = 0; i < 8; ++i) { const int idx = tid + i * NTHR, kk = idx >> 6, n4 = (idx & 63) * 4; v[i] = *(const f32x4*)(cur.src + (size_t)(cur.k0 + kk) * cur.N + cur.n0 + n4); } }
            while (have) {
#pragma unroll
                for (int i = 0; i < 8; ++i) { const int idx = tid + i * NTHR, kk = idx >> 6, n4 = (idx & 63) * 4; *(f32x4*)(tile + kk * 260 + (n4 ^ (((kk >> 3) & 7) << 2))) = v[i]; }
                __syncthreads();
                const int nti = ti + G; const bool hn = nti < t_hi;
                if (hn) { decode(nti, nxt);
#pragma unroll
                    for (int i = 0; i < 8; ++i) { const int idx = tid + i * NTHR, kk = idx >> 6, n4 = (idx & 63) * 4; v[i] = *(const f32x4*)(nxt.src + (size_t)(nxt.k0 + kk) * nxt.N + nxt.n0 + n4); } }
#pragma unroll
                for (int i = 0; i < 4; ++i) { const int item = tid + i * NTHR, n = item >> 3, kg = item & 7; f32x4 a, b;
#pragma unroll
                    for (int j = 0; j < 4; ++j) { a[j] = tile[(kg * 8 + j) * 260 + (n ^ (kg << 2))]; b[j] = tile[(kg * 8 + 4 + j) * 260 + (n ^ (kg << 2))]; }
                    int drow = cur.n0 + n;
                    if (cur.mode == 1) { const int up = drow >= DFF; const int jj = up ? drow - DFF : drow; drow = 256 * (jj >> 7) + (up ? 128 : 0) + (jj & 127); }
                    *(u32x4*)(cur.dst + (size_t)drow * cur.K + cur.k0 + kg * 8) = pack8(a, b); }
                __syncthreads();
                ti = nti; have = hn; cur = nxt;
            }
        __syncthreads();
    };
    if (((PHASE_MASK >> 0) & 1) && IN(0)) {
        weight_tiles(0, 1152);
        rmsnorm_rows<true>(P.in[0], P.in[1], Hn, nullptr, bid, G, wave, lane);
        {
            float* zf = (float*)smem; float* ha = zf + 8 * 40; float* hb = ha + 8 * 64;
            const float* w1 = P.in[5]; const float* b1 = P.in[6]; const float* w2 = P.in[7]; const float* b2 = P.in[8]; const float* w3 = P.in[9]; const float* b3 = P.in[10]; const float* fq_ = P.in[11];
            for (int pg = bid; pg < 256; pg += G) {
                const int pos = pg * 8 + wave;
                __syncthreads();
                if (lane < 33) {
                    float z;
                    if (lane == 0) z = (float)pos / 2047.0f;
                    else { const int mband = (lane - 1) & 15; const float f = 1e-4f + (float)mband * ((15.0f - 1e-4f) / 15.0f); const float w = (6.2831855f * (float)pos) / 2048.0f; const float a = f * w;
                        z = lane < 17 ? __cosf(a) : -__sinf(a); }
                    zf[wave * 40 + lane] = z;
                }
                __syncthreads();
                const float fr = fq_[lane];
                float a = b1[lane];
#pragma unroll 3
                for (int i = 0; i < 33; ++i) a += zf[wave * 40 + i] * w1[i * 64 + lane];
                ha[wave * 64 + lane] = __sinf(fr * a);
                __syncthreads();
                a = b2[lane];
#pragma unroll 8
                for (int i = 0; i < 64; ++i) a += ha[wave * 64 + i] * w2[i * 64 + lane];
                hb[wave * 64 + lane] = __sinf(fr * a);
                __syncthreads();
                a = b3[lane];
#pragma unroll 8
                for (int i = 0; i < 64; ++i) a += hb[wave * 64 + i] * w3[i * 64 + lane];
                h3[pos * 64 + lane] = __sinf(fr * a);
            }
            __syncthreads();
        }
        SEAM(0);
    }

    if (((PHASE_MASK >> 1) & 1) && IN(1)) {
        CHK(
            { const unsigned sid = bid * 8 + wave; unsigned* flags = (unsigned*)(ws + WS_BAR + 64); bool bad = false;
              { const int n = hsh(sid * 7 + 1) % 9216, k = (hsh(sid * 7 + 2) + lane) % 2048; bad |= WinT[(size_t)n * 2048 + k] != f2bf(P.in[2][(size_t)k * 9216 + n]); }
              { const int j = hsh(sid * 7 + 3) % 5632, k = (hsh(sid * 7 + 4) + lane) % 2048; const int rg = 256 * (j >> 7) + (j & 127);
                bad |= WfiT[(size_t)rg * 2048 + k] != f2bf(P.in[22][(size_t)k * 11264 + j]); bad |= WfiT[(size_t)(rg + 128) * 2048 + k] != f2bf(P.in[22][(size_t)k * 11264 + 5632 + j]); }
              { const int n = hsh(sid * 7 + 5) % 2048, k = (hsh(sid * 7 + 6) + lane) % 5632; bad |= WfoT[(size_t)n * 5632 + k] != f2bf(P.in[23][(size_t)k * 2048 + n]); }
              { const int n = hsh(sid * 7 + 5) % 2048, k = (hsh(sid * 7 + 6) + lane) % 1024; bad |= WbhT[(size_t)n * 1024 + k] != f2bf(P.in[18][(size_t)k * 2048 + n]); bad |= WbsT[(size_t)n * 1024 + k] != f2bf(P.in[19][(size_t)k * 2048 + n]); }
              { const int n = hsh(sid * 7 + 5) % 2048, k = (hsh(sid * 7 + 6) + lane) % 2048; bad |= WoutT[(size_t)n * 2048 + k] != f2bf(P.in[20][(size_t)k * 2048 + n]); }
              chk_flag(flags, bad, 1u); }
        );
        {
            const float* w4 = P.in[12]; float* Wl = (float*)smem;
            for (int cb = bid; cb < 256; cb += G) {
                __syncthreads();
                for (int idx = tid; idx < 1024; idx += NTHR) { const int cc = idx & 15, j = idx >> 4; Wl[cc * 64 + j] = w4[(size_t)j * 4096 + cb * 16 + cc]; }
                __syncthreads();
                for (int pp2 = 0; pp2 < 2; ++pp2) {
                    const int pos0 = (wave * 4 + pp2 * 2) * 64 + lane, pos1 = pos0 + 64;
                    float h0[64], h1[64];
#pragma unroll
                    for (int j4 = 0; j4 < 16; ++j4) { const f32x4 t0 = *(const f32x4*)(h3 + pos0 * 64 + j4 * 4), t1 = *(const f32x4*)(h3 + pos1 * 64 + j4 * 4);
#pragma unroll
                        for (int k = 0; k < 4; ++k) { h0[j4 * 4 + k] = t0[k]; h1[j4 * 4 + k] = t1[k]; } }
                    const float tt0 = (float)pos0 / 2047.0f, tt1 = (float)pos1 / 2047.0f;
                    for (int cc = 0; cc < 16; ++cc) {
                        const int col = cb * 16 + cc; const int dir = col >> 11, o = (col >> 10) & 1, c = col & 1023;
                        float a0 = 0.f, a1 = 0.f;
#pragma unroll
                        for (int j4 = 0; j4 < 16; ++j4) { const f32x4 w = *(const f32x4*)(Wl + cc * 64 + j4 * 4);
#pragma unroll
                            for (int k = 0; k < 4; ++k) { a0 += h0[j4 * 4 + k] * w[k]; a1 += h1[j4 * 4 + k] * w[k]; } }
                        const float ad = 3.0701134573f + (float)c * ((15.3505672866f - 3.0701134573f) / 1023.0f);
                        const float v0 = a0 * __expf(-tt0 * ad), v1 = a1 * __expf(-tt1 * ad);
                        float* kr = KF + (size_t)(o * 1024 + c) * 4096;
                        if (dir == 0) { kr[2048 + pos0] = v0; kr[2048 + pos1] = v1; }
                        else { if (pos0 >= 1) kr[2048 - pos0] = v0; else kr[0] = 0.f; kr[2048 - pos1] = v1; }
                    }
                }
            }
            __syncthreads();
        }
        {
            pg8::Gemm g{WinT, Hn, 3072, NTOK, DM}; pg8::StaticOrder S; S.init(3072, NTOK, G, bid);
            Epi1a E{PT, NTOK}; pg8::gemm_phase<Epi1a>(lds, g, S, E);
        }
        {
            pg8::Gemm g{Hn, WinT + (size_t)3072 * DM, NTOK, 6144, DM}; pg8::StaticOrder S; S.init(NTOK, 6144, G, bid);
            Epi1b E{PROJ2}; pg8::gemm_phase<Epi1b>(lds, g, S, E);
        }
        SEAM(1);
    }

    if (((PHASE_MASK >> 2) & 1) && IN(2)) {
        CHK(
            { const unsigned sid = bid * 8 + wave; unsigned* flags = (unsigned*)(ws + WS_BAR + 64);
              { const int ch = hsh(sid * 5 + 11) % 3072, tok = hsh(sid * 5 + 12) % 8192; const float ref = wdot(WinT + (size_t)ch * 2048, Hn + (size_t)tok * 2048, 2048, lane);
                chk_flag(flags, far(bf2f(PT[(size_t)ch * NTOK + tok]), ref), 2u); }
              { const int col = hsh(sid * 5 + 13) % 6144, tok = hsh(sid * 5 + 14) % 8192; const float r0 = wdot(Hn + (size_t)tok * 2048, WinT + (size_t)(3072 + col) * 2048, 2048, lane);
                const float ref = col < 2048 ? 0.5f * r0 * (1.0f + erff(r0 * 0.70710678f)) : 1.0f / (1.0f + expf(-r0));
                chk_flag(flags, far(bf2f(PROJ2[(size_t)tok * 6144 + col]), ref), 4u); } }
        );
        if (bid & 1) weight_tiles(1152, 3776);
        {
            unsigned char* Z1 = smem;
            unsigned char* Z2 = smem + 34816;
            unsigned char* KS = smem + 69632;
            bf16_t* KR = (bf16_t*)(smem + 137472);
            float* red = (float*)(smem + 145696);
            const float* scw = P.in[3]; const float* scb = P.in[4]; const float* hbias = P.in[13];
            for (int i = tid; i < 1024; i += NTHR) { const int buf = i >> 9, w = i & 511; const int off = (w < 256 ? 0 : 66 * 512 - 1024) + w * 4; *(unsigned*)((buf ? Z2 : Z1) + off) = 0u; }
            const int pp = wave & 1, gg = wave >> 1, li = lane & 15, lq = lane >> 4, bb = li & 7, jsel = li >> 3;
            const unsigned boff = (unsigned)(jsel * 512 + bb * 64 + ((lq ^ ((bb >> 2) << 1)) * 16));
            const int rcp_ = 7 - (li & 7); const int ksl = rcp_ * 8448 + 48 * (rcp_ & 3) + 2 * (2040 - 16 * pp - 8 * (li >> 3) + 8 * lq);
            float kv[8];
            if (bid < DH) { const float* kr0 = KF + (size_t)bid * 4096;
#pragma unroll
                for (int j = 0; j < 8; ++j) kv[j] = kr0[tid + j * NTHR]; }
            for (int c = bid; c < DH; c += G) {
                __syncthreads();
                {   const float w0 = scw[c], w1 = scw[3072 + c], w2 = scw[6144 + c], bs = scb[c];
                    for (int ch = tid; ch < 2048; ch += NTHR) { const int b = ch >> 8, s = (ch & 255) * 8; const bf16_t* src = PT + (size_t)c * NTOK + b * 2048 + s;
                        f32x4 fa, fb; unpack8(*(const u32x4*)src, fa, fb); const float fl = s > 0 ? bf2f(src[-1]) : 0.f, fr_ = s + 8 < 2048 ? bf2f(src[8]) : 0.f;
                        f32x4 oa, ob;
                        oa[0] = w0 * fl + w1 * fa[0] + w2 * fa[1] + bs; oa[1] = w0 * fa[0] + w1 * fa[1] + w2 * fa[2] + bs; oa[2] = w0 * fa[1] + w1 * fa[2] + w2 * fa[3] + bs; oa[3] = w0 * fa[2] + w1 * fa[3] + w2 * fb[0] + bs;
                        ob[0] = w0 * fa[3] + w1 * fb[0] + w2 * fb[1] + bs; ob[1] = w0 * fb[0] + w1 * fb[1] + w2 * fb[2] + bs; ob[2] = w0 * fb[1] + w1 * fb[2] + w2 * fb[3] + bs; ob[3] = w0 * fb[2] + w1 * fb[3] + w2 * fr_ + bs;
                        const int J = s >> 5, chunk = (s & 31) >> 3;
                        *(u32x4*)(Z1 + ((J + 2) * 8 + b) * 64 + ((chunk ^ ((b >> 2) << 1)) * 16)) = pack8(oa, ob); } }
                for (int o = 0; o < 2; ++o) {
                    float part = 0.f;
#pragma unroll
                    for (int j = 0; j < 8; ++j) { part += fabsf(kv[j]); KR[4095 - (tid + j * NTHR)] = f2bf(kv[j]); }
                    if (tid < 8) KR[4096 + tid] = 0;
                    const float scale = 1.0f / block_sum(part, red, tid);
                    {   const u32x4 c0 = *(const u32x4*)(KR + tid * 8), c1 = *(const u32x4*)(KR + tid * 8 + 8);
                        const unsigned D[8] = {c0.x, c0.y, c0.z, c0.w, c1.x, c1.y, c1.z, c1.w};
#pragma unroll
                        for (int r = 0; r < 8; ++r) { u32x4 w; const int sft = r >> 1;
                            if (r & 1) { w.x = __builtin_amdgcn_alignbit(D[sft + 1], D[sft], 16); w.y = __builtin_amdgcn_alignbit(D[sft + 2], D[sft + 1], 16); w.z = __builtin_amdgcn_alignbit(D[sft + 3], D[sft + 2], 16); w.w = __builtin_amdgcn_alignbit(D[sft + 4], D[sft + 3], 16); }
                            else { w.x = D[sft]; w.y = D[sft + 1]; w.z = D[sft + 2]; w.w = D[sft + 3]; }
                            *(u32x4*)(KS + r * 8448 + 48 * (r & 3) + tid * 16) = w; } }
                    __syncthreads();
                    {
                        const int nc = o == 0 ? c : c + G, no = o == 0 ? 1 : 0;
                        if (nc < DH) { const float* krn = KF + (size_t)(no * 1024 + nc) * 4096;
#pragma unroll
                            for (int j = 0; j < 8; ++j) kv[j] = krn[tid + j * NTHR]; } }
                    const unsigned char* Zin = o ? Z2 : Z1;
                    const int chx = (o == 0 ? 1024 : 2048) + c;
                    u32x2 xwv[8]; unsigned short xlv[8], xrv[8];
#pragma unroll
                    for (int a = 0; a < 8; ++a) { const int I = pp + 2 * (16 * gg + 2 * a + jsel); const int t0 = 16 * I + 4 * lq; const bf16_t* src = PT + (size_t)chx * NTOK + bb * 2048 + t0;
                        xwv[a] = *(const u32x2*)src; xlv[a] = t0 > 0 ? src[-1] : (unsigned short)0; xrv[a] = t0 + 4 < 2048 ? src[4] : (unsigned short)0; }
                    f32x4 acc[8];
#pragma unroll
                    for (int a = 0; a < 8; ++a) acc[a] = (f32x4){0.f, 0.f, 0.f, 0.f};
#define HY_LA(E) (*(const bf16x8*)(KS + ksl - 64 * (E)))
#define HY_LBJ(J0) (*(const bf16x8*)(Zin + (((J0) >= -1 && (J0) <= 63) ? ((J0) + 2) : 0) * 512 + boff))
                    {
                        bf16x8 aE[8], aO[8];
                        const int e0 = 16 * gg - 63;
#pragma unroll
                        for (int a2 = 0; a2 < 8; ++a2) { aE[a2] = HY_LA(e0 + 2 * a2); aO[a2] = HY_LA(e0 + 1 + 2 * a2); }
                        bf16x8 bfe = HY_LBJ(63);
                        for (int ib = 0; ib < 64; ib += 16) {
#pragma unroll
                            for (int k = 0; k < 8; ++k) { const int i = ib + 2 * k;
                                const bf16x8 bfo = HY_LBJ(62 - i);
#pragma unroll
                                for (int a2 = 0; a2 < 8; ++a2) acc[a2] = __builtin_amdgcn_mfma_f32_16x16x32_bf16(aE[(a2 + k) & 7], bfe, acc[a2], 0, 0, 0);
                                aE[k & 7] = HY_LA(e0 + i + 16);
                                bfe = HY_LBJ(61 - i);
#pragma unroll
                                for (int a2 = 0; a2 < 8; ++a2) acc[a2] = __builtin_amdgcn_mfma_f32_16x16x32_bf16(aO[(a2 + k) & 7], bfo, acc[a2], 0, 0, 0);
                                aO[k & 7] = HY_LA(e0 + i + 17);
                            }
                        }
#pragma unroll
                        for (int a2 = 0; a2 < 8; ++a2) acc[a2] = __builtin_amdgcn_mfma_f32_16x16x32_bf16(aE[a2], bfe, acc[a2], 0, 0, 0);
                    }
#undef HY_LA
#undef HY_LBJ
                    const float bo = hbias[o * 1024 + c];
                    const float w0 = scw[chx], w1 = scw[3072 + chx], w2 = scw[6144 + chx], bs = scb[chx];
#pragma unroll
                    for (int a = 0; a < 8; ++a) { const int I = pp + 2 * (16 * gg + 2 * a + jsel); const int t0 = 16 * I + 4 * lq;
                        const int zaddr = ((t0 >> 5) + 2) * 512 + bb * 64 + ((((t0 & 31) >> 3) ^ ((bb >> 2) << 1)) * 16) + (t0 & 7) * 2;
                        const u32x2 zw = *(const u32x2*)(Zin + zaddr);
                        const float z0 = __uint_as_float(zw.x << 16), z1 = __uint_as_float(zw.x & 0xffff0000u), z2 = __uint_as_float(zw.y << 16), z3 = __uint_as_float(zw.y & 0xffff0000u);
                        const u32x2 xw = xwv[a];
                        const float x0 = __uint_as_float(xw.x << 16), x1 = __uint_as_float(xw.x & 0xffff0000u), x2 = __uint_as_float(xw.y << 16), x3 = __uint_as_float(xw.y & 0xffff0000u);
                        const float xl = bf2f(xlv[a]), xr = bf2f(xrv[a]);
                        const float r0 = (w0 * xl + w1 * x0 + w2 * x1 + bs) * (acc[a][0] * scale + z0 * bo), r1 = (w0 * x0 + w1 * x1 + w2 * x2 + bs) * (acc[a][1] * scale + z1 * bo);
                        const float r2 = (w0 * x1 + w1 * x2 + w2 * x3 + bs) * (acc[a][2] * scale + z2 * bo), r3 = (w0 * x2 + w1 * x3 + w2 * xr + bs) * (acc[a][3] * scale + z3 * bo);
                        u32x2 w; w.x = cvt_pk_bf16(r0, r1); w.y = cvt_pk_bf16(r2, r3);
                        if (o == 0) *(u32x2*)(Z2 + zaddr) = w; else *(u32x2*)(YT + (size_t)c * NTOK + bb * 2048 + t0) = w; }
                    __syncthreads();
                }
            }
        }
        {
            bf16_t* Wl = (bf16_t*)smem;
            bf16_t* Vl = (bf16_t*)(smem + 36864);
            float* stl = (float*)(smem + 73728);
            const float* lng = P.in[14]; const float* lnb = P.in[15]; const float* w_s = P.in[16]; const float* b_s = P.in[17];
            const int li = lane & 15, lq = lane >> 4;
            for (int item = bid; item < 256; item += G) {
              const int bn = item >> 1, tok0 = bn * 128;
              __syncthreads();
              for (int qb = 0; qb < 4; ++qb) {
                  u32x4 raw[4][2];
#pragma unroll
                  for (int k = 0; k < 4; ++k) { const bf16_t* vp = PROJ2 + (size_t)(tok0 + wave * 16 + qb * 4 + k) * 6144 + 1024 + lane * 16; raw[k][0] = *(const u32x4*)vp; raw[k][1] = *(const u32x4*)(vp + 8); }
#pragma unroll
                  for (int k = 0; k < 4; ++k) { const int q = wave * 16 + qb * 4 + k;
                      f32x4 a0, a1, a2, a3; unpack8(raw[k][0], a0, a1); unpack8(raw[k][1], a2, a3);
                      float sm = 0.f, sq = 0.f;
#pragma unroll
                      for (int j = 0; j < 4; ++j) { sm += (a0[j] + a1[j]) + (a2[j] + a3[j]); sq += (a0[j] * a0[j] + a1[j] * a1[j]) + (a2[j] * a2[j] + a3[j] * a3[j]); }
                      for (int o = 32; o >= 1; o >>= 1) { sm += __shfl_xor(sm, o); sq += __shfl_xor(sq, o); }
                      if (lane == 0) { const float mean = sm * (1.0f / 1024.0f); const float var = sq * (1.0f / 1024.0f) - mean * mean; stl[2 * q] = mean; stl[2 * q + 1] = rsqrtf(var + EPSV); } }
              }
              for (int hh = 0; hh < 4; ++hh) {
                const int h = (item & 1) * 4 + hh;
                __syncthreads();
                for (int ch = tid; ch < 2048; ch += NTHR) {
                    { const int p = ch >> 4, q8 = (ch & 15) * 8; const float* wp = w_s + (size_t)h * 16384 + p * 128 + q8;
                      *(u32x4*)(Wl + p * 144 + q8) = pack8(*(const f32x4*)wp, *(const f32x4*)(wp + 4)); }
                    { const int q = ch >> 4, c8 = (ch & 15) * 8; const float sm = stl[2 * q], rstd = stl[2 * q + 1];
                      f32x4 va, vb; unpack8(*(const u32x4*)(PROJ2 + (size_t)(tok0 + q) * 6144 + 1024 + h * 128 + c8), va, vb);
                      const f32x4 ga = *(const f32x4*)(lng + h * 128 + c8), gb = *(const f32x4*)(lng + h * 128 + c8 + 4), ba = *(const f32x4*)(lnb + h * 128 + c8), bb_ = *(const f32x4*)(lnb + h * 128 + c8 + 4);
                      va = (va - sm) * rstd * ga + ba; vb = (vb - sm) * rstd * gb + bb_;
#pragma unroll
                      for (int j = 0; j < 4; ++j) { Vl[(c8 + j) * 144 + q] = f2bf(va[j]); Vl[(c8 + 4 + j) * 144 + q] = f2bf(vb[j]); } }
                }
                __syncthreads();
                f32x4 acc[8];
#pragma unroll
                for (int ct = 0; ct < 8; ++ct) acc[ct] = (f32x4){0.f, 0.f, 0.f, 0.f};
#pragma unroll
                for (int kk = 0; kk < 4; ++kk) { const bf16x8 wf = *(const bf16x8*)(Wl + (wave * 16 + li) * 144 + kk * 32 + lq * 8);
#pragma unroll
                    for (int ct = 0; ct < 8; ++ct) { const bf16x8 vf = *(const bf16x8*)(Vl + (ct * 16 + li) * 144 + kk * 32 + lq * 8);
                        acc[ct] = __builtin_amdgcn_mfma_f32_16x16x32_bf16(vf, wf, acc[ct], 0, 0, 0); } }
                {   const int p = wave * 16 + li, tok = tok0 + p; const float bs = b_s[h * 128 + p];
#pragma unroll
                    for (int ct = 0; ct < 8; ++ct) { const int cc = h * 128 + ct * 16 + lq * 4; const u32x2 uw = *(const u32x2*)(PROJ2 + (size_t)tok * 6144 + cc);
                        const float u0 = __uint_as_float(uw.x << 16), u1 = __uint_as_float(uw.x & 0xffff0000u), u2 = __uint_as_float(uw.y << 16), u3 = __uint_as_float(uw.y & 0xffff0000u);
                        u32x2 w; w.x = cvt_pk_bf16(u0 * (acc[ct][0] + bs), u1 * (acc[ct][1] + bs)); w.y = cvt_pk_bf16(u2 * (acc[ct][2] + bs), u3 * (acc[ct][3] + bs));
                        *(u32x2*)(Ysgu + (size_t)tok * 1024 + cc) = w; } }
              }
            }
            __syncthreads();
        }
        if (!(bid & 1)) weight_tiles(1152, 3776);
        SEAM(2);
    }

    if (((PHASE_MASK >> 3) & 1) && IN(3)) {
        auto ytrans = [&]() {
        bf16_t* tile = (bf16_t*)smem;
        u32x4 v[4]; int ti = bid; bool have = ti < 1024;
        if (have) { const int c0 = (ti & 15) * 64, t0 = (ti >> 4) * 256;
#pragma unroll
            for (int i = 0; i < 4; ++i) { const int idx = tid + i * NTHR, cr = idx >> 5, tg = idx & 31; v[i] = *(const u32x4*)(YT + (size_t)(c0 + cr) * NTOK + t0 + tg * 8); } }
        while (have) {
            const int c0 = (ti & 15) * 64, t0 = (ti >> 4) * 256;
#pragma unroll
            for (int i = 0; i < 4; ++i) { const int idx = tid + i * NTHR, cr = idx >> 5, tg = idx & 31; *(u32x4*)(tile + cr * 264 + tg * 8) = v[i]; }
            __syncthreads();
            const int nti = ti + G; const bool hn = nti < 1024;
            if (hn) { const int nc0 = (nti & 15) * 64, nt0 = (nti >> 4) * 256;
#pragma unroll
                for (int i = 0; i < 4; ++i) { const int idx = tid + i * NTHR, cr = idx >> 5, tg = idx & 31; v[i] = *(const u32x4*)(YT + (size_t)(nc0 + cr) * NTOK + nt0 + tg * 8); } }
#pragma unroll
            for (int i = 0; i < 4; ++i) { const int item = tid + i * NTHR, tr = item >> 3, cg8 = item & 7; unsigned short e[8];
#pragma unroll
                for (int j = 0; j < 8; ++j) e[j] = tile[(cg8 * 8 + j) * 264 + tr];
                u32x4 w; w.x = e[0] | ((unsigned)e[1] << 16); w.y = e[2] | ((unsigned)e[3] << 16); w.z = e[4] | ((unsigned)e[5] << 16); w.w = e[6] | ((unsigned)e[7] << 16);
                *(u32x4*)(Yhy + (size_t)(t0 + tr) * 1024 + c0 + cg8 * 8) = w; }
            __syncthreads();
            ti = nti; have = hn;
        }
        };
        if (bid & 1) ytrans();
        {   pg8::Gemm g{Ysgu, WbsT, NTOK, DM, DH}; pg8::StaticOrder S; S.init(NTOK, DM, G, bid);
            Epi4<false> E{MERGED, PROJ2 + 4096}; pg8::gemm_phase<Epi4<false>>(lds, g, S, E); }
        if (!(bid & 1)) ytrans();
        SEAM(3);
    }
#ifdef DBG_CUT3
    {
        for (size_t i = (size_t)bid * NTHR + tid; i < (size_t)NTOK * 2048; i += (size_t)G * NTHR) { const int row = (int)(i >> 11), c = (int)(i & 2047);
            P.out[i] = c < 1024 ? bf2f(Yhy[(size_t)row * 1024 + c]) : bf2f(Ysgu[(size_t)row * 1024 + c - 1024]); }
        return;
    }
#endif
    if (((PHASE_MASK >> 4) & 1) && IN(4)) {
        {   pg8::Gemm g{Yhy, WbhT, NTOK, DM, DH}; pg8::StaticOrder S; S.init(NTOK, DM, G, bid);
            Epi4<true> E{MERGED, PROJ2 + 2048}; pg8::gemm_phase<Epi4<true>>(lds, g, S, E); }
        SEAM(4);
    }

    if (((PHASE_MASK >> 5) & 1) && IN(5)) {
        pg8::Gemm g{MERGED, WoutT, NTOK, DM, DM}; pg8::StaticOrder S; S.init(NTOK, DM, G, bid);
        Epi5 E{P.in[0], P.out, SSP, P.in[21], H2}; pg8::gemm_phase<Epi5>(lds, g, S, E);
        SEAM(5);
    }
    if (((PHASE_MASK >> 6) & 1) && IN(6)) {
        pg8::Gemm g{H2, WfiT, NTOK, 2 * DFF, DM}; pg8::StaticOrder S; S.init(NTOK, 2 * DFF, G, bid);
        pg8::Unit u0; S.next(0, u0);
        {   float* rst = (float*)(smem + 131072);
            for (int r = tid; r < 256; r += NTHR) { const float* sp = SSP + (size_t)(u0.pm * 256 + r) * 32; float q4[4];
#pragma unroll
                for (int k = 0; k < 4; ++k) { const f32x4 p0 = *(const f32x4*)(sp + k * 8), p1 = *(const f32x4*)(sp + k * 8 + 4); q4[k] = ((p0[0] + p0[1]) + (p0[2] + p0[3])) + ((p1[0] + p1[1]) + (p1[2] + p1[3])); }
                rst[r] = rsqrtf(((q4[0] + q4[1]) + (q4[2] + q4[3])) * (1.0f / 2048.0f) + EPSV); }
            __syncthreads(); }
        Epi6 E{HID, SSP, (const LAS float*)(smem + 131072), u0.pm}; pg8::gemm_phase<Epi6>(lds, g, S, E);
        SEAM(6);
    }
    const bool fuse78 = (G == 256);
    if (((PHASE_MASK >> 7) & 1) && IN(7)) {
        pg8::Gemm g{HID, WfoT, NTOK, DM, DFF}; pg8::StaticOrder S; S.init(NTOK, DM, G, bid);
        if (fuse78) { S.rowmode = 1; Epi7 E{P.out, P.out, (float*)(ws + WS_R2 + 4194304), (unsigned*)(ws + WS_BAR + 1024), P.in[24]}; pg8::gemm_phase<Epi7>(lds, g, S, E); }
        else { EpiRes E{P.out, P.out}; pg8::gemm_phase<EpiRes>(lds, g, S, E); SEAM(7); }
    }
    if (((PHASE_MASK >> 8) & 1) && IN(8) && !fuse78) {
        rmsnorm_rows<false>(P.out, P.in[24], nullptr, P.out, bid, G, wave, lane);
    }
#undef IN
#undef SEAM
}

extern "C" void kernel_launch(void* const* d_in, const int* in_sizes, int n_in, void* d_out, int out_size, void* d_ws, size_t ws_size, hipStream_t stream) {
    static int grid_blocks = 0;
    if (grid_blocks == 0) {
        if (n_in != 25 || out_size != NTOK * DM || ws_size < WS_END) { fprintf(stderr, "kernel_launch: unexpected shapes n_in %d out %d ws %zu (need %zu)\n", n_in, out_size, ws_size, (size_t)WS_END); grid_blocks = -1; return; }
        int dev = 0, cus = 0, per_cu = 0;
        hipGetDevice(&dev);
        hipDeviceGetAttribute(&cus, hipDeviceAttributeMultiprocessorCount, dev);
        if (hipFuncSetAttribute((const void*)fwd_megakernel, hipFuncAttributeMaxDynamicSharedMemorySize, LDS_BYTES) != hipSuccess) { fprintf(stderr, "kernel_launch: hipFuncSetAttribute failed\n"); grid_blocks = -1; return; }
        if (hipOccupancyMaxActiveBlocksPerMultiprocessor(&per_cu, (const void*)fwd_megakernel, NTHR, LDS_BYTES) != hipSuccess || per_cu < 1) { fprintf(stderr, "kernel_launch: occupancy query gave %d\n", per_cu); per_cu = 1; }
        (void)hipGetLastError();
        grid_blocks = cus * per_cu;
    }
    if (grid_blocks < 0) return;
    if (hipMemsetAsync((char*)d_ws + WS_BAR, 0, 32768, stream) != hipSuccess) { fprintf(stderr, "kernel_launch: memset failed\n"); return; }
    Params p{};
    for (int i = 0; i < 25; ++i) p.in[i] = (const float*)d_in[i];
    p.out = (float*)d_out; p.ws = (unsigned char*)d_ws; p.lo = 0; p.hi = 9;
    void* args[] = {&p};
    hipError_t e = hipLaunchCooperativeKernel((const void*)fwd_megakernel, dim3(grid_blocks), dim3(NTHR), args, LDS_BYTES, stream);
    if (e != hipSuccess) fprintf(stderr, "cooperative launch failed: %s (grid %d)\n", hipGetErrorString(e), grid_blocks);
}
```

```cpp
#include <hip/hip_runtime.h>
#include <hip/hip_cooperative_groups.h>
#include <cstdio>
namespace cg = cooperative_groups;

#define LAS __attribute__((address_space(3)))
typedef unsigned short bf16_t;
typedef short bf16x8 __attribute__((ext_vector_type(8)));
typedef float f32x4 __attribute__((ext_vector_type(4)));
typedef float f32x2 __attribute__((ext_vector_type(2)));
typedef unsigned u32x4 __attribute__((ext_vector_type(4)));
typedef unsigned u32x2 __attribute__((ext_vector_type(2)));

constexpr int NTOK = 16384, DM = 2048, DH = 1024, DFF = 5632, SEQ = 2048;
constexpr float EPSV = 1e-6f;
constexpr int NTHR = 512;
#ifndef PHASE_MASK
#define PHASE_MASK 0x3ff
#endif
constexpr int LDS_BYTES = 146432;

constexpr size_t WS_STATS = 0;
constexpr size_t WS_SS1 = 131072;
constexpr size_t WS_SS2 = 196608;
constexpr size_t WS_H3 = 262144;
constexpr size_t WS_BAR = 917504;
constexpr size_t WS_W = 1048576;
constexpr size_t W_IN = WS_W;
constexpr size_t W_BH = W_IN + 37748736;
constexpr size_t W_BS = W_BH + 4194304;
constexpr size_t W_OUT = W_BS + 4194304;
constexpr size_t W_FI = W_OUT + 8388608;
constexpr size_t W_FO = W_FI + 46137344;
constexpr size_t WS_R2 = W_FO + 23068672;
constexpr size_t WS_R3 = WS_R2 + 67108864;
constexpr size_t R3_PT = WS_R3;
constexpr size_t R3_PROJ2 = WS_R3 + 100663296;
constexpr size_t R3_MERGED = WS_R3;
constexpr size_t R3_H2 = WS_R3 + 184549376;
constexpr size_t R3_HID = WS_R3;
constexpr size_t WS_END = WS_R3 + 301989888;

struct Params { const float* in[25]; float* out; unsigned char* ws; int lo, hi; };

__device__ __forceinline__ float bf2f(bf16_t b) { return __uint_as_float(((unsigned)b) << 16); }
__device__ __forceinline__ bf16_t f2bf(float f) { unsigned u = __float_as_uint(f); u += 0x7FFFu + ((u >> 16) & 1u); return (bf16_t)(u >> 16); }
typedef __bf16 bf16x2_t __attribute__((ext_vector_type(2)));
__device__ __forceinline__ unsigned cvt_pk_bf16(float lo, float hi) { f32x2 v = {lo, hi}; bf16x2_t b = __builtin_convertvector(v, bf16x2_t); return __builtin_bit_cast(unsigned, b); }
__device__ __forceinline__ u32x4 pack8(f32x4 a, f32x4 b) { u32x4 w; w.x = cvt_pk_bf16(a[0], a[1]); w.y = cvt_pk_bf16(a[2], a[3]); w.z = cvt_pk_bf16(b[0], b[1]); w.w = cvt_pk_bf16(b[2], b[3]); return w; }
__device__ __forceinline__ void unpack8(u32x4 w, f32x4& a, f32x4& b) {
    a[0] = __uint_as_float(w.x << 16); a[1] = __uint_as_float(w.x & 0xffff0000u); a[2] = __uint_as_float(w.y << 16); a[3] = __uint_as_float(w.y & 0xffff0000u);
    b[0] = __uint_as_float(w.z << 16); b[1] = __uint_as_float(w.z & 0xffff0000u); b[2] = __uint_as_float(w.w << 16); b[3] = __uint_as_float(w.w & 0xffff0000u); }
__device__ __forceinline__ float sigmoidf_(float x) { return __builtin_amdgcn_rcpf(1.0f + __expf(-x)); }
__device__ __forceinline__ f32x2 gelu_pk(f32x2 v) {
    const f32x2 av = __builtin_elementwise_abs(v), d = av * 0.2316418882f + 1.0f;
    f32x2 t; t.x = __builtin_amdgcn_rcpf(d.x); t.y = __builtin_amdgcn_rcpf(d.y);
    f32x2 q = t * 0.5307027145f + (-0.7265760135f); q = q * t + 0.7107068705f; q = q * t + (-0.142248368f); q = q * t + 0.127414796f; q = q * t;
    const f32x2 s = (v * v) * (-0.72134752044f);
    f32x2 e; e.x = __builtin_amdgcn_exp2f(s.x); e.y = __builtin_amdgcn_exp2f(s.y);
    const f32x2 m = v * (q * e), r = v - m;
    f32x2 o; o.x = v.x < 0.f ? m.x : r.x; o.y = v.y < 0.f ? m.y : r.y; return o;
}
__device__ __forceinline__ f32x4 gelu4(f32x4 v) { f32x2 a = gelu_pk((f32x2){v[0], v[1]}), b = gelu_pk((f32x2){v[2], v[3]}); return (f32x4){a.x, a.y, b.x, b.y}; }

namespace pg8 {
constexpr int BM = 256, BK = 64, HALF = 128, HTB = HALF * BK * 2, STAGE_BYTES = 8 * HTB, NXCD = 8, WGM = 4;
__host__ __device__ __forceinline__ int lds_byte(int r, int c) { const int st = (r >> 4) * 2 + (c >> 5), rr = r & 15, cc = c & 31, ob = rr * 64 + cc * 2; return st * 1024 + (ob ^ (((ob >> 9) & 1) << 5)); }
__host__ __device__ __forceinline__ void stage_rc(int b, int& R, int& C) { const int st = b / 1024, sb = b % 1024, swz = sb ^ (((sb >> 9) & 1) << 5); R = (st >> 1) * 16 + swz / 64; C = (st & 1) * 32 + (swz % 64) / 2; }
__host__ __device__ __forceinline__ int perm32(int rho) { const int n = rho >> 4, i = rho & 15; return 8 * (i >> 2) + 4 * n + (i & 3); }
struct Unit { int pm, pn; };
struct Gemm { const bf16_t* A; const bf16_t* Bt; int M, N, K; };
struct StaticOrder {
    int nM, nN, nwg, G, c, rowmode;
    __device__ void init(int M, int N, int G_, int c_) { nM = M / BM; nN = N / BM; nwg = nM * nN; G = G_; c = c_; rowmode = 0; }
    __device__ bool next(int i, Unit& u) const {
        const long L = (long)i * G + c; if (L >= nwg) return false;
        if (rowmode) { u.pm = i * 32 + (c & 7) * 4 + (c >> 6); u.pn = (c >> 3) & 7; return true; }
        int wgid = (int)L; { const int q = nwg / NXCD, r = nwg % NXCD, xcd = wgid % NXCD, off = wgid / NXCD; wgid = (xcd < r ? xcd * (q + 1) : r * (q + 1) + (xcd - r) * q) + off; }
        const int nig = WGM * nN, gid = wgid / nig, fm = gid * WGM, gsz = (nM - fm) < WGM ? (nM - fm) : WGM;
        u.pm = fm + ((wgid % nig) % gsz); u.pn = (wgid % nig) / gsz; return true;
    }
};

template <class Epi>
__device__ __forceinline__ void gemm_phase(LAS unsigned char* lds, const Gemm g, const StaticOrder& S, const Epi& E) {
    const int tid = threadIdx.x, wid = __builtin_amdgcn_readfirstlane(tid >> 6), lane = tid & 63, wr = wid >> 2, wc = wid & 3, fr = lane & 15, fq = lane >> 4;
    const int K = g.K, nt = K / BK;
    unsigned voffA[2], voffB[2];
#pragma unroll
    for (int i = 0; i < 2; ++i) { int R, C; stage_rc(tid * 16 + i * 8192, R, C); const int Rb = Epi::PERM ? ((R & ~31) + perm32(R & 31)) : R;
        voffA[i] = (unsigned)(R * K + C) * 2u; voffB[i] = (unsigned)(Rb * K + C) * 2u; }
    const size_t kstep = (size_t)(BK * 2);
    const size_t hstep = (size_t)HALF * K * 2;
    const size_t tstep = 2 * hstep;
    const unsigned ldsw = (unsigned)wid * 1024u;
    const int aoff = lds_byte(wr * 64 + fr, fq * 8), boff = lds_byte(wc * 32 + fr, fq * 8);
#define PG8_SA(b, h) (((b) * 2 + (h)) * HTB)
#define PG8_SB(b, h) ((4 + (b) * 2 + (h)) * HTB)
#define PG8_STAGE(bufoff, gbase, voff) do { _Pragma("unroll") for (int _i = 0; _i < 2; ++_i) \
        __builtin_amdgcn_global_load_lds((const unsigned*)((const char*)(gbase) + (voff)[_i]), (LAS unsigned*)(lds + (bufoff) + ldsw + _i * 8192), 16, 0, 0); } while (0)
#define PG8_LDA(dst, b, h) do { _Pragma("unroll") for (int m = 0; m < 4; ++m) _Pragma("unroll") for (int k = 0; k < 2; ++k) dst[m][k] = *(const LAS bf16x8*)(lds + PG8_SA(b, h) + aoff + m * 2048 + k * 1024); } while (0)
#define PG8_LDB(dst, b, h) do { _Pragma("unroll") for (int n = 0; n < 2; ++n) _Pragma("unroll") for (int k = 0; k < 2; ++k) dst[n][k] = *(const LAS bf16x8*)(lds + PG8_SB(b, h) + boff + n * 2048 + k * 1024); } while (0)
#define PG8_MMA(ai, bj, At, Bt) do { __builtin_amdgcn_s_setprio(1); _Pragma("unroll") for (int m = 0; m < 4; ++m) _Pragma("unroll") for (int n = 0; n < 2; ++n) _Pragma("unroll") for (int k = 0; k < 2; ++k) \
        acc[ai][bj][m][n] = __builtin_amdgcn_mfma_f32_16x16x32_bf16(Bt[n][k], At[m][k], acc[ai][bj][m][n], 0, 0, 0); __builtin_amdgcn_s_setprio(0); } while (0)
#define PG8_WAIT_V(n) asm volatile("s_waitcnt vmcnt(" #n ")" ::: "memory")
#define PG8_WAIT_L(n) asm volatile("s_waitcnt lgkmcnt(" #n ")" ::: "memory")
#define PG8_BAR __builtin_amdgcn_s_barrier()
#define PG8_SCHED __builtin_amdgcn_sched_barrier(0)
    Unit cur, nxt; int ui = 0;
    if (!S.next(0, cur)) return;
    f32x4 acc[2][2][4][2];
#pragma unroll
    for (int a = 0; a < 2; ++a)
#pragma unroll
        for (int b = 0; b < 2; ++b)
#pragma unroll
            for (int m = 0; m < 4; ++m)
#pragma unroll
                for (int n = 0; n < 2; ++n) acc[a][b][m][n] = (f32x4){0.f, 0.f, 0.f, 0.f};
    bf16x8 At[4][2], B0[2][2], B1[2][2];
    const char* cA = (const char*)g.A + (size_t)cur.pm * tstep; const char* cB = (const char*)g.Bt + (size_t)cur.pn * tstep;
    PG8_STAGE(PG8_SB(0, 0), cB, voffB); PG8_STAGE(PG8_SB(0, 1), cB + hstep, voffB); PG8_STAGE(PG8_SA(0, 0), cA, voffA); PG8_STAGE(PG8_SA(0, 1), cA + hstep, voffA);
    if (wr == 1) PG8_BAR;
    PG8_WAIT_V(2); PG8_BAR;
    PG8_STAGE(PG8_SB(1, 0), cB + kstep, voffB); PG8_STAGE(PG8_SA(1, 0), cA + kstep, voffA); PG8_STAGE(PG8_SB(1, 1), cB + hstep + kstep, voffB);
    PG8_WAIT_V(6); PG8_BAR;
    for (;;) {
        const bool has_next = S.next(ui + 1, nxt);
        const char* nA = has_next ? (const char*)g.A + (size_t)nxt.pm * tstep : cA; const char* nB = has_next ? (const char*)g.Bt + (size_t)nxt.pn * tstep : cB;
        for (int t = 0; t < nt; t += 2) {
            const bool last = (t == nt - 2);
            const char* a1 = cA + (size_t)(t + 1) * kstep;
            const char* a2 = last ? nA : cA + (size_t)(t + 2) * kstep; const char* b2 = last ? nB : cB + (size_t)(t + 2) * kstep;
            const char* a3 = a2 + kstep; const char* b3 = b2 + kstep;
            PG8_LDB(B0, 0, 0); PG8_LDB(B1, 0, 1); PG8_SCHED; PG8_LDA(At, 0, 0); PG8_STAGE(PG8_SA(1, 1), a1 + hstep, voffA);
            PG8_WAIT_V(8); PG8_WAIT_L(0); PG8_BAR; PG8_MMA(0, 0, At, B0); PG8_MMA(0, 1, At, B1); PG8_BAR; PG8_SCHED;
            PG8_LDA(At, 0, 1); PG8_STAGE(PG8_SB(0, 0), b2, voffB); PG8_STAGE(PG8_SB(0, 1), b2 + hstep, voffB); PG8_STAGE(PG8_SA(0, 0), a2, voffA);
            PG8_WAIT_V(8); PG8_WAIT_L(0); PG8_BAR; PG8_MMA(1, 0, At, B0); PG8_MMA(1, 1, At, B1); PG8_BAR; PG8_SCHED;
            PG8_LDB(B0, 1, 0); PG8_LDB(B1, 1, 1); PG8_SCHED; PG8_LDA(At, 1, 0); PG8_STAGE(PG8_SA(0, 1), a2 + hstep, voffA);
            PG8_WAIT_V(8); PG8_WAIT_L(0); PG8_BAR; PG8_MMA(0, 0, At, B0); PG8_MMA(0, 1, At, B1); PG8_BAR; PG8_SCHED;
            PG8_LDA(At, 1, 1); PG8_STAGE(PG8_SB(1, 0), b3, voffB); PG8_STAGE(PG8_SB(1, 1), b3 + hstep, voffB); PG8_STAGE(PG8_SA(1, 0), a3, voffA);
            PG8_WAIT_V(8); PG8_WAIT_L(0); PG8_BAR; PG8_MMA(1, 0, At, B0); PG8_MMA(1, 1, At, B1); PG8_BAR; PG8_SCHED;
        }
        if (wr == 0) PG8_BAR;
        E(acc, cur, wr, wc, fr, fq);
        if (!has_next) break;
#pragma unroll
        for (int a = 0; a < 2; ++a)
#pragma unroll
            for (int b = 0; b < 2; ++b)
#pragma unroll
                for (int m = 0; m < 4; ++m)
#pragma unroll
                    for (int n = 0; n < 2; ++n) acc[a][b][m][n] = (f32x4){0.f, 0.f, 0.f, 0.f};
        cur = nxt; cA = nA; cB = nB; ++ui;
        if (wr == 1) PG8_BAR;
    }
    PG8_WAIT_V(0);
    PG8_BAR;
#undef PG8_SA
#undef PG8_SB
#undef PG8_STAGE
#undef PG8_LDA
#undef PG8_LDB
#undef PG8_MMA
#undef PG8_WAIT_V
#undef PG8_WAIT_L
#undef PG8_BAR
#undef PG8_SCHED
}
}

typedef f32x4 AccT[2][2][4][2];
#define EROW(ai, m) (u.pm * 256 + (ai) * 128 + wr * 64 + (m) * 16 + fr)
#define ECOL0 (u.pn * 256 + wc * 32 + 8 * fq)

struct Epi1a { static constexpr bool PERM = true; bf16_t* O; int ldc;
    __device__ __forceinline__ void operator()(const AccT& acc, const pg8::Unit& u, int wr, int wc, int fr, int fq) const {
        const int col0 = ECOL0;
#pragma unroll
        for (int ai = 0; ai < 2; ++ai)
#pragma unroll
            for (int m = 0; m < 4; ++m) { bf16_t* rowp = O + (size_t)EROW(ai, m) * ldc + col0;
#pragma unroll
                for (int bj = 0; bj < 2; ++bj) *(u32x4*)(rowp + bj * 128) = pack8(acc[ai][bj][m][0], acc[ai][bj][m][1]); }
    } };
struct Epi1b { static constexpr bool PERM = true; bf16_t* O;
    __device__ __forceinline__ void operator()(const AccT& acc, const pg8::Unit& u, int wr, int wc, int fr, int fq) const {
        const int col0 = ECOL0; const int pn = u.pn;
        if (pn < 8) {
#pragma unroll
            for (int ai = 0; ai < 2; ++ai)
#pragma unroll
                for (int m = 0; m < 4; ++m) { bf16_t* rowp = O + (size_t)EROW(ai, m) * 6144 + col0;
#pragma unroll
                    for (int bj = 0; bj < 2; ++bj) *(u32x4*)(rowp + bj * 128) = pack8(gelu4(acc[ai][bj][m][0]), gelu4(acc[ai][bj][m][1])); }
        } else {
#pragma unroll
            for (int ai = 0; ai < 2; ++ai)
#pragma unroll
                for (int m = 0; m < 4; ++m) { bf16_t* rowp = O + (size_t)EROW(ai, m) * 6144 + col0;
#pragma unroll
                    for (int bj = 0; bj < 2; ++bj) { f32x4 v0 = acc[ai][bj][m][0], v1 = acc[ai][bj][m][1];
#pragma unroll
                        for (int j = 0; j < 4; ++j) { v0[j] = sigmoidf_(v0[j]); v1[j] = sigmoidf_(v1[j]); }
                        *(u32x4*)(rowp + bj * 128) = pack8(v0, v1); } }
        }
    } };
template <bool ADD> struct Epi4 { static constexpr bool PERM = true; bf16_t* O; const bf16_t* gate;
    __device__ __forceinline__ void operator()(const AccT& acc, const pg8::Unit& u, int wr, int wc, int fr, int fq) const {
        const int col0 = ECOL0;
#pragma unroll
        for (int ai = 0; ai < 2; ++ai) {
            u32x4 gt[4][2], pv[4][2];
#pragma unroll
            for (int m = 0; m < 4; ++m) { const int row = EROW(ai, m);
#pragma unroll
                for (int bj = 0; bj < 2; ++bj) { gt[m][bj] = *(const u32x4*)(gate + (size_t)row * 6144 + col0 + bj * 128); if (ADD) pv[m][bj] = *(const u32x4*)(O + (size_t)row * 2048 + col0 + bj * 128); } }
#pragma unroll
            for (int m = 0; m < 4; ++m) { bf16_t* rowp = O + (size_t)EROW(ai, m) * 2048 + col0;
#pragma unroll
                for (int bj = 0; bj < 2; ++bj) { f32x4 g0, g1; unpack8(gt[m][bj], g0, g1);
                    f32x4 v0 = acc[ai][bj][m][0] * g0, v1 = acc[ai][bj][m][1] * g1;
                    if (ADD) { f32x4 p0, p1; unpack8(pv[m][bj], p0, p1); v0 += p0; v1 += p1; }
                    *(u32x4*)(rowp + bj * 128) = pack8(v0, v1); } }
            asm volatile("" ::: "memory"); }
    } };
struct EpiRes { static constexpr bool PERM = true; const float* base; float* X;
    __device__ __forceinline__ void operator()(const AccT& acc, const pg8::Unit& u, int wr, int wc, int fr, int fq) const {
        const int col0 = ECOL0;
#pragma unroll
        for (int ai = 0; ai < 2; ++ai) {
            f32x4 bs[4][2][2];
#pragma unroll
            for (int m = 0; m < 4; ++m) { const size_t off = (size_t)EROW(ai, m) * 2048 + col0;
#pragma unroll
                for (int bj = 0; bj < 2; ++bj) { bs[m][bj][0] = *(const f32x4*)(base + off + bj * 128); bs[m][bj][1] = *(const f32x4*)(base + off + bj * 128 + 4); } }
#pragma unroll
            for (int m = 0; m < 4; ++m) { const size_t off = (size_t)EROW(ai, m) * 2048 + col0;
#pragma unroll
                for (int bj = 0; bj < 2; ++bj) { *(f32x4*)(X + off + bj * 128) = acc[ai][bj][m][0] + bs[m][bj][0]; *(f32x4*)(X + off + bj * 128 + 4) = acc[ai][bj][m][1] + bs[m][bj][1]; } }
            asm volatile("" ::: "memory"); }
    } };
struct Epi7 { static constexpr bool PERM = true; const float* base; float* X; float* ss2; unsigned* cnt; const float* g;
    __device__ __forceinline__ void operator()(AccT& acc, const pg8::Unit& u, int wr, int wc, int fr, int fq) const {
        const int col0 = ECOL0;
#pragma unroll
        for (int ai = 0; ai < 2; ++ai)
#pragma unroll
            for (int mh = 0; mh < 2; ++mh) {
                f32x4 bs[2][2][2];
#pragma unroll
                for (int mm = 0; mm < 2; ++mm) { const size_t off = (size_t)EROW(ai, mh * 2 + mm) * 2048 + col0;
#pragma unroll
                    for (int bj = 0; bj < 2; ++bj) { bs[mm][bj][0] = *(const f32x4*)(base + off + bj * 128); bs[mm][bj][1] = *(const f32x4*)(base + off + bj * 128 + 4); } }
#pragma unroll
                for (int mm = 0; mm < 2; ++mm) { const int m = mh * 2 + mm; const int row = EROW(ai, m); float q = 0.f;
#pragma unroll
                    for (int bj = 0; bj < 2; ++bj) { const f32x4 v0 = acc[ai][bj][m][0] + bs[mm][bj][0], v1 = acc[ai][bj][m][1] + bs[mm][bj][1]; acc[ai][bj][m][0] = v0; acc[ai][bj][m][1] = v1;
                        q += (v0[0] * v0[0] + v0[1] * v0[1]) + (v0[2] * v0[2] + v0[3] * v0[3]) + (v1[0] * v1[0] + v1[1] * v1[1]) + (v1[2] * v1[2] + v1[3] * v1[3]); }
                    q += __shfl_xor(q, 16); q += __shfl_xor(q, 32);
                    if (fq == 0) __hip_atomic_store(ss2 + (size_t)row * 32 + u.pn * 4 + wc, q, __ATOMIC_RELAXED, __HIP_MEMORY_SCOPE_AGENT); }
                asm volatile("" ::: "memory"); }
        asm volatile("s_waitcnt vmcnt(0)" ::: "memory");
        unsigned* cw = cnt + 16 * (u.pm * 2 + wr);
        if ((threadIdx.x & 63) == 0) __hip_atomic_fetch_add(cw, 1u, __ATOMIC_RELAXED, __HIP_MEMORY_SCOPE_AGENT);
        { unsigned spins = 0; while (__hip_atomic_load(cw, __ATOMIC_RELAXED, __HIP_MEMORY_SCOPE_AGENT) < 32u) { __builtin_amdgcn_s_sleep(1); if (++spins > (1u << 22)) break; } }
        f32x4 gv[2][2];
#pragma unroll
        for (int bj = 0; bj < 2; ++bj) { gv[bj][0] = *(const f32x4*)(g + col0 + bj * 128); gv[bj][1] = *(const f32x4*)(g + col0 + bj * 128 + 4); }
#pragma unroll
        for (int ai = 0; ai < 2; ++ai)
#pragma unroll
            for (int m = 0; m < 4; ++m) { const int row = EROW(ai, m); const float* sp = ss2 + (size_t)row * 32 + fq * 8; float pq[8];
#pragma unroll
                for (int k = 0; k < 8; ++k) pq[k] = __hip_atomic_load(sp + k, __ATOMIC_RELAXED, __HIP_MEMORY_SCOPE_AGENT);
                float q = ((pq[0] + pq[1]) + (pq[2] + pq[3])) + ((pq[4] + pq[5]) + (pq[6] + pq[7]));
                q += __shfl_xor(q, 16); q += __shfl_xor(q, 32);
                const float rs = rsqrtf(q * (1.0f / 2048.0f) + EPSV); const size_t off = (size_t)row * 2048 + col0;
#pragma unroll
                for (int bj = 0; bj < 2; ++bj) { *(f32x4*)(X + off + bj * 128) = acc[ai][bj][m][0] * rs * gv[bj][0]; *(f32x4*)(X + off + bj * 128 + 4) = acc[ai][bj][m][1] * rs * gv[bj][1]; } }
    } };
struct Epi5 { static constexpr bool PERM = true; const float* base; float* X; float* ssp; const float* g; bf16_t* Hn;
    __device__ __forceinline__ void operator()(const AccT& acc, const pg8::Unit& u, int wr, int wc, int fr, int fq) const {
        const int col0 = ECOL0;
        f32x4 gv[2][2];
#pragma unroll
        for (int bj = 0; bj < 2; ++bj) { gv[bj][0] = *(const f32x4*)(g + col0 + bj * 128); gv[bj][1] = *(const f32x4*)(g + col0 + bj * 128 + 4); }
#pragma unroll
        for (int ai = 0; ai < 2; ++ai) {
            f32x4 bs[4][2][2];
#pragma unroll
            for (int m = 0; m < 4; ++m) { const size_t off = (size_t)EROW(ai, m) * 2048 + col0;
#pragma unroll
                for (int bj = 0; bj < 2; ++bj) { bs[m][bj][0] = *(const f32x4*)(base + off + bj * 128); bs[m][bj][1] = *(const f32x4*)(base + off + bj * 128 + 4); } }
#pragma unroll
            for (int m = 0; m < 4; ++m) { const int row = EROW(ai, m); const size_t off = (size_t)row * 2048 + col0; float q = 0.f;
#pragma unroll
                for (int bj = 0; bj < 2; ++bj) { const f32x4 v0 = acc[ai][bj][m][0] + bs[m][bj][0], v1 = acc[ai][bj][m][1] + bs[m][bj][1];
                    *(f32x4*)(X + off + bj * 128) = v0; *(f32x4*)(X + off + bj * 128 + 4) = v1;
                    q += (v0[0] * v0[0] + v0[1] * v0[1]) + (v0[2] * v0[2] + v0[3] * v0[3]) + (v1[0] * v1[0] + v1[1] * v1[1]) + (v1[2] * v1[2] + v1[3] * v1[3]);
                    *(u32x4*)(Hn + off + bj * 128) = pack8(v0 * gv[bj][0], v1 * gv[bj][1]); }
                q += __shfl_xor(q, 16); q += __shfl_xor(q, 32);
                if (fq == 0) ssp[(size_t)row * 32 + u.pn * 4 + wc] = q; }
            asm volatile("" ::: "memory"); }
    } };
struct Epi6 { static constexpr bool PERM = true; bf16_t* O; const float* ssp; const LAS float* rsl; int pm0, pm1;
    __device__ __forceinline__ void operator()(const AccT& acc, const pg8::Unit& u, int wr, int wc, int fr, int fq) const {
        const int col0 = u.pn * 128 + wc * 32 + 8 * fq;
        float rsv[2][4];
        if (u.pm == pm0 || u.pm == pm1) { const int tb = (u.pm == pm0) ? 0 : 256;
#pragma unroll
            for (int ai = 0; ai < 2; ++ai)
#pragma unroll
                for (int m = 0; m < 4; ++m) rsv[ai][m] = rsl[tb + ai * 128 + wr * 64 + m * 16 + fr];
        } else {
#pragma unroll
            for (int ai = 0; ai < 2; ++ai)
#pragma unroll
                for (int m = 0; m < 4; ++m) { const int row = EROW(ai, m);
                    const f32x4 p0 = *(const f32x4*)(ssp + (size_t)row * 32 + fq * 8), p1 = *(const f32x4*)(ssp + (size_t)row * 32 + fq * 8 + 4);
                    float q = ((p0[0] + p0[1]) + (p0[2] + p0[3])) + ((p1[0] + p1[1]) + (p1[2] + p1[3]));
                    q += __shfl_xor(q, 16); q += __shfl_xor(q, 32);
                    rsv[ai][m] = rsqrtf(q * (1.0f / 2048.0f) + EPSV); }
        }
#pragma unroll
        for (int ai = 0; ai < 2; ++ai)
#pragma unroll
            for (int m = 0; m < 4; ++m) { const int row = EROW(ai, m); const float rs = rsv[ai][m];
                f32x4 h0, h1;
#pragma unroll
                for (int j = 0; j < 4; ++j) { const float g0 = acc[ai][0][m][0][j] * rs, u0 = acc[ai][1][m][0][j] * rs, g1 = acc[ai][0][m][1][j] * rs, u1 = acc[ai][1][m][1][j] * rs;
                    h0[j] = g0 * sigmoidf_(g0) * u0; h1[j] = g1 * sigmoidf_(g1) * u1; }
                *(u32x4*)(O + (size_t)row * DFF + col0) = pack8(h0, h1); }
    } };

__device__ __forceinline__ float block_sum(float v, float* red, int tid) {
    for (int o = 32; o >= 1; o >>= 1) v += __shfl_xor(v, o);
    __syncthreads();
    if ((tid & 63) == 0) red[tid >> 6] = v;
    __syncthreads();
    float s = 0.f;
#pragma unroll
    for (int i = 0; i < 8; ++i) s += red[i];
    return s;
}

__device__ __forceinline__ void tr_tile(const float* __restrict__ src, int N, int K, bf16_t* __restrict__ dst, int k0, int n0, int drow0, float* tile, int tid) {
#pragma unroll
    for (int i = 0; i < 2; ++i) { const int kk = (tid >> 4) + i * 32, n4 = (tid & 15) * 4;
        const f32x4 v = *(const f32x4*)(src + (size_t)(k0 + kk) * N + n0 + n4);
        tile[kk * 65 + n4 + 0] = v[0]; tile[kk * 65 + n4 + 1] = v[1]; tile[kk * 65 + n4 + 2] = v[2]; tile[kk * 65 + n4 + 3] = v[3]; }
    __syncthreads();
    const int n = tid >> 3, kg = tid & 7; f32x4 a, b;
#pragma unroll
    for (int j = 0; j < 4; ++j) { a[j] = tile[(kg * 8 + j) * 65 + n]; b[j] = tile[(kg * 8 + 4 + j) * 65 + n]; }
    *(u32x4*)(dst + (size_t)(drow0 + n) * K + k0 + kg * 8) = pack8(a, b);
    __syncthreads();
}

__device__ __forceinline__ float sconv(const bf16_t* __restrict__ row, int b, int s, float w0, float w1, float w2, float bias) {
    const bf16_t* p = row + b * 2048 + s;
    const float c = bf2f(p[0]); const float l = s > 0 ? bf2f(p[-1]) : 0.f; const float r = s < 2047 ? bf2f(p[1]) : 0.f;
    return w0 * l + w1 * c + w2 * r + bias;
}

#define XB_TMO      128
#define XB_XCNT(j)  (256  + 64 * (j))
#define XB_XSUB(j)  (1280 + 64 * (j))
#define XB_XGEN(j)  (2304 + 64 * (j))
#define XB_TOP      3328
#define XB_TOPGEN   3392
#define XCD_BAR_WORDS 3456
#define XB_SPIN_CAP (1u << 22)

__device__ __forceinline__ unsigned xb_ld(unsigned* p)              { return __hip_atomic_load(p, __ATOMIC_RELAXED, __HIP_MEMORY_SCOPE_AGENT); }
__device__ __forceinline__ unsigned xb_add(unsigned* p, unsigned v) { return __hip_atomic_fetch_add(p, v, __ATOMIC_RELAXED, __HIP_MEMORY_SCOPE_AGENT); }
__device__ __forceinline__ unsigned xb_xcc_id() { return (unsigned)__builtin_amdgcn_s_getreg((3 << 11) | 20) & 0xFu; }
#define XB_SPIN(cond, bar) do { unsigned _sp = 0; while (cond) { __builtin_amdgcn_s_sleep(1); \
    if ((++_sp & 255u) == 0u) { if (xb_ld(&(bar)[XB_TMO])) break; if (_sp > XB_SPIN_CAP) { atomicAdd(&(bar)[XB_TMO], 1u); break; } } } } while (0)

struct XcdBarrier {
    unsigned* bar; unsigned x;
    volatile LAS unsigned* st;
};

__device__ __forceinline__ XcdBarrier xcd_barrier_post(unsigned* bar, volatile LAS unsigned* st) {
    XcdBarrier b; b.bar = bar; b.x = xb_xcc_id(); b.st = st;
    if (threadIdx.x == 0) (void)xb_add(&bar[XB_XCNT(b.x)], 1u);
    return b;
}
__device__ __forceinline__ void xcd_barrier_complete(unsigned* bar, unsigned x, unsigned& nloc, unsigned& nx) {
    const unsigned G = gridDim.x * gridDim.y * gridDim.z;
    unsigned sum, cnt, mine, sp = 0u;
    for (;;) {
        sum = 0u; cnt = 0u; mine = 0u;
#pragma unroll
        for (unsigned j = 0; j < 16; ++j) { const unsigned c = xb_ld(&bar[XB_XCNT(j)]); sum += c; cnt += (c > 0u) ? 1u : 0u; mine = (j == x) ? c : mine; }
        if (sum == G) break;
        __builtin_amdgcn_s_sleep(1);
        if ((++sp & 255u) == 0u) { if (xb_ld(&bar[XB_TMO])) break; if (sp > XB_SPIN_CAP) { atomicAdd(&bar[XB_TMO], 1u); break; } }
    }
    nloc = mine > 0u ? mine : 1u; nx = cnt > 0u ? cnt : 1u;
}

__device__ __forceinline__ void xcd_barrier(const XcdBarrier& b) {
    asm volatile("s_waitcnt vmcnt(0)" ::: "memory");
    __syncthreads();
    if (threadIdx.x == 0) {
        unsigned* bar = b.bar;
        __builtin_amdgcn_s_waitcnt(0);
        unsigned nloc = b.st[0], nx = b.st[1];
        if (nloc == 0u) { xcd_barrier_complete(bar, b.x, nloc, nx); b.st[0] = nloc; b.st[1] = nx; }
        const unsigned old = xb_add(&bar[XB_XSUB(b.x)], 1u);
        const unsigned gen = old / nloc;
        if (old + 1u == (gen + 1u) * nloc) {
            __builtin_amdgcn_fence(__ATOMIC_RELEASE, "agent");
            asm volatile("s_waitcnt vmcnt(0)" ::: "memory");
            const unsigned og = xb_add(&bar[XB_TOP], 1u);
            const unsigned tg = og / nx;
            if (og + 1u == (tg + 1u) * nx) xb_add(&bar[XB_TOPGEN], 1u);
            else XB_SPIN(xb_ld(&bar[XB_TOPGEN]) == tg, bar);
            __builtin_amdgcn_fence(__ATOMIC_ACQUIRE, "agent");
            xb_add(&bar[XB_XGEN(b.x)], 1u);
            asm volatile("s_waitcnt vmcnt(0)" ::: "memory");
        } else {
            XB_SPIN(xb_ld(&bar[XB_XGEN(b.x)]) == gen, bar);
            __builtin_amdgcn_fence(__ATOMIC_ACQUIRE, "agent");
            asm volatile("s_waitcnt vmcnt(0)" ::: "memory");
        }
    }
    __syncthreads();
}


__device__ __forceinline__ void my_barrier(unsigned* bar, unsigned target) {
    asm volatile("s_waitcnt vmcnt(0)" ::: "memory");
    __syncthreads();
    if (threadIdx.x == 0) {
        __builtin_amdgcn_fence(__ATOMIC_RELEASE, "agent");
        asm volatile("s_waitcnt vmcnt(0)" ::: "memory");
        __hip_atomic_fetch_add(bar, 1u, __ATOMIC_RELAXED, __HIP_MEMORY_SCOPE_AGENT);
        while (__hip_atomic_load(bar, __ATOMIC_RELAXED, __HIP_MEMORY_SCOPE_AGENT) < target) __builtin_amdgcn_s_sleep(2);
        __builtin_amdgcn_fence(__ATOMIC_ACQUIRE, "agent");
        asm volatile("s_waitcnt vmcnt(0)" ::: "memory");
    }
    __syncthreads();
}

template <bool TOBF> __device__ __forceinline__ void rmsnorm_rows(const float* x, const float* __restrict__ g, bf16_t* ob, float* of, int bid, int G, int wave, int lane) {
    for (int row = bid * 8 + wave; row < NTOK; row += G * 8) {
        const float* xr = x + (size_t)row * DM; f32x4 v[8]; float q = 0.f;
#pragma unroll
        for (int i = 0; i < 8; ++i) { v[i] = *(const f32x4*)(xr + lane * 4 + i * 256); q += (v[i][0] * v[i][0] + v[i][1] * v[i][1]) + (v[i][2] * v[i][2] + v[i][3] * v[i][3]); }
        for (int o = 32; o >= 1; o >>= 1) q += __shfl_xor(q, o);
        const float rs = rsqrtf(q * (1.0f / 2048.0f) + EPSV);
#pragma unroll
        for (int i = 0; i < 8; ++i) { const f32x4 gg = *(const f32x4*)(g + lane * 4 + i * 256); const f32x4 y = v[i] * rs * gg;
            if (TOBF) { u32x2 w; w.x = cvt_pk_bf16(y[0], y[1]); w.y = cvt_pk_bf16(y[2], y[3]); *(u32x2*)(ob + (size_t)row * DM + lane * 4 + i * 256) = w; }
            else *(f32x4*)(of + (size_t)row * DM + lane * 4 + i * 256) = y; }
    }
}


#ifdef SELFCHK
__device__ __forceinline__ unsigned hsh(unsigned x) { x ^= x >> 16; x *= 0x7feb352du; x ^= x >> 15; x *= 0x846ca68bu; x ^= x >> 16; return x; }
__device__ __forceinline__ float wdot(const bf16_t* a, const bf16_t* b, int K, int lane) { float s = 0.f; for (int k = lane; k < K; k += 64) s += bf2f(a[k]) * bf2f(b[k]); for (int o = 32; o >= 1; o >>= 1) s += __shfl_xor(s, o); return s; }
__device__ __forceinline__ void chk_flag(unsigned* flags, bool bad, unsigned bit) { if (__any(bad) && (threadIdx.x & 63) == 0) atomicOr(flags, bit); }
__device__ __forceinline__ bool far(float got, float ref) { return !(fabsf(got - ref) <= 0.02f * fabsf(ref) + 0.02f); }
#define CHK(...) do { __VA_ARGS__ } while (0)
#else
#define CHK(...) do { } while (0)
#endif

__global__ void __launch_bounds__(NTHR, 2) fwd_megakernel(Params P) {
    extern __shared__ __attribute__((aligned(16))) unsigned char smem[];
    cg::grid_group grid = cg::this_grid();
    const int tid = threadIdx.x, lane = tid & 63, wave = tid >> 6;
    const int G = gridDim.x, bid = blockIdx.x;
    unsigned char* ws = P.ws;
    LAS unsigned char* lds = (LAS unsigned char*)smem;
    const int lo = P.lo, hi = P.hi;
#define IN(k) (lo <= (k) && (k) < hi)
#define SEAM(k) do { if ((k) + 1 < hi) { if (lo > (k) + 1000) grid.sync();   xcd_barrier(xb); } } while (0)

    { volatile LAS unsigned* stw = (volatile LAS unsigned*)(lds + 146400); if (tid < 2) stw[tid] = 0u; __syncthreads(); }
    const XcdBarrier xb = xcd_barrier_post((unsigned*)(ws + WS_BAR + 16384), (volatile LAS unsigned*)(lds + 146400));
    float* stats = (float*)(ws + WS_STATS); float* ss1 = (float*)(ws + WS_SS1); float* ss2 = (float*)(ws + WS_SS2); float* h3 = (float*)(ws + WS_H3);
    bf16_t* WinT = (bf16_t*)(ws + W_IN); bf16_t* WbhT = (bf16_t*)(ws + W_BH); bf16_t* WbsT = (bf16_t*)(ws + W_BS); bf16_t* WoutT = (bf16_t*)(ws + W_OUT);
    bf16_t* WfiT = (bf16_t*)(ws + W_FI); bf16_t* WfoT = (bf16_t*)(ws + W_FO);
    bf16_t* Hn = (bf16_t*)(ws + WS_R2); bf16_t* Yhy = (bf16_t*)(ws + WS_R2); bf16_t* Ysgu = (bf16_t*)(ws + WS_R2 + 33554432);
    bf16_t* PT = (bf16_t*)(ws + R3_PT); bf16_t* PROJ2 = (bf16_t*)(ws + R3_PROJ2); bf16_t* MERGED = (bf16_t*)(ws + R3_MERGED); bf16_t* H2 = (bf16_t*)(ws + R3_H2); bf16_t* HID = (bf16_t*)(ws + R3_HID);
    float* SSP = (float*)(ws + WS_R2);
    float* KF = P.out; bf16_t* YT = (bf16_t*)((unsigned char*)P.out + 33554432);

    auto weight_tiles = [&](int t_lo, int t_hi) {
            float* tile = (float*)smem;
            struct TJ { const float* src; bf16_t* dst; int K, N, k0, n0, mode; };
            auto decode = [&](int ti, TJ& j) {
                int li, ntl; j.mode = 0;
                if (ti < 1152) { j.src = P.in[2]; j.dst = WinT; j.K = 2048; j.N = 9216; li = ti; ntl = 36; }
                else if (ti < 1280) { j.src = P.in[18]; j.dst = WbhT; j.K = 1024; j.N = 2048; li = ti - 1152; ntl = 8; }
                else if (ti < 1408) { j.src = P.in[19]; j.dst = WbsT; j.K = 1024; j.N = 2048; li = ti - 1280; ntl = 8; }
                else if (ti < 1664) { j.src = P.in[20]; j.dst = WoutT; j.K = 2048; j.N = 2048; li = ti - 1408; ntl = 8; }
                else if (ti < 3072) { j.src = P.in[22]; j.dst = WfiT; j.K = 2048; j.N = 11264; li = ti - 1664; ntl = 44; j.mode = 1; }
                else { j.src = P.in[23]; j.dst = WfoT; j.K = 5632; j.N = 2048; li = ti - 3072; ntl = 8; }
                j.k0 = (li / ntl) * 64; j.n0 = (li % ntl) * 256; };
            f32x4 v[8]; TJ cur, nxt; int ti = t_lo + bid; bool have = ti < t_hi;
            if (have) { decode(ti, cur);
#pragma unroll
                for (int i = 0; i < 8; ++i) { const int idx = tid + i * NTHR, kk = idx >> 6, n4 = (idx & 63) * 4; v[i] = *(const f32x4*)(cur.src + (size_t)(cur.k0 + kk) * cur.N + cur.n0 + n4); } }
            while (have) {
#pragma unroll
                for (int i = 0; i < 8; ++i) { const int idx = tid + i * NTHR, kk = idx >> 6, n4 = (idx & 63) * 4; *(f32x4*)(tile + kk * 260 + (n4 ^ (((kk >> 3) & 7) << 2))) = v[i]; }
                __syncthreads();
                const int nti = ti + G; const bool hn = nti < t_hi;
                if (hn) { decode(nti, nxt);
#pragma unroll
                    for (int i = 0; i < 8; ++i) { const int idx = tid + i * NTHR, kk = idx >> 6, n4 = (idx & 63) * 4; v[i] = *(const f32x4*)(nxt.src + (size_t)(nxt.k0 + kk) * nxt.N + nxt.n0 + n4); } }
#pragma unroll
                for (int i = 0; i < 4; ++i) { const int item = tid + i * NTHR, n = item >> 3, kg = item & 7; f32x4 a, b;
#pragma unroll
                    for (int j = 0; j < 4; ++j) { a[j] = tile[(kg * 8 + j) * 260 + (n ^ (kg << 2))]; b[j] = tile[(kg * 8 + 4 + j) * 260 + (n ^ (kg << 2))]; }
                    int drow = cur.n0 + n;
                    if (cur.mode == 1) { const int up = drow >= DFF; const int jj = up ? drow - DFF : drow; drow = 256 * (jj >> 7) + (up ? 128 : 0) + (jj & 127); }
                    *(u32x4*)(cur.dst + (size_t)drow * cur.K + cur.k0 + kg * 8) = pack8(a, b); }
                __syncthreads();
                ti = nti; have = hn; cur = nxt;
            }
        __syncthreads();
    };
    if (((PHASE_MASK >> 0) & 1) && IN(0)) {
        weight_tiles(0, 1152);
        rmsnorm_rows<true>(P.in[0], P.in[1], Hn, nullptr, bid, G, wave, lane);
        {
            float* zf = (float*)smem; float* ha = zf + 8 * 40; float* hb = ha + 8 * 64;
            const float* w1 = P.in[5]; const float* b1 = P.in[6]; const float* w2 = P.in[7]; const float* b2 = P.in[8]; const float* w3 = P.in[9]; const float* b3 = P.in[10]; const float* fq_ = P.in[11];
            for (int pg = bid; pg < 256; pg += G) {
                const int pos = pg * 8 + wave;
                __syncthreads();
                if (lane < 33) {
                    float z;
                    if (lane == 0) z = (float)pos / 2047.0f;
                    else { const int mband = (lane - 1) & 15; const float f = 1e-4f + (float)mband * ((15.0f - 1e-4f) / 15.0f); const float w = (6.2831855f * (float)pos) / 2048.0f; const float a = f * w;
                        z = lane < 17 ? __cosf(a) : -__sinf(a); }
                    zf[wave * 40 + lane] = z;
                }
                __syncthreads();
                const float fr = fq_[lane];
                float a = b1[lane];
#pragma unroll 3
                for (int i = 0; i < 33; ++i) a += zf[wave * 40 + i] * w1[i * 64 + lane];
                ha[wave * 64 + lane] = __sinf(fr * a);
                __syncthreads();
                a = b2[lane];
#pragma unroll 8
                for (int i = 0; i < 64; ++i) a += ha[wave * 64 + i] * w2[i * 64 + lane];
                hb[wave * 64 + lane] = __sinf(fr * a);
                __syncthreads();
                a = b3[lane];
#pragma unroll 8
                for (int i = 0; i < 64; ++i) a += hb[wave * 64 + i] * w3[i * 64 + lane];
                h3[pos * 64 + lane] = __sinf(fr * a);
            }
            __syncthreads();
        }
        SEAM(0);
    }

    if (((PHASE_MASK >> 1) & 1) && IN(1)) {
        CHK(
            { const unsigned sid = bid * 8 + wave; unsigned* flags = (unsigned*)(ws + WS_BAR + 64); bool bad = false;
              { const int n = hsh(sid * 7 + 1) % 9216, k = (hsh(sid * 7 + 2) + lane) % 2048; bad |= WinT[(size_t)n * 2048 + k] != f2bf(P.in[2][(size_t)k * 9216 + n]); }
              { const int j = hsh(sid * 7 + 3) % 5632, k = (hsh(sid * 7 + 4) + lane) % 2048; const int rg = 256 * (j >> 7) + (j & 127);
                bad |= WfiT[(size_t)rg * 2048 + k] != f2bf(P.in[22][(size_t)k * 11264 + j]); bad |= WfiT[(size_t)(rg + 128) * 2048 + k] != f2bf(P.in[22][(size_t)k * 11264 + 5632 + j]); }
              { const int n = hsh(sid * 7 + 5) % 2048, k = (hsh(sid * 7 + 6) + lane) % 5632; bad |= WfoT[(size_t)n * 5632 + k] != f2bf(P.in[23][(size_t)k * 2048 + n]); }
              { const int n = hsh(sid * 7 + 5) % 2048, k = (hsh(sid * 7 + 6) + lane) % 1024; bad |= WbhT[(size_t)n * 1024 + k] != f2bf(P.in[18][(size_t)k * 2048 + n]); bad |= WbsT[(size_t)n * 1024 + k] != f2bf(P.in[19][(size_t)k * 2048 + n]); }
              { const int n = hsh(sid * 7 + 5) % 2048, k = (hsh(sid * 7 + 6) + lane) % 2048; bad |= WoutT[(size_t)n * 2048 + k] != f2bf(P.in[20][(size_t)k * 2048 + n]); }
              chk_flag(flags, bad, 1u); }
        );
        {
            const float* w4 = P.in[12]; float* Wl = (float*)smem;
            for (int cb = bid; cb < 256; cb += G) {
                __syncthreads();
                for (int idx = tid; idx < 1024; idx += NTHR) { const int cc = idx & 15, j = idx >> 4; Wl[cc * 64 + j] = w4[(size_t)j * 4096 + cb * 16 + cc]; }
                __syncthreads();
                for (int pp2 = 0; pp2 < 2; ++pp2) {
                    const int pos0 = (wave * 4 + pp2 * 2) * 64 + lane, pos1 = pos0 + 64;
                    float h0[64], h1[64];
#pragma unroll
                    for (int j4 = 0; j4 < 16; ++j4) { const f32x4 t0 = *(const f32x4*)(h3 + pos0 * 64 + j4 * 4), t1 = *(const f32x4*)(h3 + pos1 * 64 + j4 * 4);
#pragma unroll
                        for (int k = 0; k < 4; ++k) { h0[j4 * 4 + k] = t0[k]; h1[j4 * 4 + k] = t1[k]; } }
                    const float tt0 = (float)pos0 / 2047.0f, tt1 = (float)pos1 / 2047.0f;
                    for (int cc = 0; cc < 16; ++cc) {
                        const int col = cb * 16 + cc; const int dir = col >> 11, o = (col >> 10) & 1, c = col & 1023;
                        float a0 = 0.f, a1 = 0.f;
#pragma unroll
                        for (int j4 = 0; j4 < 16; ++j4) { const f32x4 w = *(const f32x4*)(Wl + cc * 64 + j4 * 4);
#pragma unroll
                            for (int k = 0; k < 4; ++k) { a0 += h0[j4 * 4 + k] * w[k]; a1 += h1[j4 * 4 + k] * w[k]; } }
                        const float ad = 3.0701134573f + (float)c * ((15.3505672866f - 3.0701134573f) / 1023.0f);
                        const float v0 = a0 * __expf(-tt0 * ad), v1 = a1 * __expf(-tt1 * ad);
                        float* kr = KF + (size_t)(o * 1024 + c) * 4096;
                        if (dir == 0) { kr[2048 + pos0] = v0; kr[2048 + pos1] = v1; }
                        else { if (pos0 >= 1) kr[2048 - pos0] = v0; else kr[0] = 0.f; kr[2048 - pos1] = v1; }
                    }
                }
            }
            __syncthreads();
        }
        {
            pg8::Gemm g{WinT, Hn, 3072, NTOK, DM}; pg8::StaticOrder S; S.init(3072, NTOK, G, bid);
            Epi1a E{PT, NTOK}; pg8::gemm_phase<Epi1a>(lds, g, S, E);
        }
        {
            pg8::Gemm g{Hn, WinT + (size_t)3072 * DM, NTOK, 6144, DM}; pg8::StaticOrder S; S.init(NTOK, 6144, G, bid);
            Epi1b E{PROJ2}; pg8::gemm_phase<Epi1b>(lds, g, S, E);
        }
        SEAM(1);
    }

    if (((PHASE_MASK >> 2) & 1) && IN(2)) {
        CHK(
            { const unsigned sid = bid * 8 + wave; unsigned* flags = (unsigned*)(ws + WS_BAR + 64);
              { const int ch = hsh(sid * 5 + 11) % 3072, tok = hsh(sid * 5 + 12) % 8192; const float ref = wdot(WinT + (size_t)ch * 2048, Hn + (size_t)tok * 2048, 2048, lane);
                chk_flag(flags, far(bf2f(PT[(size_t)ch * NTOK + tok]), ref), 2u); }
              { const int col = hsh(sid * 5 + 13) % 6144, tok = hsh(sid * 5 + 14) % 8192; const float r0 = wdot(Hn + (size_t)tok * 2048, WinT + (size_t)(3072 + col) * 2048, 2048, lane);
                const float ref = col < 2048 ? 0.5f * r0 * (1.0f + erff(r0 * 0.70710678f)) : 1.0f / (1.0f + expf(-r0));
                chk_flag(flags, far(bf2f(PROJ2[(size_t)tok * 6144 + col]), ref), 4u); } }
        );
        if (bid & 1) weight_tiles(1152, 3776);
        {
            unsigned char* Z1 = smem;
            unsigned char* Z2 = smem + 34816;
            unsigned char* KS = smem + 69632;
            bf16_t* KR = (bf16_t*)(smem + 137472);
            float* red = (float*)(smem + 145696);
            const float* scw = P.in[3]; const float* scb = P.in[4]; const float* hbias = P.in[13];
            for (int i = tid; i < 1024; i += NTHR) { const int buf = i >> 9, w = i & 511; const int off = (w < 256 ? 0 : 66 * 512 - 1024) + w * 4; *(unsigned*)((buf ? Z2 : Z1) + off) = 0u; }
            const int pp = wave & 1, gg = wave >> 1, li = lane & 15, lq = lane >> 4, bb = li & 7, jsel = li >> 3;
            const unsigned boff = (unsigned)(jsel * 512 + bb * 64 + ((lq ^ ((bb >> 2) << 1)) * 16));
            const int rcp_ = 7 - (li & 7); const int ksl = rcp_ * 8448 + 48 * (rcp_ & 3) + 2 * (2040 - 16 * pp - 8 * (li >> 3) + 8 * lq);
            float kv[8];
            if (bid < DH) { const float* kr0 = KF + (size_t)bid * 4096;
#pragma unroll
                for (int j = 0; j < 8; ++j) kv[j] = kr0[tid + j * NTHR]; }
            for (int c = bid; c < DH; c += G) {
                __syncthreads();
                {   const float w0 = scw[c], w1 = scw[3072 + c], w2 = scw[6144 + c], bs = scb[c];
                    for (int ch = tid; ch < 2048; ch += NTHR) { const int b = ch >> 8, s = (ch & 255) * 8; const bf16_t* src = PT + (size_t)c * NTOK + b * 2048 + s;
                        f32x4 fa, fb; unpack8(*(const u32x4*)src, fa, fb); const float fl = s > 0 ? bf2f(src[-1]) : 0.f, fr_ = s + 8 < 2048 ? bf2f(src[8]) : 0.f;
                        f32x4 oa, ob;
                        oa[0] = w0 * fl + w1 * fa[0] + w2 * fa[1] + bs; oa[1] = w0 * fa[0] + w1 * fa[1] + w2 * fa[2] + bs; oa[2] = w0 * fa[1] + w1 * fa[2] + w2 * fa[3] + bs; oa[3] = w0 * fa[2] + w1 * fa[3] + w2 * fb[0] + bs;
                        ob[0] = w0 * fa[3] + w1 * fb[0] + w2 * fb[1] + bs; ob[1] = w0 * fb[0] + w1 * fb[1] + w2 * fb[2] + bs; ob[2] = w0 * fb[1] + w1 * fb[2] + w2 * fb[3] + bs; ob[3] = w0 * fb[2] + w1 * fb[3] + w2 * fr_ + bs;
                        const int J = s >> 5, chunk = (s & 31) >> 3;
                        *(u32x4*)(Z1 + ((J + 2) * 8 + b) * 64 + ((chunk ^ ((b >> 2) << 1)) * 16)) = pack8(oa, ob); } }
                for (int o = 0; o < 2; ++o) {
                    float part = 0.f;
#pragma unroll
                    for (int j = 0; j < 8; ++j) { part += fabsf(kv[j]); KR[4095 - (tid + j * NTHR)] = f2bf(kv[j]); }
                    if (tid < 8) KR[4096 + tid] = 0;
                    const float scale = 1.0f / block_sum(part, red, tid);
                    {   const u32x4 c0 = *(const u32x4*)(KR + tid * 8), c1 = *(const u32x4*)(KR + tid * 8 + 8);
                        const unsigned D[8] = {c0.x, c0.y, c0.z, c0.w, c1.x, c1.y, c1.z, c1.w};
#pragma unroll
                        for (int r = 0; r < 8; ++r) { u32x4 w; const int sft = r >> 1;
                            if (r & 1) { w.x = __builtin_amdgcn_alignbit(D[sft + 1], D[sft], 16); w.y = __builtin_amdgcn_alignbit(D[sft + 2], D[sft + 1], 16); w.z = __builtin_amdgcn_alignbit(D[sft + 3], D[sft + 2], 16); w.w = __builtin_amdgcn_alignbit(D[sft + 4], D[sft + 3], 16); }
                            else { w.x = D[sft]; w.y = D[sft + 1]; w.z = D[sft + 2]; w.w = D[sft + 3]; }
                            *(u32x4*)(KS + r * 8448 + 48 * (r & 3) + tid * 16) = w; } }
                    __syncthreads();
                    {
                        const int nc = o == 0 ? c : c + G, no = o == 0 ? 1 : 0;
                        if (nc < DH) { const float* krn = KF + (size_t)(no * 1024 + nc) * 4096;
#pragma unroll
                            for (int j = 0; j < 8; ++j) kv[j] = krn[tid + j * NTHR]; } }
                    const unsigned char* Zin = o ? Z2 : Z1;
                    const int chx = (o == 0 ? 1024 : 2048) + c;
                    u32x2 xwv[8]; unsigned short xlv[8], xrv[8];
#pragma unroll
                    for (int a = 0; a < 8; ++a) { const int I = pp + 2 * (16 * gg + 2 * a + jsel); const int t0 = 16 * I + 4 * lq; const bf16_t* src = PT + (size_t)chx * NTOK + bb * 2048 + t0;
                        xwv[a] = *(const u32x2*)src; xlv[a] = t0 > 0 ? src[-1] : (unsigned short)0; xrv[a] = t0 + 4 < 2048 ? src[4] : (unsigned short)0; }
                    f32x4 acc[8];
#pragma unroll
                    for (int a = 0; a < 8; ++a) acc[a] = (f32x4){0.f, 0.f, 0.f, 0.f};
#define HY_LA(E) (*(const bf16x8*)(KS + ksl - 64 * (E)))
#define HY_LBJ(J0) (*(const bf16x8*)(Zin + (((J0) >= -1 && (J0) <= 63) ? ((J0) + 2) : 0) * 512 + boff))
                    {
                        bf16x8 aE[8], aO[8];
                        const int e0 = 16 * gg - 63;
#pragma unroll
                        for (int a2 = 0; a2 < 8; ++a2) { aE[a2] = HY_LA(e0 + 2 * a2); aO[a2] = HY_LA(e0 + 1 + 2 * a2); }
                        bf16x8 bfe = HY_LBJ(63);
                        for (int ib = 0; ib < 64; ib += 16) {
#pragma unroll
                            for (int k = 0; k < 8; ++k) { const int i = ib + 2 * k;
                                const bf16x8 bfo = HY_LBJ(62 - i);
#pragma unroll
                                for (int a2 = 0; a2 < 8; ++a2) acc[a2] = __builtin_amdgcn_mfma_f32_16x16x32_bf16(aE[(a2 + k) & 7], bfe, acc[a2], 0, 0, 0);
                                aE[k & 7] = HY_LA(e0 + i + 16);
                                bfe = HY_LBJ(61 - i);
#pragma unroll
                                for (int a2 = 0; a2 < 8; ++a2) acc[a2] = __builtin_amdgcn_mfma_f32_16x16x32_bf16(aO[(a2 + k) & 7], bfo, acc[a2], 0, 0, 0);
                                aO[k & 7] = HY_LA(e0 + i + 17);
                            }
                        }
#pragma unroll
                        for (int a2 = 0; a2 < 8; ++a2) acc[a2] = __builtin_amdgcn_mfma_f32_16x16x32_bf16(aE[a2], bfe, acc[a2], 0, 0, 0);
                    }
#undef HY_LA
#undef HY_LBJ
                    const float bo = hbias[o * 1024 + c];
                    const float w0 = scw[chx], w1 = scw[3072 + chx], w2 = scw[6144 + chx], bs = scb[chx];
#pragma unroll
                    for (int a = 0; a < 8; ++a) { const int I = pp + 2 * (16 * gg + 2 * a + jsel); const int t0 = 16 * I + 4 * lq;
                        const int zaddr = ((t0 >> 5) + 2) * 512 + bb * 64 + ((((t0 & 31) >> 3) ^ ((bb >> 2) << 1)) * 16) + (t0 & 7) * 2;
                        const u32x2 zw = *(const u32x2*)(Zin + zaddr);
                        const float z0 = __uint_as_float(zw.x << 16), z1 = __uint_as_float(zw.x & 0xffff0000u), z2 = __uint_as_float(zw.y << 16), z3 = __uint_as_float(zw.y & 0xffff0000u);
                        const u32x2 xw = xwv[a];
                        const float x0 = __uint_as_float(xw.x << 16), x1 = __uint_as_float(xw.x & 0xffff0000u), x2 = __uint_as_float(xw.y << 16), x3 = __uint_as_float(xw.y & 0xffff0000u);
                        const float xl = bf2f(xlv[a]), xr = bf2f(xrv[a]);
                        const float r0 = (w0 * xl + w1 * x0 + w2 * x1 + bs) * (acc[a][0] * scale + z0 * bo), r1 = (w0 * x0 + w1 * x1 + w2 * x2 + bs) * (acc[a][1] * scale + z1 * bo);
                        const float r2 = (w0 * x1 + w1 * x2 + w2 * x3 + bs) * (acc[a][2] * scale + z2 * bo), r3 = (w0 * x2 + w1 * x3 + w2 * xr + bs) * (acc[a][3] * scale + z3 * bo);
                        u32x2 w; w.x = cvt_pk_bf16(r0, r1); w.y = cvt_pk_bf16(r2, r3);
                        if (o == 0) *(u32x2*)(Z2 + zaddr) = w; else *(u32x2*)(YT + (size_t)c * NTOK + bb * 2048 + t0) = w; }
                    __syncthreads();
                }
            }
        }
        {
            bf16_t* Wl = (bf16_t*)smem;
            bf16_t* Vl = (bf16_t*)(smem + 36864);
            float* stl = (float*)(smem + 73728);
            const float* lng = P.in[14]; const float* lnb = P.in[15]; const float* w_s = P.in[16]; const float* b_s = P.in[17];
            const int li = lane & 15, lq = lane >> 4;
            for (int item = bid; item < 256; item += G) {
              const int bn = item >> 1, tok0 = bn * 128;
              __syncthreads();
              for (int qb = 0; qb < 4; ++qb) {
                  u32x4 raw[4][2];
#pragma unroll
                  for (int k = 0; k < 4; ++k) { const bf16_t* vp = PROJ2 + (size_t)(tok0 + wave * 16 + qb * 4 + k) * 6144 + 1024 + lane * 16; raw[k][0] = *(const u32x4*)vp; raw[k][1] = *(const u32x4*)(vp + 8); }
#pragma unroll
                  for (int k = 0; k < 4; ++k) { const int q = wave * 16 + qb * 4 + k;
                      f32x4 a0, a1, a2, a3; unpack8(raw[k][0], a0, a1); unpack8(raw[k][1], a2, a3);
                      float sm = 0.f, sq = 0.f;
#pragma unroll
                      for (int j = 0; j < 4; ++j) { sm += (a0[j] + a1[j]) + (a2[j] + a3[j]); sq += (a0[j] * a0[j] + a1[j] * a1[j]) + (a2[j] * a2[j] + a3[j] * a3[j]); }
                      for (int o = 32; o >= 1; o >>= 1) { sm += __shfl_xor(sm, o); sq += __shfl_xor(sq, o); }
                      if (lane == 0) { const float mean = sm * (1.0f / 1024.0f); const float var = sq * (1.0f / 1024.0f) - mean * mean; stl[2 * q] = mean; stl[2 * q + 1] = rsqrtf(var + EPSV); } }
              }
              for (int hh = 0; hh < 4; ++hh) {
                const int h = (item & 1) * 4 + hh;
                __syncthreads();
                for (int ch = tid; ch < 2048; ch += NTHR) {
                    { const int p = ch >> 4, q8 = (ch & 15) * 8; const float* wp = w_s + (size_t)h * 16384 + p * 128 + q8;
                      *(u32x4*)(Wl + p * 144 + q8) = pack8(*(const f32x4*)wp, *(const f32x4*)(wp + 4)); }
                    { const int q = ch >> 4, c8 = (ch & 15) * 8; const float sm = stl[2 * q], rstd = stl[2 * q + 1];
                      f32x4 va, vb; unpack8(*(const u32x4*)(PROJ2 + (size_t)(tok0 + q) * 6144 + 1024 + h * 128 + c8), va, vb);
                      const f32x4 ga = *(const f32x4*)(lng + h * 128 + c8), gb = *(const f32x4*)(lng + h * 128 + c8 + 4), ba = *(const f32x4*)(lnb + h * 128 + c8), bb_ = *(const f32x4*)(lnb + h * 128 + c8 + 4);
                      va = (va - sm) * rstd * ga + ba; vb = (vb - sm) * rstd * gb + bb_;
#pragma unroll
                      for (int j = 0; j < 4; ++j) { Vl[(c8 + j) * 144 + q] = f2bf(va[j]); Vl[(c8 + 4 + j) * 144 + q] = f2bf(vb[j]); } }
                }
                __syncthreads();
                f32x4 acc[8];
#pragma unroll
                for (int ct = 0; ct < 8; ++ct) acc[ct] = (f32x4){0.f, 0.f, 0.f, 0.f};
#pragma unroll
                for (int kk = 0; kk < 4; ++kk) { const bf16x8 wf = *(const bf16x8*)(Wl + (wave * 16 + li) * 144 + kk * 32 + lq * 8);
#pragma unroll
                    for (int ct = 0; ct < 8; ++ct) { const bf16x8 vf = *(const bf16x8*)(Vl + (ct * 16 + li) * 144 + kk * 32 + lq * 8);
                        acc[ct] = __builtin_amdgcn_mfma_f32_16x16x32_bf16(vf, wf, acc[ct], 0, 0, 0); } }
                {   const int p = wave * 16 + li, tok = tok0 + p; const float bs = b_s[h * 128 + p];
#pragma unroll
                    for (int ct = 0; ct < 8; ++ct) { const int cc = h * 128 + ct * 16 + lq * 4; const u32x2 uw = *(const u32x2*)(PROJ2 + (size_t)tok * 6144 + cc);
                        const float u0 = __uint_as_float(uw.x << 16), u1 = __uint_as_float(uw.x & 0xffff0000u), u2 = __uint_as_float(uw.y << 16), u3 = __uint_as_float(uw.y & 0xffff0000u);
                        u32x2 w; w.x = cvt_pk_bf16(u0 * (acc[ct][0] + bs), u1 * (acc[ct][1] + bs)); w.y = cvt_pk_bf16(u2 * (acc[ct][2] + bs), u3 * (acc[ct][3] + bs));
                        *(u32x2*)(Ysgu + (size_t)tok * 1024 + cc) = w; } }
              }
            }
            __syncthreads();
        }
        if (!(bid & 1)) weight_tiles(1152, 3776);
        SEAM(2);
    }

    if (((PHASE_MASK >> 3) & 1) && IN(3)) {
        auto ytrans = [&]() {
        bf16_t* tile = (bf16_t*)smem;
        u32x4 v[4]; int ti = bid; bool have = ti < 1024;
        if (have) { const int c0 = (ti & 15) * 64, t0 = (ti >> 4) * 256;
#pragma unroll
            for (int i = 0; i < 4; ++i) { const int idx = tid + i * NTHR, cr = idx >> 5, tg = idx & 31; v[i] = *(const u32x4*)(YT + (size_t)(c0 + cr) * NTOK + t0 + tg * 8); } }
        while (have) {
            const int c0 = (ti & 15) * 64, t0 = (ti >> 4) * 256;
#pragma unroll
            for (int i = 0; i < 4; ++i) { const int idx = tid + i * NTHR, cr = idx >> 5, tg = idx & 31; *(u32x4*)(tile + cr * 264 + tg * 8) = v[i]; }
            __syncthreads();
            const int nti = ti + G; const bool hn = nti < 1024;
            if (hn) { const int nc0 = (nti & 15) * 64, nt0 = (nti >> 4) * 256;
#pragma unroll
                for (int i = 0; i < 4; ++i) { const int idx = tid + i * NTHR, cr = idx >> 5, tg = idx & 31; v[i] = *(const u32x4*)(YT + (size_t)(nc0 + cr) * NTOK + nt0 + tg * 8); } }
#pragma unroll
            for (int i = 0; i < 4; ++i) { const int item = tid + i * NTHR, tr = item >> 3, cg8 = item & 7; unsigned short e[8];
#pragma unroll
                for (int j = 0; j < 8; ++j) e[j] = tile[(cg8 * 8 + j) * 264 + tr];
                u32x4 w; w.x = e[0] | ((unsigned)e[1] << 16); w.y = e[2] | ((unsigned)e[3] << 16); w.z = e[4] | ((unsigned)e[5] << 16); w.w = e[6] | ((unsigned)e[7] << 16);
                *(u32x4*)(Yhy + (size_t)(t0 + tr) * 1024 + c0 + cg8 * 8) = w; }
            __syncthreads();
            ti = nti; have = hn;
        }
        };
        if (bid & 1) ytrans();
        {   pg8::Gemm g{Ysgu, WbsT, NTOK, DM, DH}; pg8::StaticOrder S; S.init(NTOK, DM, G, bid);
            Epi4<false> E{MERGED, PROJ2 + 4096}; pg8::gemm_phase<Epi4<false>>(lds, g, S, E); }
        if (!(bid & 1)) ytrans();
        SEAM(3);
    }
#ifdef DBG_CUT3
    {
        for (size_t i = (size_t)bid * NTHR + tid; i < (size_t)NTOK * 2048; i += (size_t)G * NTHR) { const int row = (int)(i >> 11), c = (int)(i & 2047);
            P.out[i] = c < 1024 ? bf2f(Yhy[(size_t)row * 1024 + c]) : bf2f(Ysgu[(size_t)row * 1024 + c - 1024]); }
        return;
    }
#endif
    if (((PHASE_MASK >> 4) & 1) && IN(4)) {
        {   pg8::Gemm g{Yhy, WbhT, NTOK, DM, DH}; pg8::StaticOrder S; S.init(NTOK, DM, G, bid);
            Epi4<true> E{MERGED, PROJ2 + 2048}; pg8::gemm_phase<Epi4<true>>(lds, g, S, E); }
        SEAM(4);
    }

    if (((PHASE_MASK >> 5) & 1) && IN(5)) {
        pg8::Gemm g{MERGED, WoutT, NTOK, DM, DM}; pg8::StaticOrder S; S.init(NTOK, DM, G, bid);
        Epi5 E{P.in[0], P.out, SSP, P.in[21], H2}; pg8::gemm_phase<Epi5>(lds, g, S, E);
        SEAM(5);
    }
    if (((PHASE_MASK >> 6) & 1) && IN(6)) {
        pg8::Gemm g{H2, WfiT, NTOK, 2 * DFF, DM}; pg8::StaticOrder S; S.init(NTOK, 2 * DFF, G, bid);
        pg8::Unit u0, u1; S.next(0, u0); u1 = u0; for (int i = 1; ; ++i) { pg8::Unit t; if (!S.next(i, t)) break; u1 = t; }
        {   float* rst = (float*)(smem + 131072);
            for (int r = tid; r < 512; r += NTHR) { const int pmr = r < 256 ? u0.pm : u1.pm; const float* sp = SSP + (size_t)(pmr * 256 + (r & 255)) * 32; float q4[4];
#pragma unroll
                for (int k = 0; k < 4; ++k) { const f32x4 p0 = *(const f32x4*)(sp + k * 8), p1 = *(const f32x4*)(sp + k * 8 + 4); q4[k] = ((p0[0] + p0[1]) + (p0[2] + p0[3])) + ((p1[0] + p1[1]) + (p1[2] + p1[3])); }
                rst[r] = rsqrtf(((q4[0] + q4[1]) + (q4[2] + q4[3])) * (1.0f / 2048.0f) + EPSV); }
            __syncthreads(); }
        Epi6 E{HID, SSP, (const LAS float*)(smem + 131072), u0.pm, u1.pm}; pg8::gemm_phase<Epi6>(lds, g, S, E);
        SEAM(6);
    }
    const bool fuse78 = (G == 256);
    if (((PHASE_MASK >> 7) & 1) && IN(7)) {
        pg8::Gemm g{HID, WfoT, NTOK, DM, DFF}; pg8::StaticOrder S; S.init(NTOK, DM, G, bid);
        if (fuse78) { S.rowmode = 1; Epi7 E{P.out, P.out, (float*)(ws + WS_R2 + 4194304), (unsigned*)(ws + WS_BAR + 1024), P.in[24]}; pg8::gemm_phase<Epi7>(lds, g, S, E); }
        else { EpiRes E{P.out, P.out}; pg8::gemm_phase<EpiRes>(lds, g, S, E); SEAM(7); }
    }
    if (((PHASE_MASK >> 8) & 1) && IN(8) && !fuse78) {
        rmsnorm_rows<false>(P.out, P.in[24], nullptr, P.out, bid, G, wave, lane);
    }
#undef IN
#undef SEAM
}

extern "C" void kernel_launch(void* const* d_in, const int* in_sizes, int n_in, void* d_out, int out_size, void* d_ws, size_t ws_size, hipStream_t stream) {
    static int grid_blocks = 0;
    if (grid_blocks == 0) {
        if (n_in != 25 || out_size != NTOK * DM || ws_size < WS_END) { fprintf(stderr, "kernel_launch: unexpected shapes n_in %d out %d ws %zu (need %zu)\n", n_in, out_size, ws_size, (size_t)WS_END); grid_blocks = -1; return; }
        int dev = 0, cus = 0, per_cu = 0;
        hipGetDevice(&dev);
        hipDeviceGetAttribute(&cus, hipDeviceAttributeMultiprocessorCount, dev);
        if (hipFuncSetAttribute((const void*)fwd_megakernel, hipFuncAttributeMaxDynamicSharedMemorySize, LDS_BYTES) != hipSuccess) { fprintf(stderr, "kernel_launch: hipFuncSetAttribute failed\n"); grid_blocks = -1; return; }
        if (hipOccupancyMaxActiveBlocksPerMultiprocessor(&per_cu, (const void*)fwd_megakernel, NTHR, LDS_BYTES) != hipSuccess || per_cu < 1) { fprintf(stderr, "kernel_launch: occupancy query gave %d\n", per_cu); per_cu = 1; }
        (void)hipGetLastError();
        grid_blocks = cus * per_cu;
    }
    if (grid_blocks < 0) return;
    if (hipMemsetAsync((char*)d_ws + WS_BAR, 0, 32768, stream) != hipSuccess) { fprintf(stderr, "kernel_launch: memset failed\n"); return; }
    Params p{};
    for (int i = 0; i < 25; ++i) p.in[i] = (const float*)d_in[i];
    p.out = (float*)d_out; p.ws = (unsigned char*)d_ws; p.lo = 0; p.hi = 9;
    void* args[] = {&p};
    hipError_t e = hipLaunchCooperativeKernel((const void*)fwd_megakernel, dim3(grid_blocks), dim3(NTHR), args, LDS_BYTES, stream);
    if (e != hipSuccess) fprintf(stderr, "cooperative launch failed: %s (grid %d)\n", hipGetErrorString(e), grid_blocks);
}
```

```cpp
#include <hip/hip_runtime.h>
#include <hip/hip_cooperative_groups.h>
#include <cstdio>
namespace cg = cooperative_groups;

#define LAS __attribute__((address_space(3)))
typedef unsigned short bf16_t;
typedef short bf16x8 __attribute__((ext_vector_type(8)));
typedef float f32x4 __attribute__((ext_vector_type(4)));
typedef float f32x2 __attribute__((ext_vector_type(2)));
typedef unsigned u32x4 __attribute__((ext_vector_type(4)));
typedef unsigned u32x2 __attribute__((ext_vector_type(2)));

constexpr int NTOK = 16384, DM = 2048, DH = 1024, DFF = 5632, SEQ = 2048;
constexpr float EPSV = 1e-6f;
constexpr int NTHR = 512;
#ifndef PHASE_MASK
#define PHASE_MASK 0x3ff
#endif
constexpr int LDS_BYTES = 146432;

constexpr size_t WS_STATS = 0;
constexpr size_t WS_SS1 = 131072;
constexpr size_t WS_SS2 = 196608;
constexpr size_t WS_H3 = 262144;
constexpr size_t WS_BAR = 917504;
constexpr size_t WS_W = 1048576;
constexpr size_t W_IN = WS_W;
constexpr size_t W_BH = W_IN + 37748736;
constexpr size_t W_BS = W_BH + 4194304;
constexpr size_t W_OUT = W_BS + 4194304;
constexpr size_t W_FI = W_OUT + 8388608;
constexpr size_t W_FO = W_FI + 46137344;
constexpr size_t WS_R2 = W_FO + 23068672;
constexpr size_t WS_R3 = WS_R2 + 67108864;
constexpr size_t R3_PT = WS_R3;
constexpr size_t R3_PROJ2 = WS_R3 + 100663296;
constexpr size_t R3_MERGED = WS_R3;
constexpr size_t R3_H2 = WS_R3 + 184549376;
constexpr size_t R3_HID = WS_R3;
constexpr size_t WS_END = WS_R3 + 301989888;

struct Params { const float* in[25]; float* out; unsigned char* ws; int lo, hi; };

__device__ __forceinline__ float bf2f(bf16_t b) { return __uint_as_float(((unsigned)b) << 16); }
__device__ __forceinline__ bf16_t f2bf(float f) { unsigned u = __float_as_uint(f); u += 0x7FFFu + ((u >> 16) & 1u); return (bf16_t)(u >> 16); }
typedef __bf16 bf16x2_t __attribute__((ext_vector_type(2)));
__device__ __forceinline__ unsigned cvt_pk_bf16(float lo, float hi) { f32x2 v = {lo, hi}; bf16x2_t b = __builtin_convertvector(v, bf16x2_t); return __builtin_bit_cast(unsigned, b); }
__device__ __forceinline__ u32x4 pack8(f32x4 a, f32x4 b) { u32x4 w; w.x = cvt_pk_bf16(a[0], a[1]); w.y = cvt_pk_bf16(a[2], a[3]); w.z = cvt_pk_bf16(b[0], b[1]); w.w = cvt_pk_bf16(b[2], b[3]); return w; }
__device__ __forceinline__ void unpack8(u32x4 w, f32x4& a, f32x4& b) {
    a[0] = __uint_as_float(w.x << 16); a[1] = __uint_as_float(w.x & 0xffff0000u); a[2] = __uint_as_float(w.y << 16); a[3] = __uint_as_float(w.y & 0xffff0000u);
    b[0] = __uint_as_float(w.z << 16); b[1] = __uint_as_float(w.z & 0xffff0000u); b[2] = __uint_as_float(w.w << 16); b[3] = __uint_as_float(w.w & 0xffff0000u); }
__device__ __forceinline__ float sigmoidf_(float x) { return __builtin_amdgcn_rcpf(1.0f + __expf(-x)); }
__device__ __forceinline__ f32x2 gelu_pk(f32x2 v) {
    const f32x2 av = __builtin_elementwise_abs(v), d = av * 0.2316418882f + 1.0f;
    f32x2 t; t.x = __builtin_amdgcn_rcpf(d.x); t.y = __builtin_amdgcn_rcpf(d.y);
    f32x2 q = t * 0.5307027145f + (-0.7265760135f); q = q * t + 0.7107068705f; q = q * t + (-0.142248368f); q = q * t + 0.127414796f; q = q * t;
    const f32x2 s = (v * v) * (-0.72134752044f);
    f32x2 e; e.x = __builtin_amdgcn_exp2f(s.x); e.y = __builtin_amdgcn_exp2f(s.y);
    const f32x2 m = v * (q * e), r = v - m;
    f32x2 o; o.x = v.x < 0.f ? m.x : r.x; o.y = v.y < 0.f ? m.y : r.y; return o;
}
__device__ __forceinline__ f32x4 gelu4(f32x4 v) { f32x2 a = gelu_pk((f32x2){v[0], v[1]}), b = gelu_pk((f32x2){v[2], v[3]}); return (f32x4){a.x, a.y, b.x, b.y}; }

namespace pg8 {
constexpr int BM = 256, BK = 64, HALF = 128, HTB = HALF * BK * 2, STAGE_BYTES = 8 * HTB, NXCD = 8, WGM = 4;
__host__ __device__ __forceinline__ int lds_byte(int r, int c) { const int st = (r >> 4) * 2 + (c >> 5), rr = r & 15, cc = c & 31, ob = rr * 64 + cc * 2; return st * 1024 + (ob ^ (((ob >> 9) & 1) << 5)); }
__host__ __device__ __forceinline__ void stage_rc(int b, int& R, int& C) { const int st = b / 1024, sb = b % 1024, swz = sb ^ (((sb >> 9) & 1) << 5); R = (st >> 1) * 16 + swz / 64; C = (st & 1) * 32 + (swz % 64) / 2; }
__host__ __device__ __forceinline__ int perm32(int rho) { const int n = rho >> 4, i = rho & 15; return 8 * (i >> 2) + 4 * n + (i & 3); }
struct Unit { int pm, pn; };
struct Gemm { const bf16_t* A; const bf16_t* Bt; int M, N, K; };
struct StaticOrder {
    int nM, nN, nwg, G, c, rowmode, wgm;
    __device__ void init(int M, int N, int G_, int c_, int wgm_ = WGM) { nM = M / BM; nN = N / BM; nwg = nM * nN; G = G_; c = c_; rowmode = 0; wgm = wgm_; }
    __device__ bool next(int i, Unit& u) const {
        const long L = (long)i * G + c; if (L >= nwg) return false;
        if (rowmode) { u.pm = i * 32 + (c & 7) * 4 + (c >> 6); u.pn = (c >> 3) & 7; return true; }
        int wgid = (int)L; { const int q = nwg / NXCD, r = nwg % NXCD, xcd = wgid % NXCD, off = wgid / NXCD; wgid = (xcd < r ? xcd * (q + 1) : r * (q + 1) + (xcd - r) * q) + off; }
        const int nig = wgm * nN, gid = wgid / nig, fm = gid * wgm, gsz = (nM - fm) < wgm ? (nM - fm) : wgm;
        u.pm = fm + ((wgid % nig) % gsz); u.pn = (wgid % nig) / gsz; return true;
    }
};

template <class Epi>
__device__ __forceinline__ void gemm_phase(LAS unsigned char* lds, const Gemm g, const StaticOrder& S, const Epi& E) {
    const int tid = threadIdx.x, wid = __builtin_amdgcn_readfirstlane(tid >> 6), lane = tid & 63, wr = wid >> 2, wc = wid & 3, fr = lane & 15, fq = lane >> 4;
    const int K = g.K, nt = K / BK;
    unsigned voffA[2], voffB[2];
#pragma unroll
    for (int i = 0; i < 2; ++i) { int R, C; stage_rc(tid * 16 + i * 8192, R, C); const int Rb = Epi::PERM ? ((R & ~31) + perm32(R & 31)) : R;
        voffA[i] = (unsigned)(R * K + C) * 2u; voffB[i] = (unsigned)(Rb * K + C) * 2u; }
    const size_t kstep = (size_t)(BK * 2);
    const size_t hstep = (size_t)HALF * K * 2;
    const size_t tstep = 2 * hstep;
    const unsigned ldsw = (unsigned)wid * 1024u;
    const int aoff = lds_byte(wr * 64 + fr, fq * 8), boff = lds_byte(wc * 32 + fr, fq * 8);
#define PG8_SA(b, h) (((b) * 2 + (h)) * HTB)
#define PG8_SB(b, h) ((4 + (b) * 2 + (h)) * HTB)
#define PG8_STAGE(bufoff, gbase, voff) do { _Pragma("unroll") for (int _i = 0; _i < 2; ++_i) \
        __builtin_amdgcn_global_load_lds((const unsigned*)((const char*)(gbase) + (voff)[_i]), (LAS unsigned*)(lds + (bufoff) + ldsw + _i * 8192), 16, 0, 0); } while (0)
#define PG8_LDA(dst, b, h) do { _Pragma("unroll") for (int m = 0; m < 4; ++m) _Pragma("unroll") for (int k = 0; k < 2; ++k) dst[m][k] = *(const LAS bf16x8*)(lds + PG8_SA(b, h) + aoff + m * 2048 + k * 1024); } while (0)
#define PG8_LDB(dst, b, h) do { _Pragma("unroll") for (int n = 0; n < 2; ++n) _Pragma("unroll") for (int k = 0; k < 2; ++k) dst[n][k] = *(const LAS bf16x8*)(lds + PG8_SB(b, h) + boff + n * 2048 + k * 1024); } while (0)
#define PG8_MMA(ai, bj, At, Bt) do { __builtin_amdgcn_s_setprio(1); _Pragma("unroll") for (int m = 0; m < 4; ++m) _Pragma("unroll") for (int n = 0; n < 2; ++n) _Pragma("unroll") for (int k = 0; k < 2; ++k) \
        acc[ai][bj][m][n] = __builtin_amdgcn_mfma_f32_16x16x32_bf16(Bt[n][k], At[m][k], acc[ai][bj][m][n], 0, 0, 0); __builtin_amdgcn_s_setprio(0); } while (0)
#define PG8_WAIT_V(n) asm volatile("s_waitcnt vmcnt(" #n ")" ::: "memory")
#define PG8_WAIT_L(n) asm volatile("s_waitcnt lgkmcnt(" #n ")" ::: "memory")
#define PG8_BAR __builtin_amdgcn_s_barrier()
#define PG8_SCHED __builtin_amdgcn_sched_barrier(0)
    Unit cur, nxt; int ui = 0;
    if (!S.next(0, cur)) return;
    f32x4 acc[2][2][4][2];
#pragma unroll
    for (int a = 0; a < 2; ++a)
#pragma unroll
        for (int b = 0; b < 2; ++b)
#pragma unroll
            for (int m = 0; m < 4; ++m)
#pragma unroll
                for (int n = 0; n < 2; ++n) acc[a][b][m][n] = (f32x4){0.f, 0.f, 0.f, 0.f};
    bf16x8 At[4][2], B0[2][2], B1[2][2];
    const char* cA = (const char*)g.A + (size_t)cur.pm * tstep; const char* cB = (const char*)g.Bt + (size_t)cur.pn * tstep;
    PG8_STAGE(PG8_SB(0, 0), cB, voffB); PG8_STAGE(PG8_SB(0, 1), cB + hstep, voffB); PG8_STAGE(PG8_SA(0, 0), cA, voffA); PG8_STAGE(PG8_SA(0, 1), cA + hstep, voffA);
    if (wr == 1) PG8_BAR;
    PG8_WAIT_V(2); PG8_BAR;
    PG8_STAGE(PG8_SB(1, 0), cB + kstep, voffB); PG8_STAGE(PG8_SA(1, 0), cA + kstep, voffA); PG8_STAGE(PG8_SB(1, 1), cB + hstep + kstep, voffB);
    PG8_WAIT_V(6); PG8_BAR;
    for (;;) {
        const bool has_next = S.next(ui + 1, nxt);
        const char* nA = has_next ? (const char*)g.A + (size_t)nxt.pm * tstep : cA; const char* nB = has_next ? (const char*)g.Bt + (size_t)nxt.pn * tstep : cB;
        for (int t = 0; t < nt; t += 2) {
            const bool last = (t == nt - 2);
            const char* a1 = cA + (size_t)(t + 1) * kstep;
            const char* a2 = last ? nA : cA + (size_t)(t + 2) * kstep; const char* b2 = last ? nB : cB + (size_t)(t + 2) * kstep;
            const char* a3 = a2 + kstep; const char* b3 = b2 + kstep;
            PG8_LDB(B0, 0, 0); PG8_LDB(B1, 0, 1); PG8_SCHED; PG8_LDA(At, 0, 0); PG8_STAGE(PG8_SA(1, 1), a1 + hstep, voffA);
            PG8_WAIT_V(8); PG8_WAIT_L(0); PG8_BAR; PG8_MMA(0, 0, At, B0); PG8_MMA(0, 1, At, B1); PG8_BAR; PG8_SCHED;
            PG8_LDA(At, 0, 1); PG8_STAGE(PG8_SB(0, 0), b2, voffB); PG8_STAGE(PG8_SB(0, 1), b2 + hstep, voffB); PG8_STAGE(PG8_SA(0, 0), a2, voffA);
            PG8_WAIT_V(8); PG8_WAIT_L(0); PG8_BAR; PG8_MMA(1, 0, At, B0); PG8_MMA(1, 1, At, B1); PG8_BAR; PG8_SCHED;
            PG8_LDB(B0, 1, 0); PG8_LDB(B1, 1, 1); PG8_SCHED; PG8_LDA(At, 1, 0); PG8_STAGE(PG8_SA(0, 1), a2 + hstep, voffA);
            PG8_WAIT_V(8); PG8_WAIT_L(0); PG8_BAR; PG8_MMA(0, 0, At, B0); PG8_MMA(0, 1, At, B1); PG8_BAR; PG8_SCHED;
            PG8_LDA(At, 1, 1); PG8_STAGE(PG8_SB(1, 0), b3, voffB); PG8_STAGE(PG8_SB(1, 1), b3 + hstep, voffB); PG8_STAGE(PG8_SA(1, 0), a3, voffA);
            PG8_WAIT_V(8); PG8_WAIT_L(0); PG8_BAR; PG8_MMA(1, 0, At, B0); PG8_MMA(1, 1, At, B1); PG8_BAR; PG8_SCHED;
        }
        if (wr == 0) PG8_BAR;
        E(acc, cur, wr, wc, fr, fq);
        if (!has_next) break;
#pragma unroll
        for (int a = 0; a < 2; ++a)
#pragma unroll
            for (int b = 0; b < 2; ++b)
#pragma unroll
                for (int m = 0; m < 4; ++m)
#pragma unroll
                    for (int n = 0; n < 2; ++n) acc[a][b][m][n] = (f32x4){0.f, 0.f, 0.f, 0.f};
        cur = nxt; cA = nA; cB = nB; ++ui;
        if (wr == 1) PG8_BAR;
    }
    PG8_WAIT_V(0);
    PG8_BAR;
#undef PG8_SA
#undef PG8_SB
#undef PG8_STAGE
#undef PG8_LDA
#undef PG8_LDB
#undef PG8_MMA
#undef PG8_WAIT_V
#undef PG8_WAIT_L
#undef PG8_BAR
#undef PG8_SCHED
}
}

typedef f32x4 AccT[2][2][4][2];
#define EROW(ai, m) (u.pm * 256 + (ai) * 128 + wr * 64 + (m) * 16 + fr)
#define ECOL0 (u.pn * 256 + wc * 32 + 8 * fq)

struct Epi1a { static constexpr bool PERM = true; bf16_t* O; int ldc;
    __device__ __forceinline__ void operator()(const AccT& acc, const pg8::Unit& u, int wr, int wc, int fr, int fq) const {
        const int col0 = ECOL0;
#pragma unroll
        for (int ai = 0; ai < 2; ++ai)
#pragma unroll
            for (int m = 0; m < 4; ++m) { bf16_t* rowp = O + (size_t)EROW(ai, m) * ldc + col0;
#pragma unroll
                for (int bj = 0; bj < 2; ++bj) *(u32x4*)(rowp + bj * 128) = pack8(acc[ai][bj][m][0], acc[ai][bj][m][1]); }
    } };
struct Epi1b { static constexpr bool PERM = true; bf16_t* O;
    __device__ __forceinline__ void operator()(const AccT& acc, const pg8::Unit& u, int wr, int wc, int fr, int fq) const {
        const int col0 = ECOL0; const int pn = u.pn;
        if (pn < 8) {
#pragma unroll
            for (int ai = 0; ai < 2; ++ai)
#pragma unroll
                for (int m = 0; m < 4; ++m) { bf16_t* rowp = O + (size_t)EROW(ai, m) * 6144 + col0;
#pragma unroll
                    for (int bj = 0; bj < 2; ++bj) *(u32x4*)(rowp + bj * 128) = pack8(gelu4(acc[ai][bj][m][0]), gelu4(acc[ai][bj][m][1])); }
        } else {
#pragma unroll
            for (int ai = 0; ai < 2; ++ai)
#pragma unroll
                for (int m = 0; m < 4; ++m) { bf16_t* rowp = O + (size_t)EROW(ai, m) * 6144 + col0;
#pragma unroll
                    for (int bj = 0; bj < 2; ++bj) { f32x4 v0 = acc[ai][bj][m][0], v1 = acc[ai][bj][m][1];
#pragma unroll
                        for (int j = 0; j < 4; ++j) { v0[j] = sigmoidf_(v0[j]); v1[j] = sigmoidf_(v1[j]); }
                        *(u32x4*)(rowp + bj * 128) = pack8(v0, v1); } }
        }
    } };
template <bool ADD> struct Epi4 { static constexpr bool PERM = true; bf16_t* O; const bf16_t* gate;
    __device__ __forceinline__ void operator()(const AccT& acc, const pg8::Unit& u, int wr, int wc, int fr, int fq) const {
        const int col0 = ECOL0;
#pragma unroll
        for (int ai = 0; ai < 2; ++ai) {
            u32x4 gt[4][2], pv[4][2];
#pragma unroll
            for (int m = 0; m < 4; ++m) { const int row = EROW(ai, m);
#pragma unroll
                for (int bj = 0; bj < 2; ++bj) { gt[m][bj] = *(const u32x4*)(gate + (size_t)row * 6144 + col0 + bj * 128); if (ADD) pv[m][bj] = *(const u32x4*)(O + (size_t)row * 2048 + col0 + bj * 128); } }
#pragma unroll
            for (int m = 0; m < 4; ++m) { bf16_t* rowp = O + (size_t)EROW(ai, m) * 2048 + col0;
#pragma unroll
                for (int bj = 0; bj < 2; ++bj) { f32x4 g0, g1; unpack8(gt[m][bj], g0, g1);
                    f32x4 v0 = acc[ai][bj][m][0] * g0, v1 = acc[ai][bj][m][1] * g1;
                    if (ADD) { f32x4 p0, p1; unpack8(pv[m][bj], p0, p1); v0 += p0; v1 += p1; }
                    *(u32x4*)(rowp + bj * 128) = pack8(v0, v1); } }
            asm volatile("" ::: "memory"); }
    } };
struct EpiRes { static constexpr bool PERM = true; const float* base; float* X;
    __device__ __forceinline__ void operator()(const AccT& acc, const pg8::Unit& u, int wr, int wc, int fr, int fq) const {
        const int col0 = ECOL0;
#pragma unroll
        for (int ai = 0; ai < 2; ++ai) {
            f32x4 bs[4][2][2];
#pragma unroll
            for (int m = 0; m < 4; ++m) { const size_t off = (size_t)EROW(ai, m) * 2048 + col0;
#pragma unroll
                for (int bj = 0; bj < 2; ++bj) { bs[m][bj][0] = *(const f32x4*)(base + off + bj * 128); bs[m][bj][1] = *(const f32x4*)(base + off + bj * 128 + 4); } }
#pragma unroll
            for (int m = 0; m < 4; ++m) { const size_t off = (size_t)EROW(ai, m) * 2048 + col0;
#pragma unroll
                for (int bj = 0; bj < 2; ++bj) { *(f32x4*)(X + off + bj * 128) = acc[ai][bj][m][0] + bs[m][bj][0]; *(f32x4*)(X + off + bj * 128 + 4) = acc[ai][bj][m][1] + bs[m][bj][1]; } }
            asm volatile("" ::: "memory"); }
    } };
struct Epi7 { static constexpr bool PERM = true; const float* base; float* X; float* ss2; unsigned* cnt; const float* g;
    __device__ __forceinline__ void operator()(AccT& acc, const pg8::Unit& u, int wr, int wc, int fr, int fq) const {
        const int col0 = ECOL0;
#pragma unroll
        for (int ai = 0; ai < 2; ++ai)
#pragma unroll
            for (int mh = 0; mh < 2; ++mh) {
                f32x4 bs[2][2][2];
#pragma unroll
                for (int mm = 0; mm < 2; ++mm) { const size_t off = (size_t)EROW(ai, mh * 2 + mm) * 2048 + col0;
#pragma unroll
                    for (int bj = 0; bj < 2; ++bj) { bs[mm][bj][0] = *(const f32x4*)(base + off + bj * 128); bs[mm][bj][1] = *(const f32x4*)(base + off + bj * 128 + 4); } }
#pragma unroll
                for (int mm = 0; mm < 2; ++mm) { const int m = mh * 2 + mm; const int row = EROW(ai, m); float q = 0.f;
#pragma unroll
                    for (int bj = 0; bj < 2; ++bj) { const f32x4 v0 = acc[ai][bj][m][0] + bs[mm][bj][0], v1 = acc[ai][bj][m][1] + bs[mm][bj][1]; acc[ai][bj][m][0] = v0; acc[ai][bj][m][1] = v1;
                        q += (v0[0] * v0[0] + v0[1] * v0[1]) + (v0[2] * v0[2] + v0[3] * v0[3]) + (v1[0] * v1[0] + v1[1] * v1[1]) + (v1[2] * v1[2] + v1[3] * v1[3]); }
                    q += __shfl_xor(q, 16); q += __shfl_xor(q, 32);
                    if (fq == 0) __hip_atomic_store(ss2 + (size_t)row * 32 + u.pn * 4 + wc, q, __ATOMIC_RELAXED, __HIP_MEMORY_SCOPE_AGENT); }
                asm volatile("" ::: "memory"); }
        asm volatile("s_waitcnt vmcnt(0)" ::: "memory");
        unsigned* cw = cnt + 16 * (u.pm * 2 + wr);
        if ((threadIdx.x & 63) == 0) __hip_atomic_fetch_add(cw, 1u, __ATOMIC_RELAXED, __HIP_MEMORY_SCOPE_AGENT);
        { unsigned spins = 0; while (__hip_atomic_load(cw, __ATOMIC_RELAXED, __HIP_MEMORY_SCOPE_AGENT) < 32u) { __builtin_amdgcn_s_sleep(1); if (++spins > (1u << 22)) break; } }
        f32x4 gv[2][2];
#pragma unroll
        for (int bj = 0; bj < 2; ++bj) { gv[bj][0] = *(const f32x4*)(g + col0 + bj * 128); gv[bj][1] = *(const f32x4*)(g + col0 + bj * 128 + 4); }
#pragma unroll
        for (int ai = 0; ai < 2; ++ai)
#pragma unroll
            for (int m = 0; m < 4; ++m) { const int row = EROW(ai, m); const float* sp = ss2 + (size_t)row * 32 + fq * 8; float pq[8];
#pragma unroll
                for (int k = 0; k < 8; ++k) pq[k] = __hip_atomic_load(sp + k, __ATOMIC_RELAXED, __HIP_MEMORY_SCOPE_AGENT);
                float q = ((pq[0] + pq[1]) + (pq[2] + pq[3])) + ((pq[4] + pq[5]) + (pq[6] + pq[7]));
                q += __shfl_xor(q, 16); q += __shfl_xor(q, 32);
                const float rs = rsqrtf(q * (1.0f / 2048.0f) + EPSV); const size_t off = (size_t)row * 2048 + col0;
#pragma unroll
                for (int bj = 0; bj < 2; ++bj) { *(f32x4*)(X + off + bj * 128) = acc[ai][bj][m][0] * rs * gv[bj][0]; *(f32x4*)(X + off + bj * 128 + 4) = acc[ai][bj][m][1] * rs * gv[bj][1]; } }
    } };
struct Epi5 { static constexpr bool PERM = true; const float* base; float* X; float* ssp; const float* g; bf16_t* Hn;
    __device__ __forceinline__ void operator()(const AccT& acc, const pg8::Unit& u, int wr, int wc, int fr, int fq) const {
        const int col0 = ECOL0;
        f32x4 gv[2][2];
#pragma unroll
        for (int bj = 0; bj < 2; ++bj) { gv[bj][0] = *(const f32x4*)(g + col0 + bj * 128); gv[bj][1] = *(const f32x4*)(g + col0 + bj * 128 + 4); }
#pragma unroll
        for (int ai = 0; ai < 2; ++ai) {
            f32x4 bs[4][2][2];
#pragma unroll
            for (int m = 0; m < 4; ++m) { const size_t off = (size_t)EROW(ai, m) * 2048 + col0;
#pragma unroll
                for (int bj = 0; bj < 2; ++bj) { bs[m][bj][0] = *(const f32x4*)(base + off + bj * 128); bs[m][bj][1] = *(const f32x4*)(base + off + bj * 128 + 4); } }
#pragma unroll
            for (int m = 0; m < 4; ++m) { const int row = EROW(ai, m); const size_t off = (size_t)row * 2048 + col0; float q = 0.f;
#pragma unroll
                for (int bj = 0; bj < 2; ++bj) { const f32x4 v0 = acc[ai][bj][m][0] + bs[m][bj][0], v1 = acc[ai][bj][m][1] + bs[m][bj][1];
                    *(f32x4*)(X + off + bj * 128) = v0; *(f32x4*)(X + off + bj * 128 + 4) = v1;
                    q += (v0[0] * v0[0] + v0[1] * v0[1]) + (v0[2] * v0[2] + v0[3] * v0[3]) + (v1[0] * v1[0] + v1[1] * v1[1]) + (v1[2] * v1[2] + v1[3] * v1[3]);
                    *(u32x4*)(Hn + off + bj * 128) = pack8(v0 * gv[bj][0], v1 * gv[bj][1]); }
                q += __shfl_xor(q, 16); q += __shfl_xor(q, 32);
                if (fq == 0) ssp[(size_t)row * 32 + u.pn * 4 + wc] = q; }
            asm volatile("" ::: "memory"); }
    } };
struct Epi6 { static constexpr bool PERM = true; bf16_t* O; const float* ssp; const LAS float* rsl; int pm0, pm1;
    __device__ __forceinline__ void operator()(const AccT& acc, const pg8::Unit& u, int wr, int wc, int fr, int fq) const {
        const int col0 = u.pn * 128 + wc * 32 + 8 * fq;
        float rsv[2][4];
        if (u.pm == pm0 || u.pm == pm1) { const int tb = (u.pm == pm0) ? 0 : 256;
#pragma unroll
            for (int ai = 0; ai < 2; ++ai)
#pragma unroll
                for (int m = 0; m < 4; ++m) rsv[ai][m] = rsl[tb + ai * 128 + wr * 64 + m * 16 + fr];
        } else {
#pragma unroll
            for (int ai = 0; ai < 2; ++ai)
#pragma unroll
                for (int m = 0; m < 4; ++m) { const int row = EROW(ai, m);
                    const f32x4 p0 = *(const f32x4*)(ssp + (size_t)row * 32 + fq * 8), p1 = *(const f32x4*)(ssp + (size_t)row * 32 + fq * 8 + 4);
                    float q = ((p0[0] + p0[1]) + (p0[2] + p0[3])) + ((p1[0] + p1[1]) + (p1[2] + p1[3]));
                    q += __shfl_xor(q, 16); q += __shfl_xor(q, 32);
                    rsv[ai][m] = rsqrtf(q * (1.0f / 2048.0f) + EPSV); }
        }
#pragma unroll
        for (int ai = 0; ai < 2; ++ai)
#pragma unroll
            for (int m = 0; m < 4; ++m) { const int row = EROW(ai, m); const float rs = rsv[ai][m];
                f32x4 h0, h1;
#pragma unroll
                for (int j = 0; j < 4; ++j) { const float g0 = acc[ai][0][m][0][j] * rs, u0 = acc[ai][1][m][0][j] * rs, g1 = acc[ai][0][m][1][j] * rs, u1 = acc[ai][1][m][1][j] * rs;
                    h0[j] = g0 * sigmoidf_(g0) * u0; h1[j] = g1 * sigmoidf_(g1) * u1; }
                *(u32x4*)(O + (size_t)row * DFF + col0) = pack8(h0, h1); }
    } };

__device__ __forceinline__ float block_sum(float v, float* red, int tid) {
    for (int o = 32; o >= 1; o >>= 1) v += __shfl_xor(v, o);
    __syncthreads();
    if ((tid & 63) == 0) red[tid >> 6] = v;
    __syncthreads();
    float s = 0.f;
#pragma unroll
    for (int i = 0; i < 8; ++i) s += red[i];
    return s;
}

__device__ __forceinline__ void tr_tile(const float* __restrict__ src, int N, int K, bf16_t* __restrict__ dst, int k0, int n0, int drow0, float* tile, int tid) {
#pragma unroll
    for (int i = 0; i < 2; ++i) { const int kk = (tid >> 4) + i * 32, n4 = (tid & 15) * 4;
        const f32x4 v = *(const f32x4*)(src + (size_t)(k0 + kk) * N + n0 + n4);
        tile[kk * 65 + n4 + 0] = v[0]; tile[kk * 65 + n4 + 1] = v[1]; tile[kk * 65 + n4 + 2] = v[2]; tile[kk * 65 + n4 + 3] = v[3]; }
    __syncthreads();
    const int n = tid >> 3, kg = tid & 7; f32x4 a, b;
#pragma unroll
    for (int j = 0; j < 4; ++j) { a[j] = tile[(kg * 8 + j) * 65 + n]; b[j] = tile[(kg * 8 + 4 + j) * 65 + n]; }
    *(u32x4*)(dst + (size_t)(drow0 + n) * K + k0 + kg * 8) = pack8(a, b);
    __syncthreads();
}

__device__ __forceinline__ float sconv(const bf16_t* __restrict__ row, int b, int s, float w0, float w1, float w2, float bias) {
    const bf16_t* p = row + b * 2048 + s;
    const float c = bf2f(p[0]); const float l = s > 0 ? bf2f(p[-1]) : 0.f; const float r = s < 2047 ? bf2f(p[1]) : 0.f;
    return w0 * l + w1 * c + w2 * r + bias;
}

#define XB_TMO      128
#define XB_XCNT(j)  (256  + 64 * (j))
#define XB_XSUB(j)  (1280 + 64 * (j))
#define XB_XGEN(j)  (2304 + 64 * (j))
#define XB_TOP      3328
#define XB_TOPGEN   3392
#define XCD_BAR_WORDS 3456
#define XB_SPIN_CAP (1u << 22)

__device__ __forceinline__ unsigned xb_ld(unsigned* p)              { return __hip_atomic_load(p, __ATOMIC_RELAXED, __HIP_MEMORY_SCOPE_AGENT); }
__device__ __forceinline__ unsigned xb_add(unsigned* p, unsigned v) { return __hip_atomic_fetch_add(p, v, __ATOMIC_RELAXED, __HIP_MEMORY_SCOPE_AGENT); }
__device__ __forceinline__ unsigned xb_xcc_id() { return (unsigned)__builtin_amdgcn_s_getreg((3 << 11) | 20) & 0xFu; }
#define XB_SPIN(cond, bar) do { unsigned _sp = 0; while (cond) { __builtin_amdgcn_s_sleep(1); \
    if ((++_sp & 255u) == 0u) { if (xb_ld(&(bar)[XB_TMO])) break; if (_sp > XB_SPIN_CAP) { atomicAdd(&(bar)[XB_TMO], 1u); break; } } } } while (0)

struct XcdBarrier {
    unsigned* bar; unsigned x;
    volatile LAS unsigned* st;
};

__device__ __forceinline__ XcdBarrier xcd_barrier_post(unsigned* bar, volatile LAS unsigned* st) {
    XcdBarrier b; b.bar = bar; b.x = xb_xcc_id(); b.st = st;
    if (threadIdx.x == 0) (void)xb_add(&bar[XB_XCNT(b.x)], 1u);
    return b;
}
__device__ __forceinline__ void xcd_barrier_complete(unsigned* bar, unsigned x, unsigned& nloc, unsigned& nx) {
    const unsigned G = gridDim.x * gridDim.y * gridDim.z;
    unsigned sum, cnt, mine, sp = 0u;
    for (;;) {
        sum = 0u; cnt = 0u; mine = 0u;
#pragma unroll
        for (unsigned j = 0; j < 16; ++j) { const unsigned c = xb_ld(&bar[XB_XCNT(j)]); sum += c; cnt += (c > 0u) ? 1u : 0u; mine = (j == x) ? c : mine; }
        if (sum == G) break;
        __builtin_amdgcn_s_sleep(1);
        if ((++sp & 255u) == 0u) { if (xb_ld(&bar[XB_TMO])) break; if (sp > XB_SPIN_CAP) { atomicAdd(&bar[XB_TMO], 1u); break; } }
    }
    nloc = mine > 0u ? mine : 1u; nx = cnt > 0u ? cnt : 1u;
}

__device__ __forceinline__ void xcd_barrier(const XcdBarrier& b) {
    asm volatile("s_waitcnt vmcnt(0)" ::: "memory");
    __syncthreads();
    if (threadIdx.x == 0) {
        unsigned* bar = b.bar;
        __builtin_amdgcn_s_waitcnt(0);
        unsigned nloc = b.st[0], nx = b.st[1];
        if (nloc == 0u) { xcd_barrier_complete(bar, b.x, nloc, nx); b.st[0] = nloc; b.st[1] = nx; }
        const unsigned old = xb_add(&bar[XB_XSUB(b.x)], 1u);
        const unsigned gen = old / nloc;
        if (old + 1u == (gen + 1u) * nloc) {
            __builtin_amdgcn_fence(__ATOMIC_RELEASE, "agent");
            asm volatile("s_waitcnt vmcnt(0)" ::: "memory");
            const unsigned og = xb_add(&bar[XB_TOP], 1u);
            const unsigned tg = og / nx;
            if (og + 1u == (tg + 1u) * nx) xb_add(&bar[XB_TOPGEN], 1u);
            else XB_SPIN(xb_ld(&bar[XB_TOPGEN]) == tg, bar);
            __builtin_amdgcn_fence(__ATOMIC_ACQUIRE, "agent");
            xb_add(&bar[XB_XGEN(b.x)], 1u);
            asm volatile("s_waitcnt vmcnt(0)" ::: "memory");
        } else {
            XB_SPIN(xb_ld(&bar[XB_XGEN(b.x)]) == gen, bar);
            __builtin_amdgcn_fence(__ATOMIC_ACQUIRE, "agent");
            asm volatile("s_waitcnt vmcnt(0)" ::: "memory");
        }
    }
    __syncthreads();
}


__device__ __forceinline__ void my_barrier(unsigned* bar, unsigned target) {
    asm volatile("s_waitcnt vmcnt(0)" ::: "memory");
    __syncthreads();
    if (threadIdx.x == 0) {
        __builtin_amdgcn_fence(__ATOMIC_RELEASE, "agent");
        asm volatile("s_waitcnt vmcnt(0)" ::: "memory");
        __hip_atomic_fetch_add(bar, 1u, __ATOMIC_RELAXED, __HIP_MEMORY_SCOPE_AGENT);
        while (__hip_atomic_load(bar, __ATOMIC_RELAXED, __HIP_MEMORY_SCOPE_AGENT) < target) __builtin_amdgcn_s_sleep(2);
        __builtin_amdgcn_fence(__ATOMIC_ACQUIRE, "agent");
        asm volatile("s_waitcnt vmcnt(0)" ::: "memory");
    }
    __syncthreads();
}

template <bool TOBF> __device__ __forceinline__ void rmsnorm_rows(const float* x, const float* __restrict__ g, bf16_t* ob, float* of, int bid, int G, int wave, int lane) {
    for (int row = bid * 8 + wave; row < NTOK; row += G * 8) {
        const float* xr = x + (size_t)row * DM; f32x4 v[8]; float q = 0.f;
#pragma unroll
        for (int i = 0; i < 8; ++i) { v[i] = *(const f32x4*)(xr + lane * 4 + i * 256); q += (v[i][0] * v[i][0] + v[i][1] * v[i][1]) + (v[i][2] * v[i][2] + v[i][3] * v[i][3]); }
        for (int o = 32; o >= 1; o >>= 1) q += __shfl_xor(q, o);
        const float rs = rsqrtf(q * (1.0f / 2048.0f) + EPSV);
#pragma unroll
        for (int i = 0; i < 8; ++i) { const f32x4 gg = *(const f32x4*)(g + lane * 4 + i * 256); const f32x4 y = v[i] * rs * gg;
            if (TOBF) { u32x2 w; w.x = cvt_pk_bf16(y[0], y[1]); w.y = cvt_pk_bf16(y[2], y[3]); *(u32x2*)(ob + (size_t)row * DM + lane * 4 + i * 256) = w; }
            else *(f32x4*)(of + (size_t)row * DM + lane * 4 + i * 256) = y; }
    }
}


#ifdef SELFCHK
__device__ __forceinline__ unsigned hsh(unsigned x) { x ^= x >> 16; x *= 0x7feb352du; x ^= x >> 15; x *= 0x846ca68bu; x ^= x >> 16; return x; }
__device__ __forceinline__ float wdot(const bf16_t* a, const bf16_t* b, int K, int lane) { float s = 0.f; for (int k = lane; k < K; k += 64) s += bf2f(a[k]) * bf2f(b[k]); for (int o = 32; o >= 1; o >>= 1) s += __shfl_xor(s, o); return s; }
__device__ __forceinline__ void chk_flag(unsigned* flags, bool bad, unsigned bit) { if (__any(bad) && (threadIdx.x & 63) == 0) atomicOr(flags, bit); }
__device__ __forceinline__ bool far(float got, float ref) { return !(fabsf(got - ref) <= 0.02f * fabsf(ref) + 0.02f); }
#define CHK(...) do { __VA_ARGS__ } while (0)
#else
#define CHK(...) do { } while (0)
#endif

__global__ void __launch_bounds__(NTHR, 2) fwd_megakernel(Params P) {
    extern __shared__ __attribute__((aligned(16))) unsigned char smem[];
    cg::grid_group grid = cg::this_grid();
    const int tid = threadIdx.x, lane = tid & 63, wave = tid >> 6;
    const int G = gridDim.x, bid = blockIdx.x;
    unsigned char* ws = P.ws;
    LAS unsigned char* lds = (LAS unsigned char*)smem;
    const int lo = P.lo, hi = P.hi;
#define IN(k) (lo <= (k) && (k) < hi)
#define SEAM(k) do { if ((k) + 1 < hi) { if (lo > (k) + 1000) grid.sync();   xcd_barrier(xb); } } while (0)

    { volatile LAS unsigned* stw = (volatile LAS unsigned*)(lds + 146400); if (tid < 2) stw[tid] = 0u; __syncthreads(); }
    const XcdBarrier xb = xcd_barrier_post((unsigned*)(ws + WS_BAR + 16384), (volatile LAS unsigned*)(lds + 146400));
    float* stats = (float*)(ws + WS_STATS); float* ss1 = (float*)(ws + WS_SS1); float* ss2 = (float*)(ws + WS_SS2); float* h3 = (float*)(ws + WS_H3);
    bf16_t* WinT = (bf16_t*)(ws + W_IN); bf16_t* WbhT = (bf16_t*)(ws + W_BH); bf16_t* WbsT = (bf16_t*)(ws + W_BS); bf16_t* WoutT = (bf16_t*)(ws + W_OUT);
    bf16_t* WfiT = (bf16_t*)(ws + W_FI); bf16_t* WfoT = (bf16_t*)(ws + W_FO);
    bf16_t* Hn = (bf16_t*)(ws + WS_R2); bf16_t* Yhy = (bf16_t*)(ws + WS_R2); bf16_t* Ysgu = (bf16_t*)(ws + WS_R2 + 33554432);
    bf16_t* PT = (bf16_t*)(ws + R3_PT); bf16_t* PROJ2 = (bf16_t*)(ws + R3_PROJ2); bf16_t* MERGED = (bf16_t*)(ws + R3_MERGED); bf16_t* H2 = (bf16_t*)(ws + R3_H2); bf16_t* HID = (bf16_t*)(ws + R3_HID);
    float* SSP = (float*)(ws + WS_R2);
    float* KF = P.out; bf16_t* YT = (bf16_t*)((unsigned char*)P.out + 33554432);

    auto weight_tiles = [&](int t_lo, int t_hi) {
            float* tile = (float*)smem;
            struct TJ { const float* src; bf16_t* dst; int K, N, k0, n0, mode; };
            auto decode = [&](int ti, TJ& j) {
                int li, ntl; j.mode = 0;
                if (ti < 1152) { j.src = P.in[2]; j.dst = WinT; j.K = 2048; j.N = 9216; li = ti; ntl = 36; }
                else if (ti < 1280) { j.src = P.in[18]; j.dst = WbhT; j.K = 1024; j.N = 2048; li = ti - 1152; ntl = 8; }
                else if (ti < 1408) { j.src = P.in[19]; j.dst = WbsT; j.K = 1024; j.N = 2048; li = ti - 1280; ntl = 8; }
                else if (ti < 1664) { j.src = P.in[20]; j.dst = WoutT; j.K = 2048; j.N = 2048; li = ti - 1408; ntl = 8; }
                else if (ti < 3072) { j.src = P.in[22]; j.dst = WfiT; j.K = 2048; j.N = 11264; li = ti - 1664; ntl = 44; j.mode = 1; }
                else { j.src = P.in[23]; j.dst = WfoT; j.K = 5632; j.N = 2048; li = ti - 3072; ntl = 8; }
                j.k0 = (li / ntl) * 64; j.n0 = (li % ntl) * 256; };
            f32x4 v[8]; TJ cur, nxt; int ti = t_lo + bid; bool have = ti < t_hi;
            if (have) { decode(ti, cur);
#pragma unroll
                for (int i = 0; i < 8; ++i) { const int idx = tid + i * NTHR, kk = idx >> 6, n4 = (idx & 63) * 4; v[i] = *(const f32x4*)(cur.src + (size_t)(cur.k0 + kk) * cur.N + cur.n0 + n4); } }
            while (have) {
#pragma unroll
                for (int i = 0; i < 8; ++i) { const int idx = tid + i * NTHR, kk = idx >> 6, n4 = (idx & 63) * 4; *(f32x4*)(tile + kk * 260 + (n4 ^ (((kk >> 3) & 7) << 2))) = v[i]; }
                __syncthreads();
                const int nti = ti + G; const bool hn = nti < t_hi;
                if (hn) { decode(nti, nxt);
#pragma unroll
                    for (int i = 0; i < 8; ++i) { const int idx = tid + i * NTHR, kk = idx >> 6, n4 = (idx & 63) * 4; v[i] = *(const f32x4*)(nxt.src + (size_t)(nxt.k0 + kk) * nxt.N + nxt.n0 + n4); } }
#pragma unroll
                for (int i = 0; i < 4; ++i) { const int item = tid + i * NTHR, n = item >> 3, kg = item & 7; f32x4 a, b;
#pragma unroll
                    for (int j = 0; j < 4; ++j) { a[j] = tile[(kg * 8 + j) * 260 + (n ^ (kg << 2))]; b[j] = tile[(kg * 8 + 4 + j) * 260 + (n ^ (kg << 2))]; }
                    int drow = cur.n0 + n;
                    if (cur.mode == 1) { const int up = drow >= DFF; const int jj = up ? drow - DFF : drow; drow = 256 * (jj >> 7) + (up ? 128 : 0) + (jj & 127); }
                    *(u32x4*)(cur.dst + (size_t)drow * cur.K + cur.k0 + kg * 8) = pack8(a, b); }
                __syncthreads();
                ti = nti; have = hn; cur = nxt;
            }
        __syncthreads();
    };
    if (((PHASE_MASK >> 0) & 1) && IN(0)) {
        weight_tiles(0, 1152);
        rmsnorm_rows<true>(P.in[0], P.in[1], Hn, nullptr, bid, G, wave, lane);
        {
            float* zf = (float*)smem; float* ha = zf + 8 * 40; float* hb = ha + 8 * 64;
            const float* w1 = P.in[5]; const float* b1 = P.in[6]; const float* w2 = P.in[7]; const float* b2 = P.in[8]; const float* w3 = P.in[9]; const float* b3 = P.in[10]; const float* fq_ = P.in[11];
            for (int pg = bid; pg < 256; pg += G) {
                const int pos = pg * 8 + wave;
                __syncthreads();
                if (lane < 33) {
                    float z;
                    if (lane == 0) z = (float)pos / 2047.0f;
                    else { const int mband = (lane - 1) & 15; const float f = 1e-4f + (float)mband * ((15.0f - 1e-4f) / 15.0f); const float w = (6.2831855f * (float)pos) / 2048.0f; const float a = f * w;
                        z = lane < 17 ? __cosf(a) : -__sinf(a); }
                    zf[wave * 40 + lane] = z;
                }
                __syncthreads();
                const float fr = fq_[lane];
                float a = b1[lane];
#pragma unroll 3
                for (int i = 0; i < 33; ++i) a += zf[wave * 40 + i] * w1[i * 64 + lane];
                ha[wave * 64 + lane] = __sinf(fr * a);
                __syncthreads();
                a = b2[lane];
#pragma unroll 8
                for (int i = 0; i < 64; ++i) a += ha[wave * 64 + i] * w2[i * 64 + lane];
                hb[wave * 64 + lane] = __sinf(fr * a);
                __syncthreads();
                a = b3[lane];
#pragma unroll 8
                for (int i = 0; i < 64; ++i) a += hb[wave * 64 + i] * w3[i * 64 + lane];
                h3[pos * 64 + lane] = __sinf(fr * a);
            }
            __syncthreads();
        }
        SEAM(0);
    }

    if (((PHASE_MASK >> 1) & 1) && IN(1)) {
        CHK(
            { const unsigned sid = bid * 8 + wave; unsigned* flags = (unsigned*)(ws + WS_BAR + 64); bool bad = false;
              { const int n = hsh(sid * 7 + 1) % 9216, k = (hsh(sid * 7 + 2) + lane) % 2048; bad |= WinT[(size_t)n * 2048 + k] != f2bf(P.in[2][(size_t)k * 9216 + n]); }
              { const int j = hsh(sid * 7 + 3) % 5632, k = (hsh(sid * 7 + 4) + lane) % 2048; const int rg = 256 * (j >> 7) + (j & 127);
                bad |= WfiT[(size_t)rg * 2048 + k] != f2bf(P.in[22][(size_t)k * 11264 + j]); bad |= WfiT[(size_t)(rg + 128) * 2048 + k] != f2bf(P.in[22][(size_t)k * 11264 + 5632 + j]); }
              { const int n = hsh(sid * 7 + 5) % 2048, k = (hsh(sid * 7 + 6) + lane) % 5632; bad |= WfoT[(size_t)n * 5632 + k] != f2bf(P.in[23][(size_t)k * 2048 + n]); }
              { const int n = hsh(sid * 7 + 5) % 2048, k = (hsh(sid * 7 + 6) + lane) % 1024; bad |= WbhT[(size_t)n * 1024 + k] != f2bf(P.in[18][(size_t)k * 2048 + n]); bad |= WbsT[(size_t)n * 1024 + k] != f2bf(P.in[19][(size_t)k * 2048 + n]); }
              { const int n = hsh(sid * 7 + 5) % 2048, k = (hsh(sid * 7 + 6) + lane) % 2048; bad |= WoutT[(size_t)n * 2048 + k] != f2bf(P.in[20][(size_t)k * 2048 + n]); }
              chk_flag(flags, bad, 1u); }
        );
        {
            const float* w4 = P.in[12]; float* Wl = (float*)smem;
            for (int cb = bid; cb < 256; cb += G) {
                __syncthreads();
                for (int idx = tid; idx < 1024; idx += NTHR) { const int cc = idx & 15, j = idx >> 4; Wl[cc * 64 + j] = w4[(size_t)j * 4096 + cb * 16 + cc]; }
                __syncthreads();
                for (int pp2 = 0; pp2 < 2; ++pp2) {
                    const int pos0 = (wave * 4 + pp2 * 2) * 64 + lane, pos1 = pos0 + 64;
                    float h0[64], h1[64];
#pragma unroll
                    for (int j4 = 0; j4 < 16; ++j4) { const f32x4 t0 = *(const f32x4*)(h3 + pos0 * 64 + j4 * 4), t1 = *(const f32x4*)(h3 + pos1 * 64 + j4 * 4);
#pragma unroll
                        for (int k = 0; k < 4; ++k) { h0[j4 * 4 + k] = t0[k]; h1[j4 * 4 + k] = t1[k]; } }
                    const float tt0 = (float)pos0 / 2047.0f, tt1 = (float)pos1 / 2047.0f;
                    for (int cc = 0; cc < 16; ++cc) {
                        const int col = cb * 16 + cc; const int dir = col >> 11, o = (col >> 10) & 1, c = col & 1023;
                        float a0 = 0.f, a1 = 0.f;
#pragma unroll
                        for (int j4 = 0; j4 < 16; ++j4) { const f32x4 w = *(const f32x4*)(Wl + cc * 64 + j4 * 4);
#pragma unroll
                            for (int k = 0; k < 4; ++k) { a0 += h0[j4 * 4 + k] * w[k]; a1 += h1[j4 * 4 + k] * w[k]; } }
                        const float ad = 3.0701134573f + (float)c * ((15.3505672866f - 3.0701134573f) / 1023.0f);
                        const float v0 = a0 * __expf(-tt0 * ad), v1 = a1 * __expf(-tt1 * ad);
                        float* kr = KF + (size_t)(o * 1024 + c) * 4096;
                        if (dir == 0) { kr[2048 + pos0] = v0; kr[2048 + pos1] = v1; }
                        else { if (pos0 >= 1) kr[2048 - pos0] = v0; else kr[0] = 0.f; kr[2048 - pos1] = v1; }
                    }
                }
            }
            __syncthreads();
        }
        {
            pg8::Gemm g{WinT, Hn, 3072, NTOK, DM}; pg8::StaticOrder S; S.init(3072, NTOK, G, bid);
            Epi1a E{PT, NTOK}; pg8::gemm_phase<Epi1a>(lds, g, S, E);
        }
        {
            pg8::Gemm g{Hn, WinT + (size_t)3072 * DM, NTOK, 6144, DM}; pg8::StaticOrder S; S.init(NTOK, 6144, G, bid);
            Epi1b E{PROJ2}; pg8::gemm_phase<Epi1b>(lds, g, S, E);
        }
        SEAM(1);
    }

    if (((PHASE_MASK >> 2) & 1) && IN(2)) {
        CHK(
            { const unsigned sid = bid * 8 + wave; unsigned* flags = (unsigned*)(ws + WS_BAR + 64);
              { const int ch = hsh(sid * 5 + 11) % 3072, tok = hsh(sid * 5 + 12) % 8192; const float ref = wdot(WinT + (size_t)ch * 2048, Hn + (size_t)tok * 2048, 2048, lane);
                chk_flag(flags, far(bf2f(PT[(size_t)ch * NTOK + tok]), ref), 2u); }
              { const int col = hsh(sid * 5 + 13) % 6144, tok = hsh(sid * 5 + 14) % 8192; const float r0 = wdot(Hn + (size_t)tok * 2048, WinT + (size_t)(3072 + col) * 2048, 2048, lane);
                const float ref = col < 2048 ? 0.5f * r0 * (1.0f + erff(r0 * 0.70710678f)) : 1.0f / (1.0f + expf(-r0));
                chk_flag(flags, far(bf2f(PROJ2[(size_t)tok * 6144 + col]), ref), 4u); } }
        );
        if (bid & 1) weight_tiles(1152, 3776);
        {
            unsigned char* Z1 = smem;
            unsigned char* Z2 = smem + 34816;
            unsigned char* KS = smem + 69632;
            bf16_t* KR = (bf16_t*)(smem + 137472);
            float* red = (float*)(smem + 145696);
            const float* scw = P.in[3]; const float* scb = P.in[4]; const float* hbias = P.in[13];
            for (int i = tid; i < 1024; i += NTHR) { const int buf = i >> 9, w = i & 511; const int off = (w < 256 ? 0 : 66 * 512 - 1024) + w * 4; *(unsigned*)((buf ? Z2 : Z1) + off) = 0u; }
            const int pp = wave & 1, gg = wave >> 1, li = lane & 15, lq = lane >> 4, bb = li & 7, jsel = li >> 3;
            const unsigned boff = (unsigned)(jsel * 512 + bb * 64 + ((lq ^ ((bb >> 2) << 1)) * 16));
            const int rcp_ = 7 - (li & 7); const int ksl = rcp_ * 8448 + 48 * (rcp_ & 3) + 2 * (2040 - 16 * pp - 8 * (li >> 3) + 8 * lq);
            float kv[8];
            if (bid < DH) { const float* kr0 = KF + (size_t)bid * 4096;
#pragma unroll
                for (int j = 0; j < 8; ++j) kv[j] = kr0[tid + j * NTHR]; }
            for (int c = bid; c < DH; c += G) {
                __syncthreads();
                {   const float w0 = scw[c], w1 = scw[3072 + c], w2 = scw[6144 + c], bs = scb[c];
                    for (int ch = tid; ch < 2048; ch += NTHR) { const int b = ch >> 8, s = (ch & 255) * 8; const bf16_t* src = PT + (size_t)c * NTOK + b * 2048 + s;
                        f32x4 fa, fb; unpack8(*(const u32x4*)src, fa, fb); const float fl = s > 0 ? bf2f(src[-1]) : 0.f, fr_ = s + 8 < 2048 ? bf2f(src[8]) : 0.f;
                        f32x4 oa, ob;
                        oa[0] = w0 * fl + w1 * fa[0] + w2 * fa[1] + bs; oa[1] = w0 * fa[0] + w1 * fa[1] + w2 * fa[2] + bs; oa[2] = w0 * fa[1] + w1 * fa[2] + w2 * fa[3] + bs; oa[3] = w0 * fa[2] + w1 * fa[3] + w2 * fb[0] + bs;
                        ob[0] = w0 * fa[3] + w1 * fb[0] + w2 * fb[1] + bs; ob[1] = w0 * fb[0] + w1 * fb[1] + w2 * fb[2] + bs; ob[2] = w0 * fb[1] + w1 * fb[2] + w2 * fb[3] + bs; ob[3] = w0 * fb[2] + w1 * fb[3] + w2 * fr_ + bs;
                        const int J = s >> 5, chunk = (s & 31) >> 3;
                        *(u32x4*)(Z1 + ((J + 2) * 8 + b) * 64 + ((chunk ^ ((b >> 2) << 1)) * 16)) = pack8(oa, ob); } }
                for (int o = 0; o < 2; ++o) {
                    float part = 0.f;
#pragma unroll
                    for (int j = 0; j < 8; ++j) { part += fabsf(kv[j]); KR[4095 - (tid + j * NTHR)] = f2bf(kv[j]); }
                    if (tid < 8) KR[4096 + tid] = 0;
                    const float scale = 1.0f / block_sum(part, red, tid);
                    {   const u32x4 c0 = *(const u32x4*)(KR + tid * 8), c1 = *(const u32x4*)(KR + tid * 8 + 8);
                        const unsigned D[8] = {c0.x, c0.y, c0.z, c0.w, c1.x, c1.y, c1.z, c1.w};
#pragma unroll
                        for (int r = 0; r < 8; ++r) { u32x4 w; const int sft = r >> 1;
                            if (r & 1) { w.x = __builtin_amdgcn_alignbit(D[sft + 1], D[sft], 16); w.y = __builtin_amdgcn_alignbit(D[sft + 2], D[sft + 1], 16); w.z = __builtin_amdgcn_alignbit(D[sft + 3], D[sft + 2], 16); w.w = __builtin_amdgcn_alignbit(D[sft + 4], D[sft + 3], 16); }
                            else { w.x = D[sft]; w.y = D[sft + 1]; w.z = D[sft + 2]; w.w = D[sft + 3]; }
                            *(u32x4*)(KS + r * 8448 + 48 * (r & 3) + tid * 16) = w; } }
                    __syncthreads();
                    {
                        const int nc = o == 0 ? c : c + G, no = o == 0 ? 1 : 0;
                        if (nc < DH) { const float* krn = KF + (size_t)(no * 1024 + nc) * 4096;
#pragma unroll
                            for (int j = 0; j < 8; ++j) kv[j] = krn[tid + j * NTHR]; } }
                    const unsigned char* Zin = o ? Z2 : Z1;
                    const int chx = (o == 0 ? 1024 : 2048) + c;
                    u32x2 xwv[8]; unsigned short xlv[8], xrv[8];
#pragma unroll
                    for (int a = 0; a < 8; ++a) { const int I = pp + 2 * (16 * gg + 2 * a + jsel); const int t0 = 16 * I + 4 * lq; const bf16_t* src = PT + (size_t)chx * NTOK + bb * 2048 + t0;
                        xwv[a] = *(const u32x2*)src; xlv[a] = t0 > 0 ? src[-1] : (unsigned short)0; xrv[a] = t0 + 4 < 2048 ? src[4] : (unsigned short)0; }
                    f32x4 acc[8];
#pragma unroll
                    for (int a = 0; a < 8; ++a) acc[a] = (f32x4){0.f, 0.f, 0.f, 0.f};
#define HY_LA(E) (*(const bf16x8*)(KS + ksl - 64 * (E)))
#define HY_LBJ(J0) (*(const bf16x8*)(Zin + (((J0) >= -1 && (J0) <= 63) ? ((J0) + 2) : 0) * 512 + boff))
                    {
                        bf16x8 aE[8], aO[8];
                        const int e0 = 16 * gg - 63;
#pragma unroll
                        for (int a2 = 0; a2 < 8; ++a2) { aE[a2] = HY_LA(e0 + 2 * a2); aO[a2] = HY_LA(e0 + 1 + 2 * a2); }
                        bf16x8 bfe = HY_LBJ(63);
                        for (int ib = 0; ib < 64; ib += 16) {
#pragma unroll
                            for (int k = 0; k < 8; ++k) { const int i = ib + 2 * k;
                                const bf16x8 bfo = HY_LBJ(62 - i);
#pragma unroll
                                for (int a2 = 0; a2 < 8; ++a2) acc[a2] = __builtin_amdgcn_mfma_f32_16x16x32_bf16(aE[(a2 + k) & 7], bfe, acc[a2], 0, 0, 0);
                                aE[k & 7] = HY_LA(e0 + i + 16);
                                bfe = HY_LBJ(61 - i);
#pragma unroll
                                for (int a2 = 0; a2 < 8; ++a2) acc[a2] = __builtin_amdgcn_mfma_f32_16x16x32_bf16(aO[(a2 + k) & 7], bfo, acc[a2], 0, 0, 0);
                                aO[k & 7] = HY_LA(e0 + i + 17);
                            }
                        }
#pragma unroll
                        for (int a2 = 0; a2 < 8; ++a2) acc[a2] = __builtin_amdgcn_mfma_f32_16x16x32_bf16(aE[a2], bfe, acc[a2], 0, 0, 0);
                    }
#undef HY_LA
#undef HY_LBJ
                    const float bo = hbias[o * 1024 + c];
                    const float w0 = scw[chx], w1 = scw[3072 + chx], w2 = scw[6144 + chx], bs = scb[chx];
#pragma unroll
                    for (int a = 0; a < 8; ++a) { const int I = pp + 2 * (16 * gg + 2 * a + jsel); const int t0 = 16 * I + 4 * lq;
                        const int zaddr = ((t0 >> 5) + 2) * 512 + bb * 64 + ((((t0 & 31) >> 3) ^ ((bb >> 2) << 1)) * 16) + (t0 & 7) * 2;
                        const u32x2 zw = *(const u32x2*)(Zin + zaddr);
                        const float z0 = __uint_as_float(zw.x << 16), z1 = __uint_as_float(zw.x & 0xffff0000u), z2 = __uint_as_float(zw.y << 16), z3 = __uint_as_float(zw.y & 0xffff0000u);
                        const u32x2 xw = xwv[a];
                        const float x0 = __uint_as_float(xw.x << 16), x1 = __uint_as_float(xw.x & 0xffff0000u), x2 = __uint_as_float(xw.y << 16), x3 = __uint_as_float(xw.y & 0xffff0000u);
                        const float xl = bf2f(xlv[a]), xr = bf2f(xrv[a]);
                        const float r0 = (w0 * xl + w1 * x0 + w2 * x1 + bs) * (acc[a][0] * scale + z0 * bo), r1 = (w0 * x0 + w1 * x1 + w2 * x2 + bs) * (acc[a][1] * scale + z1 * bo);
                        const float r2 = (w0 * x1 + w1 * x2 + w2 * x3 + bs) * (acc[a][2] * scale + z2 * bo), r3 = (w0 * x2 + w1 * x3 + w2 * xr + bs) * (acc[a][3] * scale + z3 * bo);
                        u32x2 w; w.x = cvt_pk_bf16(r0, r1); w.y = cvt_pk_bf16(r2, r3);
                        if (o == 0) *(u32x2*)(Z2 + zaddr) = w; else *(u32x2*)(YT + (size_t)c * NTOK + bb * 2048 + t0) = w; }
                    __syncthreads();
                }
            }
        }
        {
            bf16_t* Wl = (bf16_t*)smem;
            bf16_t* Vl = (bf16_t*)(smem + 36864);
            float* stl = (float*)(smem + 73728);
            const float* lng = P.in[14]; const float* lnb = P.in[15]; const float* w_s = P.in[16]; const float* b_s = P.in[17];
            const int li = lane & 15, lq = lane >> 4;
            for (int item = bid; item < 256; item += G) {
              const int bn = item >> 1, tok0 = bn * 128;
              __syncthreads();
              for (int qb = 0; qb < 4; ++qb) {
                  u32x4 raw[4][2];
#pragma unroll
                  for (int k = 0; k < 4; ++k) { const bf16_t* vp = PROJ2 + (size_t)(tok0 + wave * 16 + qb * 4 + k) * 6144 + 1024 + lane * 16; raw[k][0] = *(const u32x4*)vp; raw[k][1] = *(const u32x4*)(vp + 8); }
#pragma unroll
                  for (int k = 0; k < 4; ++k) { const int q = wave * 16 + qb * 4 + k;
                      f32x4 a0, a1, a2, a3; unpack8(raw[k][0], a0, a1); unpack8(raw[k][1], a2, a3);
                      float sm = 0.f, sq = 0.f;
#pragma unroll
                      for (int j = 0; j < 4; ++j) { sm += (a0[j] + a1[j]) + (a2[j] + a3[j]); sq += (a0[j] * a0[j] + a1[j] * a1[j]) + (a2[j] * a2[j] + a3[j] * a3[j]); }
                      for (int o = 32; o >= 1; o >>= 1) { sm += __shfl_xor(sm, o); sq += __shfl_xor(sq, o); }
                      if (lane == 0) { const float mean = sm * (1.0f / 1024.0f); const float var = sq * (1.0f / 1024.0f) - mean * mean; stl[2 * q] = mean; stl[2 * q + 1] = rsqrtf(var + EPSV); } }
              }
              for (int hh = 0; hh < 4; ++hh) {
                const int h = (item & 1) * 4 + hh;
                __syncthreads();
                for (int ch = tid; ch < 2048; ch += NTHR) {
                    { const int p = ch >> 4, q8 = (ch & 15) * 8; const float* wp = w_s + (size_t)h * 16384 + p * 128 + q8;
                      *(u32x4*)(Wl + p * 144 + q8) = pack8(*(const f32x4*)wp, *(const f32x4*)(wp + 4)); }
                    { const int q = ch >> 4, c8 = (ch & 15) * 8; const float sm = stl[2 * q], rstd = stl[2 * q + 1];
                      f32x4 va, vb; unpack8(*(const u32x4*)(PROJ2 + (size_t)(tok0 + q) * 6144 + 1024 + h * 128 + c8), va, vb);
                      const f32x4 ga = *(const f32x4*)(lng + h * 128 + c8), gb = *(const f32x4*)(lng + h * 128 + c8 + 4), ba = *(const f32x4*)(lnb + h * 128 + c8), bb_ = *(const f32x4*)(lnb + h * 128 + c8 + 4);
                      va = (va - sm) * rstd * ga + ba; vb = (vb - sm) * rstd * gb + bb_;
#pragma unroll
                      for (int j = 0; j < 4; ++j) { Vl[(c8 + j) * 144 + q] = f2bf(va[j]); Vl[(c8 + 4 + j) * 144 + q] = f2bf(vb[j]); } }
                }
                __syncthreads();
                f32x4 acc[8];
#pragma unroll
                for (int ct = 0; ct < 8; ++ct) acc[ct] = (f32x4){0.f, 0.f, 0.f, 0.f};
#pragma unroll
                for (int kk = 0; kk < 4; ++kk) { const bf16x8 wf = *(const bf16x8*)(Wl + (wave * 16 + li) * 144 + kk * 32 + lq * 8);
#pragma unroll
                    for (int ct = 0; ct < 8; ++ct) { const bf16x8 vf = *(const bf16x8*)(Vl + (ct * 16 + li) * 144 + kk * 32 + lq * 8);
                        acc[ct] = __builtin_amdgcn_mfma_f32_16x16x32_bf16(vf, wf, acc[ct], 0, 0, 0); } }
                {   const int p = wave * 16 + li, tok = tok0 + p; const float bs = b_s[h * 128 + p];
#pragma unroll
                    for (int ct = 0; ct < 8; ++ct) { const int cc = h * 128 + ct * 16 + lq * 4; const u32x2 uw = *(const u32x2*)(PROJ2 + (size_t)tok * 6144 + cc);
                        const float u0 = __uint_as_float(uw.x << 16), u1 = __uint_as_float(uw.x & 0xffff0000u), u2 = __uint_as_float(uw.y << 16), u3 = __uint_as_float(uw.y & 0xffff0000u);
                        u32x2 w; w.x = cvt_pk_bf16(u0 * (acc[ct][0] + bs), u1 * (acc[ct][1] + bs)); w.y = cvt_pk_bf16(u2 * (acc[ct][2] + bs), u3 * (acc[ct][3] + bs));
                        *(u32x2*)(Ysgu + (size_t)tok * 1024 + cc) = w; } }
              }
            }
            __syncthreads();
        }
        if (!(bid & 1)) weight_tiles(1152, 3776);
        SEAM(2);
    }

    if (((PHASE_MASK >> 3) & 1) && IN(3)) {
        auto ytrans = [&]() {
        bf16_t* tile = (bf16_t*)smem;
        u32x4 v[4]; int ti = bid; bool have = ti < 1024;
        if (have) { const int c0 = (ti & 15) * 64, t0 = (ti >> 4) * 256;
#pragma unroll
            for (int i = 0; i < 4; ++i) { const int idx = tid + i * NTHR, cr = idx >> 5, tg = idx & 31; v[i] = *(const u32x4*)(YT + (size_t)(c0 + cr) * NTOK + t0 + tg * 8); } }
        while (have) {
            const int c0 = (ti & 15) * 64, t0 = (ti >> 4) * 256;
#pragma unroll
            for (int i = 0; i < 4; ++i) { const int idx = tid + i * NTHR, cr = idx >> 5, tg = idx & 31; *(u32x4*)(tile + cr * 264 + tg * 8) = v[i]; }
            __syncthreads();
            const int nti = ti + G; const bool hn = nti < 1024;
            if (hn) { const int nc0 = (nti & 15) * 64, nt0 = (nti >> 4) * 256;
#pragma unroll
                for (int i = 0; i < 4; ++i) { const int idx = tid + i * NTHR, cr = idx >> 5, tg = idx & 31; v[i] = *(const u32x4*)(YT + (size_t)(nc0 + cr) * NTOK + nt0 + tg * 8); } }
#pragma unroll
            for (int i = 0; i < 4; ++i) { const int item = tid + i * NTHR, tr = item >> 3, cg8 = item & 7; unsigned short e[8];
#pragma unroll
                for (int j = 0; j < 8; ++j) e[j] = tile[(cg8 * 8 + j) * 264 + tr];
                u32x4 w; w.x = e[0] | ((unsigned)e[1] << 16); w.y = e[2] | ((unsigned)e[3] << 16); w.z = e[4] | ((unsigned)e[5] << 16); w.w = e[6] | ((unsigned)e[7] << 16);
                *(u32x4*)(Yhy + (size_t)(t0 + tr) * 1024 + c0 + cg8 * 8) = w; }
            __syncthreads();
            ti = nti; have = hn;
        }
        };
        if (bid & 1) ytrans();
        {   pg8::Gemm g{Ysgu, WbsT, NTOK, DM, DH}; pg8::StaticOrder S; S.init(NTOK, DM, G, bid);
            Epi4<false> E{MERGED, PROJ2 + 4096}; pg8::gemm_phase<Epi4<false>>(lds, g, S, E); }
        if (!(bid & 1)) ytrans();
        SEAM(3);
    }
#ifdef DBG_CUT3
    {
        for (size_t i = (size_t)bid * NTHR + tid; i < (size_t)NTOK * 2048; i += (size_t)G * NTHR) { const int row = (int)(i >> 11), c = (int)(i & 2047);
            P.out[i] = c < 1024 ? bf2f(Yhy[(size_t)row * 1024 + c]) : bf2f(Ysgu[(size_t)row * 1024 + c - 1024]); }
        return;
    }
#endif
    if (((PHASE_MASK >> 4) & 1) && IN(4)) {
        {   pg8::Gemm g{Yhy, WbhT, NTOK, DM, DH}; pg8::StaticOrder S; S.init(NTOK, DM, G, bid);
            Epi4<true> E{MERGED, PROJ2 + 2048}; pg8::gemm_phase<Epi4<true>>(lds, g, S, E); }
        SEAM(4);
    }

    if (((PHASE_MASK >> 5) & 1) && IN(5)) {
        pg8::Gemm g{MERGED, WoutT, NTOK, DM, DM}; pg8::StaticOrder S; S.init(NTOK, DM, G, bid);
        Epi5 E{P.in[0], P.out, SSP, P.in[21], H2}; pg8::gemm_phase<Epi5>(lds, g, S, E);
        SEAM(5);
    }
    if (((PHASE_MASK >> 6) & 1) && IN(6)) {
        pg8::Gemm g{H2, WfiT, NTOK, 2 * DFF, DM}; pg8::StaticOrder S; S.init(NTOK, 2 * DFF, G, bid, 8);
        pg8::Unit u0, u1; S.next(0, u0); u1 = u0; for (int i = 1; ; ++i) { pg8::Unit t; if (!S.next(i, t)) break; u1 = t; }
        {   float* rst = (float*)(smem + 131072);
            for (int r = tid; r < 512; r += NTHR) { const int pmr = r < 256 ? u0.pm : u1.pm; const float* sp = SSP + (size_t)(pmr * 256 + (r & 255)) * 32; float q4[4];
#pragma unroll
                for (int k = 0; k < 4; ++k) { const f32x4 p0 = *(const f32x4*)(sp + k * 8), p1 = *(const f32x4*)(sp + k * 8 + 4); q4[k] = ((p0[0] + p0[1]) + (p0[2] + p0[3])) + ((p1[0] + p1[1]) + (p1[2] + p1[3])); }
                rst[r] = rsqrtf(((q4[0] + q4[1]) + (q4[2] + q4[3])) * (1.0f / 2048.0f) + EPSV); }
            __syncthreads(); }
        Epi6 E{HID, SSP, (const LAS float*)(smem + 131072), u0.pm, u1.pm}; pg8::gemm_phase<Epi6>(lds, g, S, E);
        SEAM(6);
    }
    const bool fuse78 = (G == 256);
    if (((PHASE_MASK >> 7) & 1) && IN(7)) {
        pg8::Gemm g{HID, WfoT, NTOK, DM, DFF}; pg8::StaticOrder S; S.init(NTOK, DM, G, bid);
        if (fuse78) { S.rowmode = 1; Epi7 E{P.out, P.out, (float*)(ws + WS_R2 + 4194304), (unsigned*)(ws + WS_BAR + 1024), P.in[24]}; pg8::gemm_phase<Epi7>(lds, g, S, E); }
        else { EpiRes E{P.out, P.out}; pg8::gemm_phase<EpiRes>(lds, g, S, E); SEAM(7); }
    }
    if (((PHASE_MASK >> 8) & 1) && IN(8) && !fuse78) {
        rmsnorm_rows<false>(P.out, P.in[24], nullptr, P.out, bid, G, wave, lane);
    }
#undef IN
#undef SEAM
}

extern "C" void kernel_launch(void* const* d_in, const int* in_sizes, int n_in, void* d_out, int out_size, void* d_ws, size_t ws_size, hipStream_t stream) {
    static int grid_blocks = 0;
    if (grid_blocks == 0) {
        if (n_in != 25 || out_size != NTOK * DM || ws_size < WS_END) { fprintf(stderr, "kernel_launch: unexpected shapes n_in %d out %d ws %zu (need %zu)\n", n_in, out_size, ws_size, (size_t)WS_END); grid_blocks = -1; return; }
        int dev = 0, cus = 0, per_cu = 0;
        hipGetDevice(&dev);
        hipDeviceGetAttribute(&cus, hipDeviceAttributeMultiprocessorCount, dev);
        if (hipFuncSetAttribute((const void*)fwd_megakernel, hipFuncAttributeMaxDynamicSharedMemorySize, LDS_BYTES) != hipSuccess) { fprintf(stderr, "kernel_launch: hipFuncSetAttribute failed\n"); grid_blocks = -1; return; }
        if (hipOccupancyMaxActiveBlocksPerMultiprocessor(&per_cu, (const void*)fwd_megakernel, NTHR, LDS_BYTES) != hipSuccess || per_cu < 1) { fprintf(stderr, "kernel_launch: occupancy query gave %d\n", per_cu); per_cu = 1; }
        (void)hipGetLastError();
        grid_blocks = cus * per_cu;
    }
    if (grid_blocks < 0) return;
    if (hipMemsetAsync((char*)d_ws + WS_BAR, 0, 32768, stream) != hipSuccess) { fprintf(stderr, "kernel_launch: memset failed\n"); return; }
    Params p{};
    for (int i = 0; i < 25; ++i) p.in[i] = (const float*)d_in[i];
    p.out = (float*)d_out; p.ws = (unsigned char*)d_ws; p.lo = 0; p.hi = 9;
    void* args[] = {&p};
    hipError_t e = hipLaunchCooperativeKernel((const void*)fwd_megakernel, dim3(grid_blocks), dim3(NTHR), args, LDS_BYTES, stream);
    if (e != hipSuccess) fprintf(stderr, "cooperative launch failed: %s (grid %d)\n", hipGetErrorString(e), grid_blocks);
}
```

```cpp
#include <hip/hip_runtime.h>
#include <hip/hip_cooperative_groups.h>
#include <cstdio>
namespace cg = cooperative_groups;

#define LAS __attribute__((address_space(3)))
typedef unsigned short bf16_t;
typedef short bf16x8 __attribute__((ext_vector_type(8)));
typedef float f32x4 __attribute__((ext_vector_type(4)));
typedef float f32x2 __attribute__((ext_vector_type(2)));
typedef unsigned u32x4 __attribute__((ext_vector_type(4)));
typedef unsigned u32x2 __attribute__((ext_vector_type(2)));

constexpr int NTOK = 16384, DM = 2048, DH = 1024, DFF = 5632, SEQ = 2048;
constexpr float EPSV = 1e-6f;
constexpr int NTHR = 512;
#ifndef PHASE_MASK
#define PHASE_MASK 0x3ff
#endif
constexpr int LDS_BYTES = 146432;

constexpr size_t WS_STATS = 0;
constexpr size_t WS_SS1 = 131072;
constexpr size_t WS_SS2 = 196608;
constexpr size_t WS_H3 = 262144;
constexpr size_t WS_BAR = 917504;
constexpr size_t WS_W = 1048576;
constexpr size_t W_IN = WS_W;
constexpr size_t W_BH = W_IN + 37748736;
constexpr size_t W_BS = W_BH + 4194304;
constexpr size_t W_OUT = W_BS + 4194304;
constexpr size_t W_FI = W_OUT + 8388608;
constexpr size_t W_FO = W_FI + 46137344;
constexpr size_t WS_R2 = W_FO + 23068672;
constexpr size_t WS_R3 = WS_R2 + 67108864;
constexpr size_t R3_PT = WS_R3;
constexpr size_t R3_PROJ2 = WS_R3 + 100663296;
constexpr size_t R3_MERGED = WS_R3;
constexpr size_t R3_H2 = WS_R3 + 184549376;
constexpr size_t R3_HID = WS_R3;
constexpr size_t WS_END = WS_R3 + 301989888;

struct Params { const float* in[25]; float* out; unsigned char* ws; int lo, hi; };

__device__ __forceinline__ float bf2f(bf16_t b) { return __uint_as_float(((unsigned)b) << 16); }
__device__ __forceinline__ bf16_t f2bf(float f) { unsigned u = __float_as_uint(f); u += 0x7FFFu + ((u >> 16) & 1u); return (bf16_t)(u >> 16); }
typedef __bf16 bf16x2_t __attribute__((ext_vector_type(2)));
__device__ __forceinline__ unsigned cvt_pk_bf16(float lo, float hi) { f32x2 v = {lo, hi}; bf16x2_t b = __builtin_convertvector(v, bf16x2_t); return __builtin_bit_cast(unsigned, b); }
__device__ __forceinline__ u32x4 pack8(f32x4 a, f32x4 b) { u32x4 w; w.x = cvt_pk_bf16(a[0], a[1]); w.y = cvt_pk_bf16(a[2], a[3]); w.z = cvt_pk_bf16(b[0], b[1]); w.w = cvt_pk_bf16(b[2], b[3]); return w; }
__device__ __forceinline__ void unpack8(u32x4 w, f32x4& a, f32x4& b) {
    a[0] = __uint_as_float(w.x << 16); a[1] = __uint_as_float(w.x & 0xffff0000u); a[2] = __uint_as_float(w.y << 16); a[3] = __uint_as_float(w.y & 0xffff0000u);
    b[0] = __uint_as_float(w.z << 16); b[1] = __uint_as_float(w.z & 0xffff0000u); b[2] = __uint_as_float(w.w << 16); b[3] = __uint_as_float(w.w & 0xffff0000u); }
__device__ __forceinline__ float sigmoidf_(float x) { return __builtin_amdgcn_rcpf(1.0f + __expf(-x)); }
__device__ __forceinline__ f32x2 gelu_pk(f32x2 v) {
    const f32x2 av = __builtin_elementwise_abs(v), d = av * 0.2316418882f + 1.0f;
    f32x2 t; t.x = __builtin_amdgcn_rcpf(d.x); t.y = __builtin_amdgcn_rcpf(d.y);
    f32x2 q = t * 0.5307027145f + (-0.7265760135f); q = q * t + 0.7107068705f; q = q * t + (-0.142248368f); q = q * t + 0.127414796f; q = q * t;
    const f32x2 s = (v * v) * (-0.72134752044f);
    f32x2 e; e.x = __builtin_amdgcn_exp2f(s.x); e.y = __builtin_amdgcn_exp2f(s.y);
    const f32x2 m = v * (q * e), r = v - m;
    f32x2 o; o.x = v.x < 0.f ? m.x : r.x; o.y = v.y < 0.f ? m.y : r.y; return o;
}
__device__ __forceinline__ f32x4 gelu4(f32x4 v) { f32x2 a = gelu_pk((f32x2){v[0], v[1]}), b = gelu_pk((f32x2){v[2], v[3]}); return (f32x4){a.x, a.y, b.x, b.y}; }

namespace pg8 {
constexpr int BM = 256, BK = 64, HALF = 128, HTB = HALF * BK * 2, STAGE_BYTES = 8 * HTB, NXCD = 8, WGM = 4;
__host__ __device__ __forceinline__ int lds_byte(int r, int c) { const int st = (r >> 4) * 2 + (c >> 5), rr = r & 15, cc = c & 31, ob = rr * 64 + cc * 2; return st * 1024 + (ob ^ (((ob >> 9) & 1) << 5)); }
__host__ __device__ __forceinline__ void stage_rc(int b, int& R, int& C) { const int st = b / 1024, sb = b % 1024, swz = sb ^ (((sb >> 9) & 1) << 5); R = (st >> 1) * 16 + swz / 64; C = (st & 1) * 32 + (swz % 64) / 2; }
__host__ __device__ __forceinline__ int perm32(int rho) { const int n = rho >> 4, i = rho & 15; return 8 * (i >> 2) + 4 * n + (i & 3); }
struct Unit { int pm, pn; };
struct Gemm { const bf16_t* A; const bf16_t* Bt; int M, N, K; };
struct StaticOrder {
    int nM, nN, nwg, G, c, rowmode, wgm;
    __device__ void init(int M, int N, int G_, int c_, int wgm_ = WGM) { nM = M / BM; nN = N / BM; nwg = nM * nN; G = G_; c = c_; rowmode = 0; wgm = wgm_; }
    __device__ bool next(int i, Unit& u) const {
        const long L = (long)i * G + c; if (L >= nwg) return false;
        if (rowmode) { u.pm = i * 32 + (c & 7) * 4 + (c >> 6); u.pn = (c >> 3) & 7; return true; }
        int wgid = (int)L; { const int q = nwg / NXCD, r = nwg % NXCD, xcd = wgid % NXCD, off = wgid / NXCD; wgid = (xcd < r ? xcd * (q + 1) : r * (q + 1) + (xcd - r) * q) + off; }
        const int nig = wgm * nN, gid = wgid / nig, fm = gid * wgm, gsz = (nM - fm) < wgm ? (nM - fm) : wgm;
        u.pm = fm + ((wgid % nig) % gsz); u.pn = (wgid % nig) / gsz; return true;
    }
};

template <class Epi>
__device__ __forceinline__ void gemm_phase(LAS unsigned char* lds, const Gemm g, const StaticOrder& S, const Epi& E) {
    const int tid = threadIdx.x, wid = __builtin_amdgcn_readfirstlane(tid >> 6), lane = tid & 63, wr = wid >> 2, wc = wid & 3, fr = lane & 15, fq = lane >> 4;
    const int K = g.K, nt = K / BK;
    unsigned voffA[2], voffB[2];
#pragma unroll
    for (int i = 0; i < 2; ++i) { int R, C; stage_rc(tid * 16 + i * 8192, R, C); const int Rb = Epi::PERM ? ((R & ~31) + perm32(R & 31)) : R;
        voffA[i] = (unsigned)(R * K + C) * 2u; voffB[i] = (unsigned)(Rb * K + C) * 2u; }
    const size_t kstep = (size_t)(BK * 2);
    const size_t hstep = (size_t)HALF * K * 2;
    const size_t tstep = 2 * hstep;
    const unsigned ldsw = (unsigned)wid * 1024u;
    const int aoff = lds_byte(wr * 64 + fr, fq * 8), boff = lds_byte(wc * 32 + fr, fq * 8);
#define PG8_SA(b, h) (((b) * 2 + (h)) * HTB)
#define PG8_SB(b, h) ((4 + (b) * 2 + (h)) * HTB)
#define PG8_STAGE(bufoff, gbase, voff) do { _Pragma("unroll") for (int _i = 0; _i < 2; ++_i) \
        __builtin_amdgcn_global_load_lds((const unsigned*)((const char*)(gbase) + (voff)[_i]), (LAS unsigned*)(lds + (bufoff) + ldsw + _i * 8192), 16, 0, 0); } while (0)
#define PG8_LDA(dst, b, h) do { _Pragma("unroll") for (int m = 0; m < 4; ++m) _Pragma("unroll") for (int k = 0; k < 2; ++k) dst[m][k] = *(const LAS bf16x8*)(lds + PG8_SA(b, h) + aoff + m * 2048 + k * 1024); } while (0)
#define PG8_LDB(dst, b, h) do { _Pragma("unroll") for (int n = 0; n < 2; ++n) _Pragma("unroll") for (int k = 0; k < 2; ++k) dst[n][k] = *(const LAS bf16x8*)(lds + PG8_SB(b, h) + boff + n * 2048 + k * 1024); } while (0)
#define PG8_MMA(ai, bj, At, Bt) do { __builtin_amdgcn_s_setprio(1); _Pragma("unroll") for (int m = 0; m < 4; ++m) _Pragma("unroll") for (int n = 0; n < 2; ++n) _Pragma("unroll") for (int k = 0; k < 2; ++k) \
        acc[ai][bj][m][n] = __builtin_amdgcn_mfma_f32_16x16x32_bf16(Bt[n][k], At[m][k], acc[ai][bj][m][n], 0, 0, 0); __builtin_amdgcn_s_setprio(0); } while (0)
#define PG8_WAIT_V(n) asm volatile("s_waitcnt vmcnt(" #n ")" ::: "memory")
#define PG8_WAIT_L(n) asm volatile("s_waitcnt lgkmcnt(" #n ")" ::: "memory")
#define PG8_BAR __builtin_amdgcn_s_barrier()
#define PG8_SCHED __builtin_amdgcn_sched_barrier(0)
    Unit cur, nxt; int ui = 0;
    if (!S.next(0, cur)) return;
    f32x4 acc[2][2][4][2];
#pragma unroll
    for (int a = 0; a < 2; ++a)
#pragma unroll
        for (int b = 0; b < 2; ++b)
#pragma unroll
            for (int m = 0; m < 4; ++m)
#pragma unroll
                for (int n = 0; n < 2; ++n) acc[a][b][m][n] = (f32x4){0.f, 0.f, 0.f, 0.f};
    bf16x8 At[4][2], B0[2][2], B1[2][2];
    const char* cA = (const char*)g.A + (size_t)cur.pm * tstep; const char* cB = (const char*)g.Bt + (size_t)cur.pn * tstep;
    PG8_STAGE(PG8_SB(0, 0), cB, voffB); PG8_STAGE(PG8_SB(0, 1), cB + hstep, voffB); PG8_STAGE(PG8_SA(0, 0), cA, voffA); PG8_STAGE(PG8_SA(0, 1), cA + hstep, voffA);
    if (wr == 1) PG8_BAR;
    PG8_WAIT_V(2); PG8_BAR;
    PG8_STAGE(PG8_SB(1, 0), cB + kstep, voffB); PG8_STAGE(PG8_SA(1, 0), cA + kstep, voffA); PG8_STAGE(PG8_SB(1, 1), cB + hstep + kstep, voffB);
    PG8_WAIT_V(6); PG8_BAR;
    for (;;) {
        const bool has_next = S.next(ui + 1, nxt);
        const char* nA = has_next ? (const char*)g.A + (size_t)nxt.pm * tstep : cA; const char* nB = has_next ? (const char*)g.Bt + (size_t)nxt.pn * tstep : cB;
        for (int t = 0; t < nt; t += 2) {
            const bool last = (t == nt - 2);
            const char* a1 = cA + (size_t)(t + 1) * kstep;
            const char* a2 = last ? nA : cA + (size_t)(t + 2) * kstep; const char* b2 = last ? nB : cB + (size_t)(t + 2) * kstep;
            const char* a3 = a2 + kstep; const char* b3 = b2 + kstep;
            PG8_LDB(B0, 0, 0); PG8_LDB(B1, 0, 1); PG8_SCHED; PG8_LDA(At, 0, 0); PG8_STAGE(PG8_SA(1, 1), a1 + hstep, voffA);
            PG8_WAIT_V(8); PG8_WAIT_L(0); PG8_BAR; PG8_MMA(0, 0, At, B0); PG8_MMA(0, 1, At, B1); PG8_BAR; PG8_SCHED;
            PG8_LDA(At, 0, 1); PG8_STAGE(PG8_SB(0, 0), b2, voffB); PG8_STAGE(PG8_SB(0, 1), b2 + hstep, voffB); PG8_STAGE(PG8_SA(0, 0), a2, voffA);
            PG8_WAIT_V(8); PG8_WAIT_L(0); PG8_BAR; PG8_MMA(1, 0, At, B0); PG8_MMA(1, 1, At, B1); PG8_BAR; PG8_SCHED;
            PG8_LDB(B0, 1, 0); PG8_LDB(B1, 1, 1); PG8_SCHED; PG8_LDA(At, 1, 0); PG8_STAGE(PG8_SA(0, 1), a2 + hstep, voffA);
            PG8_WAIT_V(8); PG8_WAIT_L(0); PG8_BAR; PG8_MMA(0, 0, At, B0); PG8_MMA(0, 1, At, B1); PG8_BAR; PG8_SCHED;
            PG8_LDA(At, 1, 1); PG8_STAGE(PG8_SB(1, 0), b3, voffB); PG8_STAGE(PG8_SB(1, 1), b3 + hstep, voffB); PG8_STAGE(PG8_SA(1, 0), a3, voffA);
            PG8_WAIT_V(8); PG8_WAIT_L(0); PG8_BAR; PG8_MMA(1, 0, At, B0); PG8_MMA(1, 1, At, B1); PG8_BAR; PG8_SCHED;
        }
        if (wr == 0) PG8_BAR;
        E(acc, cur, wr, wc, fr, fq);
        if (!has_next) break;
#pragma unroll
        for (int a = 0; a < 2; ++a)
#pragma unroll
            for (int b = 0; b < 2; ++b)
#pragma unroll
                for (int m = 0; m < 4; ++m)
#pragma unroll
                    for (int n = 0; n < 2; ++n) acc[a][b][m][n] = (f32x4){0.f, 0.f, 0.f, 0.f};
        cur = nxt; cA = nA; cB = nB; ++ui;
        if (wr == 1) PG8_BAR;
    }
    PG8_WAIT_V(0);
    PG8_BAR;
#undef PG8_SA
#undef PG8_SB
#undef PG8_STAGE
#undef PG8_LDA
#undef PG8_LDB
#undef PG8_MMA
#undef PG8_WAIT_V
#undef PG8_WAIT_L
#undef PG8_BAR
#undef PG8_SCHED
}
}

typedef f32x4 AccT[2][2][4][2];
#define EROW(ai, m) (u.pm * 256 + (ai) * 128 + wr * 64 + (m) * 16 + fr)
#define ECOL0 (u.pn * 256 + wc * 32 + 8 * fq)

struct Epi1a { static constexpr bool PERM = true; bf16_t* O; int ldc;
    __device__ __forceinline__ void operator()(const AccT& acc, const pg8::Unit& u, int wr, int wc, int fr, int fq) const {
        const int col0 = ECOL0;
#pragma unroll
        for (int ai = 0; ai < 2; ++ai)
#pragma unroll
            for (int m = 0; m < 4; ++m) { bf16_t* rowp = O + (size_t)EROW(ai, m) * ldc + col0;
#pragma unroll
                for (int bj = 0; bj < 2; ++bj) __builtin_nontemporal_store(pack8(acc[ai][bj][m][0], acc[ai][bj][m][1]), (u32x4*)(rowp + bj * 128)); }
    } };
struct Epi1b { static constexpr bool PERM = true; bf16_t* O;
    __device__ __forceinline__ void operator()(const AccT& acc, const pg8::Unit& u, int wr, int wc, int fr, int fq) const {
        const int col0 = ECOL0; const int pn = u.pn;
        if (pn < 8) {
#pragma unroll
            for (int ai = 0; ai < 2; ++ai)
#pragma unroll
                for (int m = 0; m < 4; ++m) { bf16_t* rowp = O + (size_t)EROW(ai, m) * 6144 + col0;
#pragma unroll
                    for (int bj = 0; bj < 2; ++bj) __builtin_nontemporal_store(pack8(gelu4(acc[ai][bj][m][0]), gelu4(acc[ai][bj][m][1])), (u32x4*)(rowp + bj * 128)); }
        } else {
#pragma unroll
            for (int ai = 0; ai < 2; ++ai)
#pragma unroll
                for (int m = 0; m < 4; ++m) { bf16_t* rowp = O + (size_t)EROW(ai, m) * 6144 + col0;
#pragma unroll
                    for (int bj = 0; bj < 2; ++bj) { f32x4 v0 = acc[ai][bj][m][0], v1 = acc[ai][bj][m][1];
#pragma unroll
                        for (int j = 0; j < 4; ++j) { v0[j] = sigmoidf_(v0[j]); v1[j] = sigmoidf_(v1[j]); }
                        __builtin_nontemporal_store(pack8(v0, v1), (u32x4*)(rowp + bj * 128)); } }
        }
    } };
template <bool ADD> struct Epi4 { static constexpr bool PERM = true; bf16_t* O; const bf16_t* gate;
    __device__ __forceinline__ void operator()(const AccT& acc, const pg8::Unit& u, int wr, int wc, int fr, int fq) const {
        const int col0 = ECOL0;
#pragma unroll
        for (int ai = 0; ai < 2; ++ai) {
            u32x4 gt[4][2], pv[4][2];
#pragma unroll
            for (int m = 0; m < 4; ++m) { const int row = EROW(ai, m);
#pragma unroll
                for (int bj = 0; bj < 2; ++bj) { gt[m][bj] = *(const u32x4*)(gate + (size_t)row * 6144 + col0 + bj * 128); if (ADD) pv[m][bj] = *(const u32x4*)(O + (size_t)row * 2048 + col0 + bj * 128); } }
#pragma unroll
            for (int m = 0; m < 4; ++m) { bf16_t* rowp = O + (size_t)EROW(ai, m) * 2048 + col0;
#pragma unroll
                for (int bj = 0; bj < 2; ++bj) { f32x4 g0, g1; unpack8(gt[m][bj], g0, g1);
                    f32x4 v0 = acc[ai][bj][m][0] * g0, v1 = acc[ai][bj][m][1] * g1;
                    if (ADD) { f32x4 p0, p1; unpack8(pv[m][bj], p0, p1); v0 += p0; v1 += p1; }
                    *(u32x4*)(rowp + bj * 128) = pack8(v0, v1); } }
            asm volatile("" ::: "memory"); }
    } };
struct EpiRes { static constexpr bool PERM = true; const float* base; float* X;
    __device__ __forceinline__ void operator()(const AccT& acc, const pg8::Unit& u, int wr, int wc, int fr, int fq) const {
        const int col0 = ECOL0;
#pragma unroll
        for (int ai = 0; ai < 2; ++ai) {
            f32x4 bs[4][2][2];
#pragma unroll
            for (int m = 0; m < 4; ++m) { const size_t off = (size_t)EROW(ai, m) * 2048 + col0;
#pragma unroll
                for (int bj = 0; bj < 2; ++bj) { bs[m][bj][0] = *(const f32x4*)(base + off + bj * 128); bs[m][bj][1] = *(const f32x4*)(base + off + bj * 128 + 4); } }
#pragma unroll
            for (int m = 0; m < 4; ++m) { const size_t off = (size_t)EROW(ai, m) * 2048 + col0;
#pragma unroll
                for (int bj = 0; bj < 2; ++bj) { *(f32x4*)(X + off + bj * 128) = acc[ai][bj][m][0] + bs[m][bj][0]; *(f32x4*)(X + off + bj * 128 + 4) = acc[ai][bj][m][1] + bs[m][bj][1]; } }
            asm volatile("" ::: "memory"); }
    } };
struct Epi7 { static constexpr bool PERM = true; const float* base; float* X; float* ss2; unsigned* cnt; const float* g;
    __device__ __forceinline__ void operator()(AccT& acc, const pg8::Unit& u, int wr, int wc, int fr, int fq) const {
        const int col0 = ECOL0;
#pragma unroll
        for (int ai = 0; ai < 2; ++ai)
#pragma unroll
            for (int mh = 0; mh < 2; ++mh) {
                f32x4 bs[2][2][2];
#pragma unroll
                for (int mm = 0; mm < 2; ++mm) { const size_t off = (size_t)EROW(ai, mh * 2 + mm) * 2048 + col0;
#pragma unroll
                    for (int bj = 0; bj < 2; ++bj) { bs[mm][bj][0] = *(const f32x4*)(base + off + bj * 128); bs[mm][bj][1] = *(const f32x4*)(base + off + bj * 128 + 4); } }
#pragma unroll
                for (int mm = 0; mm < 2; ++mm) { const int m = mh * 2 + mm; const int row = EROW(ai, m); float q = 0.f;
#pragma unroll
                    for (int bj = 0; bj < 2; ++bj) { const f32x4 v0 = acc[ai][bj][m][0] + bs[mm][bj][0], v1 = acc[ai][bj][m][1] + bs[mm][bj][1]; acc[ai][bj][m][0] = v0; acc[ai][bj][m][1] = v1;
                        q += (v0[0] * v0[0] + v0[1] * v0[1]) + (v0[2] * v0[2] + v0[3] * v0[3]) + (v1[0] * v1[0] + v1[1] * v1[1]) + (v1[2] * v1[2] + v1[3] * v1[3]); }
                    q += __shfl_xor(q, 16); q += __shfl_xor(q, 32);
                    if (fq == 0) __hip_atomic_store(ss2 + (size_t)row * 32 + u.pn * 4 + wc, q, __ATOMIC_RELAXED, __HIP_MEMORY_SCOPE_AGENT); }
                asm volatile("" ::: "memory"); }
        asm volatile("s_waitcnt vmcnt(0)" ::: "memory");
        unsigned* cw = cnt + 16 * (u.pm * 2 + wr);
        if ((threadIdx.x & 63) == 0) __hip_atomic_fetch_add(cw, 1u, __ATOMIC_RELAXED, __HIP_MEMORY_SCOPE_AGENT);
        { unsigned spins = 0; while (__hip_atomic_load(cw, __ATOMIC_RELAXED, __HIP_MEMORY_SCOPE_AGENT) < 32u) { __builtin_amdgcn_s_sleep(1); if (++spins > (1u << 22)) break; } }
        f32x4 gv[2][2];
#pragma unroll
        for (int bj = 0; bj < 2; ++bj) { gv[bj][0] = *(const f32x4*)(g + col0 + bj * 128); gv[bj][1] = *(const f32x4*)(g + col0 + bj * 128 + 4); }
#pragma unroll
        for (int ai = 0; ai < 2; ++ai)
#pragma unroll
            for (int m = 0; m < 4; ++m) { const int row = EROW(ai, m); const float* sp = ss2 + (size_t)row * 32 + fq * 8; float pq[8];
#pragma unroll
                for (int k = 0; k < 8; ++k) pq[k] = __hip_atomic_load(sp + k, __ATOMIC_RELAXED, __HIP_MEMORY_SCOPE_AGENT);
                float q = ((pq[0] + pq[1]) + (pq[2] + pq[3])) + ((pq[4] + pq[5]) + (pq[6] + pq[7]));
                q += __shfl_xor(q, 16); q += __shfl_xor(q, 32);
                const float rs = rsqrtf(q * (1.0f / 2048.0f) + EPSV); const size_t off = (size_t)row * 2048 + col0;
#pragma unroll
                for (int bj = 0; bj < 2; ++bj) { *(f32x4*)(X + off + bj * 128) = acc[ai][bj][m][0] * rs * gv[bj][0]; *(f32x4*)(X + off + bj * 128 + 4) = acc[ai][bj][m][1] * rs * gv[bj][1]; } }
    } };
struct Epi5 { static constexpr bool PERM = true; const float* base; float* X; float* ssp; const float* g; bf16_t* Hn;
    __device__ __forceinline__ void operator()(const AccT& acc, const pg8::Unit& u, int wr, int wc, int fr, int fq) const {
        const int col0 = ECOL0;
        f32x4 gv[2][2];
#pragma unroll
        for (int bj = 0; bj < 2; ++bj) { gv[bj][0] = *(const f32x4*)(g + col0 + bj * 128); gv[bj][1] = *(const f32x4*)(g + col0 + bj * 128 + 4); }
#pragma unroll
        for (int ai = 0; ai < 2; ++ai) {
            f32x4 bs[4][2][2];
#pragma unroll
            for (int m = 0; m < 4; ++m) { const size_t off = (size_t)EROW(ai, m) * 2048 + col0;
#pragma unroll
                for (int bj = 0; bj < 2; ++bj) { bs[m][bj][0] = *(const f32x4*)(base + off + bj * 128); bs[m][bj][1] = *(const f32x4*)(base + off + bj * 128 + 4); } }
#pragma unroll
            for (int m = 0; m < 4; ++m) { const int row = EROW(ai, m); const size_t off = (size_t)row * 2048 + col0; float q = 0.f;
#pragma unroll
                for (int bj = 0; bj < 2; ++bj) { const f32x4 v0 = acc[ai][bj][m][0] + bs[m][bj][0], v1 = acc[ai][bj][m][1] + bs[m][bj][1];
                    *(f32x4*)(X + off + bj * 128) = v0; *(f32x4*)(X + off + bj * 128 + 4) = v1;
                    q += (v0[0] * v0[0] + v0[1] * v0[1]) + (v0[2] * v0[2] + v0[3] * v0[3]) + (v1[0] * v1[0] + v1[1] * v1[1]) + (v1[2] * v1[2] + v1[3] * v1[3]);
                    *(u32x4*)(Hn + off + bj * 128) = pack8(v0 * gv[bj][0], v1 * gv[bj][1]); }
                q += __shfl_xor(q, 16); q += __shfl_xor(q, 32);
                if (fq == 0) ssp[(size_t)row * 32 + u.pn * 4 + wc] = q; }
            asm volatile("" ::: "memory"); }
    } };
struct Epi6 { static constexpr bool PERM = true; bf16_t* O; const float* ssp; const LAS float* rsl; int pm0, pm1;
    __device__ __forceinline__ void operator()(const AccT& acc, const pg8::Unit& u, int wr, int wc, int fr, int fq) const {
        const int col0 = u.pn * 128 + wc * 32 + 8 * fq;
        float rsv[2][4];
        if (u.pm == pm0 || u.pm == pm1) { const int tb = (u.pm == pm0) ? 0 : 256;
#pragma unroll
            for (int ai = 0; ai < 2; ++ai)
#pragma unroll
                for (int m = 0; m < 4; ++m) rsv[ai][m] = rsl[tb + ai * 128 + wr * 64 + m * 16 + fr];
        } else {
#pragma unroll
            for (int ai = 0; ai < 2; ++ai)
#pragma unroll
                for (int m = 0; m < 4; ++m) { const int row = EROW(ai, m);
                    const f32x4 p0 = *(const f32x4*)(ssp + (size_t)row * 32 + fq * 8), p1 = *(const f32x4*)(ssp + (size_t)row * 32 + fq * 8 + 4);
                    float q = ((p0[0] + p0[1]) + (p0[2] + p0[3])) + ((p1[0] + p1[1]) + (p1[2] + p1[3]));
                    q += __shfl_xor(q, 16); q += __shfl_xor(q, 32);
                    rsv[ai][m] = rsqrtf(q * (1.0f / 2048.0f) + EPSV); }
        }
#pragma unroll
        for (int ai = 0; ai < 2; ++ai)
#pragma unroll
            for (int m = 0; m < 4; ++m) { const int row = EROW(ai, m); const float rs = rsv[ai][m];
                f32x4 h0, h1;
#pragma unroll
                for (int j = 0; j < 4; ++j) { const float g0 = acc[ai][0][m][0][j] * rs, u0 = acc[ai][1][m][0][j] * rs, g1 = acc[ai][0][m][1][j] * rs, u1 = acc[ai][1][m][1][j] * rs;
                    h0[j] = g0 * sigmoidf_(g0) * u0; h1[j] = g1 * sigmoidf_(g1) * u1; }
                __builtin_nontemporal_store(pack8(h0, h1), (u32x4*)(O + (size_t)row * DFF + col0)); }
    } };

__device__ __forceinline__ float block_sum(float v, float* red, int tid) {
    for (int o = 32; o >= 1; o >>= 1) v += __shfl_xor(v, o);
    __syncthreads();
    if ((tid & 63) == 0) red[tid >> 6] = v;
    __syncthreads();
    float s = 0.f;
#pragma unroll
    for (int i = 0; i < 8; ++i) s += red[i];
    return s;
}

__device__ __forceinline__ void tr_tile(const float* __restrict__ src, int N, int K, bf16_t* __restrict__ dst, int k0, int n0, int drow0, float* tile, int tid) {
#pragma unroll
    for (int i = 0; i < 2; ++i) { const int kk = (tid >> 4) + i * 32, n4 = (tid & 15) * 4;
        const f32x4 v = *(const f32x4*)(src + (size_t)(k0 + kk) * N + n0 + n4);
        tile[kk * 65 + n4 + 0] = v[0]; tile[kk * 65 + n4 + 1] = v[1]; tile[kk * 65 + n4 + 2] = v[2]; tile[kk * 65 + n4 + 3] = v[3]; }
    __syncthreads();
    const int n = tid >> 3, kg = tid & 7; f32x4 a, b;
#pragma unroll
    for (int j = 0; j < 4; ++j) { a[j] = tile[(kg * 8 + j) * 65 + n]; b[j] = tile[(kg * 8 + 4 + j) * 65 + n]; }
    *(u32x4*)(dst + (size_t)(drow0 + n) * K + k0 + kg * 8) = pack8(a, b);
    __syncthreads();
}

__device__ __forceinline__ float sconv(const bf16_t* __restrict__ row, int b, int s, float w0, float w1, float w2, float bias) {
    const bf16_t* p = row + b * 2048 + s;
    const float c = bf2f(p[0]); const float l = s > 0 ? bf2f(p[-1]) : 0.f; const float r = s < 2047 ? bf2f(p[1]) : 0.f;
    return w0 * l + w1 * c + w2 * r + bias;
}

#define XB_TMO      128
#define XB_XCNT(j)  (256  + 64 * (j))
#define XB_XSUB(j)  (1280 + 64 * (j))
#define XB_XGEN(j)  (2304 + 64 * (j))
#define XB_TOP      3328
#define XB_TOPGEN   3392
#define XCD_BAR_WORDS 3456
#define XB_SPIN_CAP (1u << 22)

__device__ __forceinline__ unsigned xb_ld(unsigned* p)              { return __hip_atomic_load(p, __ATOMIC_RELAXED, __HIP_MEMORY_SCOPE_AGENT); }
__device__ __forceinline__ unsigned xb_add(unsigned* p, unsigned v) { return __hip_atomic_fetch_add(p, v, __ATOMIC_RELAXED, __HIP_MEMORY_SCOPE_AGENT); }
__device__ __forceinline__ unsigned xb_xcc_id() { return (unsigned)__builtin_amdgcn_s_getreg((3 << 11) | 20) & 0xFu; }
#define XB_SPIN(cond, bar) do { unsigned _sp = 0; while (cond) { __builtin_amdgcn_s_sleep(1); \
    if ((++_sp & 255u) == 0u) { if (xb_ld(&(bar)[XB_TMO])) break; if (_sp > XB_SPIN_CAP) { atomicAdd(&(bar)[XB_TMO], 1u); break; } } } } while (0)

struct XcdBarrier {
    unsigned* bar; unsigned x;
    volatile LAS unsigned* st;
};

__device__ __forceinline__ XcdBarrier xcd_barrier_post(unsigned* bar, volatile LAS unsigned* st) {
    XcdBarrier b; b.bar = bar; b.x = xb_xcc_id(); b.st = st;
    if (threadIdx.x == 0) (void)xb_add(&bar[XB_XCNT(b.x)], 1u);
    return b;
}
__device__ __forceinline__ void xcd_barrier_complete(unsigned* bar, unsigned x, unsigned& nloc, unsigned& nx) {
    const unsigned G = gridDim.x * gridDim.y * gridDim.z;
    unsigned sum, cnt, mine, sp = 0u;
    for (;;) {
        sum = 0u; cnt = 0u; mine = 0u;
#pragma unroll
        for (unsigned j = 0; j < 16; ++j) { const unsigned c = xb_ld(&bar[XB_XCNT(j)]); sum += c; cnt += (c > 0u) ? 1u : 0u; mine = (j == x) ? c : mine; }
        if (sum == G) break;
        __builtin_amdgcn_s_sleep(1);
        if ((++sp & 255u) == 0u) { if (xb_ld(&bar[XB_TMO])) break; if (sp > XB_SPIN_CAP) { atomicAdd(&bar[XB_TMO], 1u); break; } }
    }
    nloc = mine > 0u ? mine : 1u; nx = cnt > 0u ? cnt : 1u;
}

__device__ __forceinline__ void xcd_barrier(const XcdBarrier& b) {
    asm volatile("s_waitcnt vmcnt(0)" ::: "memory");
    __syncthreads();
    if (threadIdx.x == 0) {
        unsigned* bar = b.bar;
        __builtin_amdgcn_s_waitcnt(0);
        unsigned nloc = b.st[0], nx = b.st[1];
        if (nloc == 0u) { xcd_barrier_complete(bar, b.x, nloc, nx); b.st[0] = nloc; b.st[1] = nx; }
        const unsigned old = xb_add(&bar[XB_XSUB(b.x)], 1u);
        const unsigned gen = old / nloc;
        if (old + 1u == (gen + 1u) * nloc) {
            __builtin_amdgcn_fence(__ATOMIC_RELEASE, "agent");
            asm volatile("s_waitcnt vmcnt(0)" ::: "memory");
            const unsigned og = xb_add(&bar[XB_TOP], 1u);
            const unsigned tg = og / nx;
            if (og + 1u == (tg + 1u) * nx) xb_add(&bar[XB_TOPGEN], 1u);
            else XB_SPIN(xb_ld(&bar[XB_TOPGEN]) == tg, bar);
            __builtin_amdgcn_fence(__ATOMIC_ACQUIRE, "agent");
            xb_add(&bar[XB_XGEN(b.x)], 1u);
            asm volatile("s_waitcnt vmcnt(0)" ::: "memory");
        } else {
            XB_SPIN(xb_ld(&bar[XB_XGEN(b.x)]) == gen, bar);
            __builtin_amdgcn_fence(__ATOMIC_ACQUIRE, "agent");
            asm volatile("s_waitcnt vmcnt(0)" ::: "memory");
        }
    }
    __syncthreads();
}


__device__ __forceinline__ void my_barrier(unsigned* bar, unsigned target) {
    asm volatile("s_waitcnt vmcnt(0)" ::: "memory");
    __syncthreads();
    if (threadIdx.x == 0) {
        __builtin_amdgcn_fence(__ATOMIC_RELEASE, "agent");
        asm volatile("s_waitcnt vmcnt(0)" ::: "memory");
        __hip_atomic_fetch_add(bar, 1u, __ATOMIC_RELAXED, __HIP_MEMORY_SCOPE_AGENT);
        while (__hip_atomic_load(bar, __ATOMIC_RELAXED, __HIP_MEMORY_SCOPE_AGENT) < target) __builtin_amdgcn_s_sleep(2);
        __builtin_amdgcn_fence(__ATOMIC_ACQUIRE, "agent");
        asm volatile("s_waitcnt vmcnt(0)" ::: "memory");
    }
    __syncthreads();
}

template <bool TOBF> __device__ __forceinline__ void rmsnorm_rows(const float* x, const float* __restrict__ g, bf16_t* ob, float* of, int bid, int G, int wave, int lane) {
    for (int row = bid * 8 + wave; row < NTOK; row += G * 8) {
        const float* xr = x + (size_t)row * DM; f32x4 v[8]; float q = 0.f;
#pragma unroll
        for (int i = 0; i < 8; ++i) { v[i] = *(const f32x4*)(xr + lane * 4 + i * 256); q += (v[i][0] * v[i][0] + v[i][1] * v[i][1]) + (v[i][2] * v[i][2] + v[i][3] * v[i][3]); }
        for (int o = 32; o >= 1; o >>= 1) q += __shfl_xor(q, o);
        const float rs = rsqrtf(q * (1.0f / 2048.0f) + EPSV);
#pragma unroll
        for (int i = 0; i < 8; ++i) { const f32x4 gg = *(const f32x4*)(g + lane * 4 + i * 256); const f32x4 y = v[i] * rs * gg;
            if (TOBF) { u32x2 w; w.x = cvt_pk_bf16(y[0], y[1]); w.y = cvt_pk_bf16(y[2], y[3]); *(u32x2*)(ob + (size_t)row * DM + lane * 4 + i * 256) = w; }
            else *(f32x4*)(of + (size_t)row * DM + lane * 4 + i * 256) = y; }
    }
}


#ifdef SELFCHK
__device__ __forceinline__ unsigned hsh(unsigned x) { x ^= x >> 16; x *= 0x7feb352du; x ^= x >> 15; x *= 0x846ca68bu; x ^= x >> 16; return x; }
__device__ __forceinline__ float wdot(const bf16_t* a, const bf16_t* b, int K, int lane) { float s = 0.f; for (int k = lane; k < K; k += 64) s += bf2f(a[k]) * bf2f(b[k]); for (int o = 32; o >= 1; o >>= 1) s += __shfl_xor(s, o); return s; }
__device__ __forceinline__ void chk_flag(unsigned* flags, bool bad, unsigned bit) { if (__any(bad) && (threadIdx.x & 63) == 0) atomicOr(flags, bit); }
__device__ __forceinline__ bool far(float got, float ref) { return !(fabsf(got - ref) <= 0.02f * fabsf(ref) + 0.02f); }
#define CHK(...) do { __VA_ARGS__ } while (0)
#else
#define CHK(...) do { } while (0)
#endif

__global__ void __launch_bounds__(NTHR, 2) fwd_megakernel(Params P) {
    extern __shared__ __attribute__((aligned(16))) unsigned char smem[];
    cg::grid_group grid = cg::this_grid();
    const int tid = threadIdx.x, lane = tid & 63, wave = tid >> 6;
    const int G = gridDim.x, bid = blockIdx.x;
    unsigned char* ws = P.ws;
    LAS unsigned char* lds = (LAS unsigned char*)smem;
    const int lo = P.lo, hi = P.hi;
#define IN(k) (lo <= (k) && (k) < hi)
#define SEAM(k) do { if ((k) + 1 < hi) { if (lo > (k) + 1000) grid.sync();   xcd_barrier(xb); } } while (0)

    { volatile LAS unsigned* stw = (volatile LAS unsigned*)(lds + 146400); if (tid < 2) stw[tid] = 0u; __syncthreads(); }
    const XcdBarrier xb = xcd_barrier_post((unsigned*)(ws + WS_BAR + 16384), (volatile LAS unsigned*)(lds + 146400));
    float* stats = (float*)(ws + WS_STATS); float* ss1 = (float*)(ws + WS_SS1); float* ss2 = (float*)(ws + WS_SS2); float* h3 = (float*)(ws + WS_H3);
    bf16_t* WinT = (bf16_t*)(ws + W_IN); bf16_t* WbhT = (bf16_t*)(ws + W_BH); bf16_t* WbsT = (bf16_t*)(ws + W_BS); bf16_t* WoutT = (bf16_t*)(ws + W_OUT);
    bf16_t* WfiT = (bf16_t*)(ws + W_FI); bf16_t* WfoT = (bf16_t*)(ws + W_FO);
    bf16_t* Hn = (bf16_t*)(ws + WS_R2); bf16_t* Yhy = (bf16_t*)(ws + WS_R2); bf16_t* Ysgu = (bf16_t*)(ws + WS_R2 + 33554432);
    bf16_t* PT = (bf16_t*)(ws + R3_PT); bf16_t* PROJ2 = (bf16_t*)(ws + R3_PROJ2); bf16_t* MERGED = (bf16_t*)(ws + R3_MERGED); bf16_t* H2 = (bf16_t*)(ws + R3_H2); bf16_t* HID = (bf16_t*)(ws + R3_HID);
    float* SSP = (float*)(ws + WS_R2);
    float* KF = P.out; bf16_t* YT = (bf16_t*)((unsigned char*)P.out + 33554432);

    auto weight_tiles = [&](int t_lo, int t_hi) {
            float* tile = (float*)smem;
            struct TJ { const float* src; bf16_t* dst; int K, N, k0, n0, mode; };
            auto decode = [&](int ti, TJ& j) {
                int li, ntl; j.mode = 0;
                if (ti < 1152) { j.src = P.in[2]; j.dst = WinT; j.K = 2048; j.N = 9216; li = ti; ntl = 36; }
                else if (ti < 1280) { j.src = P.in[18]; j.dst = WbhT; j.K = 1024; j.N = 2048; li = ti - 1152; ntl = 8; }
                else if (ti < 1408) { j.src = P.in[19]; j.dst = WbsT; j.K = 1024; j.N = 2048; li = ti - 1280; ntl = 8; }
                else if (ti < 1664) { j.src = P.in[20]; j.dst = WoutT; j.K = 2048; j.N = 2048; li = ti - 1408; ntl = 8; }
                else if (ti < 3072) { j.src = P.in[22]; j.dst = WfiT; j.K = 2048; j.N = 11264; li = ti - 1664; ntl = 44; j.mode = 1; }
                else { j.src = P.in[23]; j.dst = WfoT; j.K = 5632; j.N = 2048; li = ti - 3072; ntl = 8; }
                j.k0 = (li / ntl) * 64; j.n0 = (li % ntl) * 256; };
            f32x4 v[8]; TJ cur, nxt; int ti = t_lo + bid; bool have = ti < t_hi;
            if (have) { decode(ti, cur);
#pragma unroll
                for (int i = 0; i < 8; ++i) { const int idx = tid + i * NTHR, kk = idx >> 6, n4 = (idx & 63) * 4; v[i] = *(const f32x4*)(cur.src + (size_t)(cur.k0 + kk) * cur.N + cur.n0 + n4); } }
            while (have) {
#pragma unroll
                for (int i = 0; i < 8; ++i) { const int idx = tid + i * NTHR, kk = idx >> 6, n4 = (idx & 63) * 4; *(f32x4*)(tile + kk * 260 + (n4 ^ (((kk >> 3) & 7) << 2))) = v[i]; }
                __syncthreads();
                const int nti = ti + G; const bool hn = nti < t_hi;
                if (hn) { decode(nti, nxt);
#pragma unroll
                    for (int i = 0; i < 8; ++i) { const int idx = tid + i * NTHR, kk = idx >> 6, n4 = (idx & 63) * 4; v[i] = *(const f32x4*)(nxt.src + (size_t)(nxt.k0 + kk) * nxt.N + nxt.n0 + n4); } }
#pragma unroll
                for (int i = 0; i < 4; ++i) { const int item = tid + i * NTHR, n = item >> 3, kg = item & 7; f32x4 a, b;
#pragma unroll
                    for (int j = 0; j < 4; ++j) { a[j] = tile[(kg * 8 + j) * 260 + (n ^ (kg << 2))]; b[j] = tile[(kg * 8 + 4 + j) * 260 + (n ^ (kg << 2))]; }
                    int drow = cur.n0 + n;
                    if (cur.mode == 1) { const int up = drow >= DFF; const int jj = up ? drow - DFF : drow; drow = 256 * (jj >> 7) + (up ? 128 : 0) + (jj & 127); }
                    *(u32x4*)(cur.dst + (size_t)drow * cur.K + cur.k0 + kg * 8) = pack8(a, b); }
                __syncthreads();
                ti = nti; have = hn; cur = nxt;
            }
        __syncthreads();
    };
    if (((PHASE_MASK >> 0) & 1) && IN(0)) {
        weight_tiles(0, 1152);
        rmsnorm_rows<true>(P.in[0], P.in[1], Hn, nullptr, bid, G, wave, lane);
        {
            float* zf = (float*)smem; float* ha = zf + 8 * 40; float* hb = ha + 8 * 64;
            const float* w1 = P.in[5]; const float* b1 = P.in[6]; const float* w2 = P.in[7]; const float* b2 = P.in[8]; const float* w3 = P.in[9]; const float* b3 = P.in[10]; const float* fq_ = P.in[11];
            for (int pg = bid; pg < 256; pg += G) {
                const int pos = pg * 8 + wave;
                __syncthreads();
                if (lane < 33) {
                    float z;
                    if (lane == 0) z = (float)pos / 2047.0f;
                    else { const int mband = (lane - 1) & 15; const float f = 1e-4f + (float)mband * ((15.0f - 1e-4f) / 15.0f); const float w = (6.2831855f * (float)pos) / 2048.0f; const float a = f * w;
                        z = lane < 17 ? __cosf(a) : -__sinf(a); }
                    zf[wave * 40 + lane] = z;
                }
                __syncthreads();
                const float fr = fq_[lane];
                float a = b1[lane];
#pragma unroll 3
                for (int i = 0; i < 33; ++i) a += zf[wave * 40 + i] * w1[i * 64 + lane];
                ha[wave * 64 + lane] = __sinf(fr * a);
                __syncthreads();
                a = b2[lane];
#pragma unroll 8
                for (int i = 0; i < 64; ++i) a += ha[wave * 64 + i] * w2[i * 64 + lane];
                hb[wave * 64 + lane] = __sinf(fr * a);
                __syncthreads();
                a = b3[lane];
#pragma unroll 8
                for (int i = 0; i < 64; ++i) a += hb[wave * 64 + i] * w3[i * 64 + lane];
                h3[pos * 64 + lane] = __sinf(fr * a);
            }
            __syncthreads();
        }
        SEAM(0);
    }

    if (((PHASE_MASK >> 1) & 1) && IN(1)) {
        CHK(
            { const unsigned sid = bid * 8 + wave; unsigned* flags = (unsigned*)(ws + WS_BAR + 64); bool bad = false;
              { const int n = hsh(sid * 7 + 1) % 9216, k = (hsh(sid * 7 + 2) + lane) % 2048; bad |= WinT[(size_t)n * 2048 + k] != f2bf(P.in[2][(size_t)k * 9216 + n]); }
              { const int j = hsh(sid * 7 + 3) % 5632, k = (hsh(sid * 7 + 4) + lane) % 2048; const int rg = 256 * (j >> 7) + (j & 127);
                bad |= WfiT[(size_t)rg * 2048 + k] != f2bf(P.in[22][(size_t)k * 11264 + j]); bad |= WfiT[(size_t)(rg + 128) * 2048 + k] != f2bf(P.in[22][(size_t)k * 11264 + 5632 + j]); }
              { const int n = hsh(sid * 7 + 5) % 2048, k = (hsh(sid * 7 + 6) + lane) % 5632; bad |= WfoT[(size_t)n * 5632 + k] != f2bf(P.in[23][(size_t)k * 2048 + n]); }
              { const int n = hsh(sid * 7 + 5) % 2048, k = (hsh(sid * 7 + 6) + lane) % 1024; bad |= WbhT[(size_t)n * 1024 + k] != f2bf(P.in[18][(size_t)k * 2048 + n]); bad |= WbsT[(size_t)n * 1024 + k] != f2bf(P.in[19][(size_t)k * 2048 + n]); }
              { const int n = hsh(sid * 7 + 5) % 2048, k = (hsh(sid * 7 + 6) + lane) % 2048; bad |= WoutT[(size_t)n * 2048 + k] != f2bf(P.in[20][(size_t)k * 2048 + n]); }
              chk_flag(flags, bad, 1u); }
        );
        {
            const float* w4 = P.in[12]; float* Wl = (float*)smem;
            for (int cb = bid; cb < 256; cb += G) {
                __syncthreads();
                for (int idx = tid; idx < 1024; idx += NTHR) { const int cc = idx & 15, j = idx >> 4; Wl[cc * 64 + j] = w4[(size_t)j * 4096 + cb * 16 + cc]; }
                __syncthreads();
                for (int pp2 = 0; pp2 < 2; ++pp2) {
                    const int pos0 = (wave * 4 + pp2 * 2) * 64 + lane, pos1 = pos0 + 64;
                    float h0[64], h1[64];
#pragma unroll
                    for (int j4 = 0; j4 < 16; ++j4) { const f32x4 t0 = *(const f32x4*)(h3 + pos0 * 64 + j4 * 4), t1 = *(const f32x4*)(h3 + pos1 * 64 + j4 * 4);
#pragma unroll
                        for (int k = 0; k < 4; ++k) { h0[j4 * 4 + k] = t0[k]; h1[j4 * 4 + k] = t1[k]; } }
                    const float tt0 = (float)pos0 / 2047.0f, tt1 = (float)pos1 / 2047.0f;
                    for (int cc = 0; cc < 16; ++cc) {
                        const int col = cb * 16 + cc; const int dir = col >> 11, o = (col >> 10) & 1, c = col & 1023;
                        float a0 = 0.f, a1 = 0.f;
#pragma unroll
                        for (int j4 = 0; j4 < 16; ++j4) { const f32x4 w = *(const f32x4*)(Wl + cc * 64 + j4 * 4);
#pragma unroll
                            for (int k = 0; k < 4; ++k) { a0 += h0[j4 * 4 + k] * w[k]; a1 += h1[j4 * 4 + k] * w[k]; } }
                        const float ad = 3.0701134573f + (float)c * ((15.3505672866f - 3.0701134573f) / 1023.0f);
                        const float v0 = a0 * __expf(-tt0 * ad), v1 = a1 * __expf(-tt1 * ad);
                        float* kr = KF + (size_t)(o * 1024 + c) * 4096;
                        if (dir == 0) { kr[2048 + pos0] = v0; kr[2048 + pos1] = v1; }
                        else { if (pos0 >= 1) kr[2048 - pos0] = v0; else kr[0] = 0.f; kr[2048 - pos1] = v1; }
                    }
                }
            }
            __syncthreads();
        }
        {
            pg8::Gemm g{WinT, Hn, 3072, NTOK, DM}; pg8::StaticOrder S; S.init(3072, NTOK, G, bid);
            Epi1a E{PT, NTOK}; pg8::gemm_phase<Epi1a>(lds, g, S, E);
        }
        {
            pg8::Gemm g{Hn, WinT + (size_t)3072 * DM, NTOK, 6144, DM}; pg8::StaticOrder S; S.init(NTOK, 6144, G, bid);
            Epi1b E{PROJ2}; pg8::gemm_phase<Epi1b>(lds, g, S, E);
        }
        SEAM(1);
    }

    if (((PHASE_MASK >> 2) & 1) && IN(2)) {
        CHK(
            { const unsigned sid = bid * 8 + wave; unsigned* flags = (unsigned*)(ws + WS_BAR + 64);
              { const int ch = hsh(sid * 5 + 11) % 3072, tok = hsh(sid * 5 + 12) % 8192; const float ref = wdot(WinT + (size_t)ch * 2048, Hn + (size_t)tok * 2048, 2048, lane);
                chk_flag(flags, far(bf2f(PT[(size_t)ch * NTOK + tok]), ref), 2u); }
              { const int col = hsh(sid * 5 + 13) % 6144, tok = hsh(sid * 5 + 14) % 8192; const float r0 = wdot(Hn + (size_t)tok * 2048, WinT + (size_t)(3072 + col) * 2048, 2048, lane);
                const float ref = col < 2048 ? 0.5f * r0 * (1.0f + erff(r0 * 0.70710678f)) : 1.0f / (1.0f + expf(-r0));
                chk_flag(flags, far(bf2f(PROJ2[(size_t)tok * 6144 + col]), ref), 4u); } }
        );
        if (bid & 1) weight_tiles(1152, 3776);
        {
            unsigned char* Z1 = smem;
            unsigned char* Z2 = smem + 34816;
            unsigned char* KS = smem + 69632;
            bf16_t* KR = (bf16_t*)(smem + 137472);
            float* red = (float*)(smem + 145696);
            const float* scw = P.in[3]; const float* scb = P.in[4]; const float* hbias = P.in[13];
            for (int i = tid; i < 1024; i += NTHR) { const int buf = i >> 9, w = i & 511; const int off = (w < 256 ? 0 : 66 * 512 - 1024) + w * 4; *(unsigned*)((buf ? Z2 : Z1) + off) = 0u; }
            const int pp = wave & 1, gg = wave >> 1, li = lane & 15, lq = lane >> 4, bb = li & 7, jsel = li >> 3;
            const unsigned boff = (unsigned)(jsel * 512 + bb * 64 + ((lq ^ ((bb >> 2) << 1)) * 16));
            const int rcp_ = 7 - (li & 7); const int ksl = rcp_ * 8448 + 48 * (rcp_ & 3) + 2 * (2040 - 16 * pp - 8 * (li >> 3) + 8 * lq);
            float kv[8];
            if (bid < DH) { const float* kr0 = KF + (size_t)bid * 4096;
#pragma unroll
                for (int j = 0; j < 8; ++j) kv[j] = kr0[tid + j * NTHR]; }
            for (int c = bid; c < DH; c += G) {
                __syncthreads();
                {   const float w0 = scw[c], w1 = scw[3072 + c], w2 = scw[6144 + c], bs = scb[c];
                    for (int ch = tid; ch < 2048; ch += NTHR) { const int b = ch >> 8, s = (ch & 255) * 8; const bf16_t* src = PT + (size_t)c * NTOK + b * 2048 + s;
                        f32x4 fa, fb; unpack8(*(const u32x4*)src, fa, fb); const float fl = s > 0 ? bf2f(src[-1]) : 0.f, fr_ = s + 8 < 2048 ? bf2f(src[8]) : 0.f;
                        f32x4 oa, ob;
                        oa[0] = w0 * fl + w1 * fa[0] + w2 * fa[1] + bs; oa[1] = w0 * fa[0] + w1 * fa[1] + w2 * fa[2] + bs; oa[2] = w0 * fa[1] + w1 * fa[2] + w2 * fa[3] + bs; oa[3] = w0 * fa[2] + w1 * fa[3] + w2 * fb[0] + bs;
                        ob[0] = w0 * fa[3] + w1 * fb[0] + w2 * fb[1] + bs; ob[1] = w0 * fb[0] + w1 * fb[1] + w2 * fb[2] + bs; ob[2] = w0 * fb[1] + w1 * fb[2] + w2 * fb[3] + bs; ob[3] = w0 * fb[2] + w1 * fb[3] + w2 * fr_ + bs;
                        const int J = s >> 5, chunk = (s & 31) >> 3;
                        *(u32x4*)(Z1 + ((J + 2) * 8 + b) * 64 + ((chunk ^ ((b >> 2) << 1)) * 16)) = pack8(oa, ob); } }
                for (int o = 0; o < 2; ++o) {
                    float part = 0.f;
#pragma unroll
                    for (int j = 0; j < 8; ++j) { part += fabsf(kv[j]); KR[4095 - (tid + j * NTHR)] = f2bf(kv[j]); }
                    if (tid < 8) KR[4096 + tid] = 0;
                    const float scale = 1.0f / block_sum(part, red, tid);
                    {   const u32x4 c0 = *(const u32x4*)(KR + tid * 8), c1 = *(const u32x4*)(KR + tid * 8 + 8);
                        const unsigned D[8] = {c0.x, c0.y, c0.z, c0.w, c1.x, c1.y, c1.z, c1.w};
#pragma unroll
                        for (int r = 0; r < 8; ++r) { u32x4 w; const int sft = r >> 1;
                            if (r & 1) { w.x = __builtin_amdgcn_alignbit(D[sft + 1], D[sft], 16); w.y = __builtin_amdgcn_alignbit(D[sft + 2], D[sft + 1], 16); w.z = __builtin_amdgcn_alignbit(D[sft + 3], D[sft + 2], 16); w.w = __builtin_amdgcn_alignbit(D[sft + 4], D[sft + 3], 16); }
                            else { w.x = D[sft]; w.y = D[sft + 1]; w.z = D[sft + 2]; w.w = D[sft + 3]; }
                            *(u32x4*)(KS + r * 8448 + 48 * (r & 3) + tid * 16) = w; } }
                    __syncthreads();
                    {
                        const int nc = o == 0 ? c : c + G, no = o == 0 ? 1 : 0;
                        if (nc < DH) { const float* krn = KF + (size_t)(no * 1024 + nc) * 4096;
#pragma unroll
                            for (int j = 0; j < 8; ++j) kv[j] = krn[tid + j * NTHR]; } }
                    const unsigned char* Zin = o ? Z2 : Z1;
                    const int chx = (o == 0 ? 1024 : 2048) + c;
                    u32x2 xwv[8]; unsigned short xlv[8], xrv[8];
#pragma unroll
                    for (int a = 0; a < 8; ++a) { const int I = pp + 2 * (16 * gg + 2 * a + jsel); const int t0 = 16 * I + 4 * lq; const bf16_t* src = PT + (size_t)chx * NTOK + bb * 2048 + t0;
                        xwv[a] = *(const u32x2*)src; xlv[a] = t0 > 0 ? src[-1] : (unsigned short)0; xrv[a] = t0 + 4 < 2048 ? src[4] : (unsigned short)0; }
                    f32x4 acc[8];
#pragma unroll
                    for (int a = 0; a < 8; ++a) acc[a] = (f32x4){0.f, 0.f, 0.f, 0.f};
#define HY_LA(E) (*(const bf16x8*)(KS + ksl - 64 * (E)))
#define HY_LBJ(J0) (*(const bf16x8*)(Zin + (((J0) >= -1 && (J0) <= 63) ? ((J0) + 2) : 0) * 512 + boff))
                    {
                        bf16x8 aE[8], aO[8];
                        const int e0 = 16 * gg - 63;
#pragma unroll
                        for (int a2 = 0; a2 < 8; ++a2) { aE[a2] = HY_LA(e0 + 2 * a2); aO[a2] = HY_LA(e0 + 1 + 2 * a2); }
                        bf16x8 bfe = HY_LBJ(63);
                        for (int ib = 0; ib < 64; ib += 16) {
#pragma unroll
                            for (int k = 0; k < 8; ++k) { const int i = ib + 2 * k;
                                const bf16x8 bfo = HY_LBJ(62 - i);
#pragma unroll
                                for (int a2 = 0; a2 < 8; ++a2) acc[a2] = __builtin_amdgcn_mfma_f32_16x16x32_bf16(aE[(a2 + k) & 7], bfe, acc[a2], 0, 0, 0);
                                aE[k & 7] = HY_LA(e0 + i + 16);
                                bfe = HY_LBJ(61 - i);
#pragma unroll
                                for (int a2 = 0; a2 < 8; ++a2) acc[a2] = __builtin_amdgcn_mfma_f32_16x16x32_bf16(aO[(a2 + k) & 7], bfo, acc[a2], 0, 0, 0);
                                aO[k & 7] = HY_LA(e0 + i + 17);
                            }
                        }
#pragma unroll
                        for (int a2 = 0; a2 < 8; ++a2) acc[a2] = __builtin_amdgcn_mfma_f32_16x16x32_bf16(aE[a2], bfe, acc[a2], 0, 0, 0);
                    }
#undef HY_LA
#undef HY_LBJ
                    const float bo = hbias[o * 1024 + c];
                    const float w0 = scw[chx], w1 = scw[3072 + chx], w2 = scw[6144 + chx], bs = scb[chx];
#pragma unroll
                    for (int a = 0; a < 8; ++a) { const int I = pp + 2 * (16 * gg + 2 * a + jsel); const int t0 = 16 * I + 4 * lq;
                        const int zaddr = ((t0 >> 5) + 2) * 512 + bb * 64 + ((((t0 & 31) >> 3) ^ ((bb >> 2) << 1)) * 16) + (t0 & 7) * 2;
                        const u32x2 zw = *(const u32x2*)(Zin + zaddr);
                        const float z0 = __uint_as_float(zw.x << 16), z1 = __uint_as_float(zw.x & 0xffff0000u), z2 = __uint_as_float(zw.y << 16), z3 = __uint_as_float(zw.y & 0xffff0000u);
                        const u32x2 xw = xwv[a];
                        const float x0 = __uint_as_float(xw.x << 16), x1 = __uint_as_float(xw.x & 0xffff0000u), x2 = __uint_as_float(xw.y << 16), x3 = __uint_as_float(xw.y & 0xffff0000u);
                        const float xl = bf2f(xlv[a]), xr = bf2f(xrv[a]);
                        const float r0 = (w0 * xl + w1 * x0 + w2 * x1 + bs) * (acc[a][0] * scale + z0 * bo), r1 = (w0 * x0 + w1 * x1 + w2 * x2 + bs) * (acc[a][1] * scale + z1 * bo);
                        const float r2 = (w0 * x1 + w1 * x2 + w2 * x3 + bs) * (acc[a][2] * scale + z2 * bo), r3 = (w0 * x2 + w1 * x3 + w2 * xr + bs) * (acc[a][3] * scale + z3 * bo);
                        u32x2 w; w.x = cvt_pk_bf16(r0, r1); w.y = cvt_pk_bf16(r2, r3);
                        if (o == 0) *(u32x2*)(Z2 + zaddr) = w; else *(u32x2*)(YT + (size_t)c * NTOK + bb * 2048 + t0) = w; }
                    __syncthreads();
                }
            }
        }
        {
            bf16_t* Wl = (bf16_t*)smem;
            bf16_t* Vl = (bf16_t*)(smem + 36864);
            float* stl = (float*)(smem + 73728);
            const float* lng = P.in[14]; const float* lnb = P.in[15]; const float* w_s = P.in[16]; const float* b_s = P.in[17];
            const int li = lane & 15, lq = lane >> 4;
            for (int item = bid; item < 256; item += G) {
              const int bn = item >> 1, tok0 = bn * 128;
              __syncthreads();
              for (int qb = 0; qb < 4; ++qb) {
                  u32x4 raw[4][2];
#pragma unroll
                  for (int k = 0; k < 4; ++k) { const bf16_t* vp = PROJ2 + (size_t)(tok0 + wave * 16 + qb * 4 + k) * 6144 + 1024 + lane * 16; raw[k][0] = *(const u32x4*)vp; raw[k][1] = *(const u32x4*)(vp + 8); }
#pragma unroll
                  for (int k = 0; k < 4; ++k) { const int q = wave * 16 + qb * 4 + k;
                      f32x4 a0, a1, a2, a3; unpack8(raw[k][0], a0, a1); unpack8(raw[k][1], a2, a3);
                      float sm = 0.f, sq = 0.f;
#pragma unroll
                      for (int j = 0; j < 4; ++j) { sm += (a0[j] + a1[j]) + (a2[j] + a3[j]); sq += (a0[j] * a0[j] + a1[j] * a1[j]) + (a2[j] * a2[j] + a3[j] * a3[j]); }
                      for (int o = 32; o >= 1; o >>= 1) { sm += __shfl_xor(sm, o); sq += __shfl_xor(sq, o); }
                      if (lane == 0) { const float mean = sm * (1.0f / 1024.0f); const float var = sq * (1.0f / 1024.0f) - mean * mean; stl[2 * q] = mean; stl[2 * q + 1] = rsqrtf(var + EPSV); } }
              }
              for (int hh = 0; hh < 4; ++hh) {
                const int h = (item & 1) * 4 + hh;
                __syncthreads();
                for (int ch = tid; ch < 2048; ch += NTHR) {
                    { const int p = ch >> 4, q8 = (ch & 15) * 8; const float* wp = w_s + (size_t)h * 16384 + p * 128 + q8;
                      *(u32x4*)(Wl + p * 144 + q8) = pack8(*(const f32x4*)wp, *(const f32x4*)(wp + 4)); }
                    { const int q = ch >> 4, c8 = (ch & 15) * 8; const float sm = stl[2 * q], rstd = stl[2 * q + 1];
                      f32x4 va, vb; unpack8(*(const u32x4*)(PROJ2 + (size_t)(tok0 + q) * 6144 + 1024 + h * 128 + c8), va, vb);
                      const f32x4 ga = *(const f32x4*)(lng + h * 128 + c8), gb = *(const f32x4*)(lng + h * 128 + c8 + 4), ba = *(const f32x4*)(lnb + h * 128 + c8), bb_ = *(const f32x4*)(lnb + h * 128 + c8 + 4);
                      va = (va - sm) * rstd * ga + ba; vb = (vb - sm) * rstd * gb + bb_;
#pragma unroll
                      for (int j = 0; j < 4; ++j) { Vl[(c8 + j) * 144 + q] = f2bf(va[j]); Vl[(c8 + 4 + j) * 144 + q] = f2bf(vb[j]); } }
                }
                __syncthreads();
                f32x4 acc[8];
#pragma unroll
                for (int ct = 0; ct < 8; ++ct) acc[ct] = (f32x4){0.f, 0.f, 0.f, 0.f};
#pragma unroll
                for (int kk = 0; kk < 4; ++kk) { const bf16x8 wf = *(const bf16x8*)(Wl + (wave * 16 + li) * 144 + kk * 32 + lq * 8);
#pragma unroll
                    for (int ct = 0; ct < 8; ++ct) { const bf16x8 vf = *(const bf16x8*)(Vl + (ct * 16 + li) * 144 + kk * 32 + lq * 8);
                        acc[ct] = __builtin_amdgcn_mfma_f32_16x16x32_bf16(vf, wf, acc[ct], 0, 0, 0); } }
                {   const int p = wave * 16 + li, tok = tok0 + p; const float bs = b_s[h * 128 + p];
#pragma unroll
                    for (int ct = 0; ct < 8; ++ct) { const int cc = h * 128 + ct * 16 + lq * 4; const u32x2 uw = *(const u32x2*)(PROJ2 + (size_t)tok * 6144 + cc);
                        const float u0 = __uint_as_float(uw.x << 16), u1 = __uint_as_float(uw.x & 0xffff0000u), u2 = __uint_as_float(uw.y << 16), u3 = __uint_as_float(uw.y & 0xffff0000u);
                        u32x2 w; w.x = cvt_pk_bf16(u0 * (acc[ct][0] + bs), u1 * (acc[ct][1] + bs)); w.y = cvt_pk_bf16(u2 * (acc[ct][2] + bs), u3 * (acc[ct][3] + bs));
                        *(u32x2*)(Ysgu + (size_t)tok * 1024 + cc) = w; } }
              }
            }
            __syncthreads();
        }
        if (!(bid & 1)) weight_tiles(1152, 3776);
        SEAM(2);
    }

    if (((PHASE_MASK >> 3) & 1) && IN(3)) {
        auto ytrans = [&]() {
        bf16_t* tile = (bf16_t*)smem;
        u32x4 v[4]; int ti = bid; bool have = ti < 1024;
        if (have) { const int c0 = (ti & 15) * 64, t0 = (ti >> 4) * 256;
#pragma unroll
            for (int i = 0; i < 4; ++i) { const int idx = tid + i * NTHR, cr = idx >> 5, tg = idx & 31; v[i] = *(const u32x4*)(YT + (size_t)(c0 + cr) * NTOK + t0 + tg * 8); } }
        while (have) {
            const int c0 = (ti & 15) * 64, t0 = (ti >> 4) * 256;
#pragma unroll
            for (int i = 0; i < 4; ++i) { const int idx = tid + i * NTHR, cr = idx >> 5, tg = idx & 31; *(u32x4*)(tile + cr * 264 + tg * 8) = v[i]; }
            __syncthreads();
            const int nti = ti + G; const bool hn = nti < 1024;
            if (hn) { const int nc0 = (nti & 15) * 64, nt0 = (nti >> 4) * 256;
#pragma unroll
                for (int i = 0; i < 4; ++i) { const int idx = tid + i * NTHR, cr = idx >> 5, tg = idx & 31; v[i] = *(const u32x4*)(YT + (size_t)(nc0 + cr) * NTOK + nt0 + tg * 8); } }
#pragma unroll
            for (int i = 0; i < 4; ++i) { const int item = tid + i * NTHR, tr = item >> 3, cg8 = item & 7; unsigned short e[8];
#pragma unroll
                for (int j = 0; j < 8; ++j) e[j] = tile[(cg8 * 8 + j) * 264 + tr];
                u32x4 w; w.x = e[0] | ((unsigned)e[1] << 16); w.y = e[2] | ((unsigned)e[3] << 16); w.z = e[4] | ((unsigned)e[5] << 16); w.w = e[6] | ((unsigned)e[7] << 16);
                *(u32x4*)(Yhy + (size_t)(t0 + tr) * 1024 + c0 + cg8 * 8) = w; }
            __syncthreads();
            ti = nti; have = hn;
        }
        };
        if (bid & 1) ytrans();
        {   pg8::Gemm g{Ysgu, WbsT, NTOK, DM, DH}; pg8::StaticOrder S; S.init(NTOK, DM, G, bid);
            Epi4<false> E{MERGED, PROJ2 + 4096}; pg8::gemm_phase<Epi4<false>>(lds, g, S, E); }
        if (!(bid & 1)) ytrans();
        SEAM(3);
    }
#ifdef DBG_CUT3
    {
        for (size_t i = (size_t)bid * NTHR + tid; i < (size_t)NTOK * 2048; i += (size_t)G * NTHR) { const int row = (int)(i >> 11), c = (int)(i & 2047);
            P.out[i] = c < 1024 ? bf2f(Yhy[(size_t)row * 1024 + c]) : bf2f(Ysgu[(size_t)row * 1024 + c - 1024]); }
        return;
    }
#endif
    if (((PHASE_MASK >> 4) & 1) && IN(4)) {
        {   pg8::Gemm g{Yhy, WbhT, NTOK, DM, DH}; pg8::StaticOrder S; S.init(NTOK, DM, G, bid);
            Epi4<true> E{MERGED, PROJ2 + 2048}; pg8::gemm_phase<Epi4<true>>(lds, g, S, E); }
        SEAM(4);
    }

    if (((PHASE_MASK >> 5) & 1) && IN(5)) {
        pg8::Gemm g{MERGED, WoutT, NTOK, DM, DM}; pg8::StaticOrder S; S.init(NTOK, DM, G, bid);
        Epi5 E{P.in[0], P.out, SSP, P.in[21], H2}; pg8::gemm_phase<Epi5>(lds, g, S, E);
        SEAM(5);
    }
    if (((PHASE_MASK >> 6) & 1) && IN(6)) {
        pg8::Gemm g{H2, WfiT, NTOK, 2 * DFF, DM}; pg8::StaticOrder S; S.init(NTOK, 2 * DFF, G, bid, 8);
        pg8::Unit u0, u1; S.next(0, u0); u1 = u0; for (int i = 1; ; ++i) { pg8::Unit t; if (!S.next(i, t)) break; u1 = t; }
        {   float* rst = (float*)(smem + 131072);
            for (int r = tid; r < 512; r += NTHR) { const int pmr = r < 256 ? u0.pm : u1.pm; const float* sp = SSP + (size_t)(pmr * 256 + (r & 255)) * 32; float q4[4];
#pragma unroll
                for (int k = 0; k < 4; ++k) { const f32x4 p0 = *(const f32x4*)(sp + k * 8), p1 = *(const f32x4*)(sp + k * 8 + 4); q4[k] = ((p0[0] + p0[1]) + (p0[2] + p0[3])) + ((p1[0] + p1[1]) + (p1[2] + p1[3])); }
                rst[r] = rsqrtf(((q4[0] + q4[1]) + (q4[2] + q4[3])) * (1.0f / 2048.0f) + EPSV); }
            __syncthreads(); }
        Epi6 E{HID, SSP, (const LAS float*)(smem + 131072), u0.pm, u1.pm}; pg8::gemm_phase<Epi6>(lds, g, S, E);
        SEAM(6);
    }
    const bool fuse78 = (G == 256);
    if (((PHASE_MASK >> 7) & 1) && IN(7)) {
        pg8::Gemm g{HID, WfoT, NTOK, DM, DFF}; pg8::StaticOrder S; S.init(NTOK, DM, G, bid);
        if (fuse78) { S.rowmode = 1; Epi7 E{P.out, P.out, (float*)(ws + WS_R2 + 4194304), (unsigned*)(ws + WS_BAR + 1024), P.in[24]}; pg8::gemm_phase<Epi7>(lds, g, S, E); }
        else { EpiRes E{P.out, P.out}; pg8::gemm_phase<EpiRes>(lds, g, S, E); SEAM(7); }
    }
    if (((PHASE_MASK >> 8) & 1) && IN(8) && !fuse78) {
        rmsnorm_rows<false>(P.out, P.in[24], nullptr, P.out, bid, G, wave, lane);
    }
#undef IN
#undef SEAM
}

extern "C" void kernel_launch(void* const* d_in, const int* in_sizes, int n_in, void* d_out, int out_size, void* d_ws, size_t ws_size, hipStream_t stream) {
    static int grid_blocks = 0;
    if (grid_blocks == 0) {
        if (n_in != 25 || out_size != NTOK * DM || ws_size < WS_END) { fprintf(stderr, "kernel_launch: unexpected shapes n_in %d out %d ws %zu (need %zu)\n", n_in, out_size, ws_size, (size_t)WS_END); grid_blocks = -1; return; }
        int dev = 0, cus = 0, per_cu = 0;
        hipGetDevice(&dev);
        hipDeviceGetAttribute(&cus, hipDeviceAttributeMultiprocessorCount, dev);
        if (hipFuncSetAttribute((const void*)fwd_megakernel, hipFuncAttributeMaxDynamicSharedMemorySize, LDS_BYTES) != hipSuccess) { fprintf(stderr, "kernel_launch: hipFuncSetAttribute failed\n"); grid_blocks = -1; return; }
        if (hipOccupancyMaxActiveBlocksPerMultiprocessor(&per_cu, (const void*)fwd_megakernel, NTHR, LDS_BYTES) != hipSuccess || per_cu < 1) { fprintf(stderr, "kernel_launch: occupancy query gave %d\n", per_cu); per_cu = 1; }
        (void)hipGetLastError();
        grid_blocks = cus * per_cu;
    }
    if (grid_blocks < 0) return;
    if (hipMemsetAsync((char*)d_ws + WS_BAR, 0, 32768, stream) != hipSuccess) { fprintf(stderr, "kernel_launch: memset failed\n"); return; }
    Params p{};
    for (int i = 0; i < 25; ++i) p.in[i] = (const float*)d_in[i];
    p.out = (float*)d_out; p.ws = (unsigned char*)d_ws; p.lo = 0; p.hi = 9;
    void* args[] = {&p};
    hipError_t e = hipLaunchCooperativeKernel((const void*)fwd_megakernel, dim3(grid_blocks), dim3(NTHR), args, LDS_BYTES, stream);
    if (e != hipSuccess) fprintf(stderr, "cooperative launch failed: %s (grid %d)\n", hipGetErrorString(e), grid_blocks);
}
```

```cpp
#include <hip/hip_runtime.h>
#include <hip/hip_cooperative_groups.h>
#include <cstdio>
namespace cg = cooperative_groups;

#define LAS __attribute__((address_space(3)))
typedef unsigned short bf16_t;
typedef short bf16x8 __attribute__((ext_vector_type(8)));
typedef float f32x4 __attribute__((ext_vector_type(4)));
typedef float f32x2 __attribute__((ext_vector_type(2)));
typedef unsigned u32x4 __attribute__((ext_vector_type(4)));
typedef unsigned u32x2 __attribute__((ext_vector_type(2)));

constexpr int NTOK = 16384, DM = 2048, DH = 1024, DFF = 5632, SEQ = 2048;
constexpr float EPSV = 1e-6f;
constexpr int NTHR = 512;
#ifndef PHASE_MASK
#define PHASE_MASK 0x3ff
#endif
constexpr int LDS_BYTES = 146432;

constexpr size_t WS_STATS = 0;
constexpr size_t WS_SS1 = 131072;
constexpr size_t WS_SS2 = 196608;
constexpr size_t WS_H3 = 262144;
constexpr size_t WS_BAR = 917504;
constexpr size_t WS_W = 1048576;
constexpr size_t W_IN = WS_W;
constexpr size_t W_BH = W_IN + 37748736;
constexpr size_t W_BS = W_BH + 4194304;
constexpr size_t W_OUT = W_BS + 4194304;
constexpr size_t W_FI = W_OUT + 8388608;
constexpr size_t W_FO = W_FI + 46137344;
constexpr size_t WS_R2 = W_FO + 23068672;
constexpr size_t WS_R3 = WS_R2 + 67108864;
constexpr size_t R3_PT = WS_R3;
constexpr size_t R3_PROJ2 = WS_R3 + 100663296;
constexpr size_t R3_MERGED = WS_R3;
constexpr size_t R3_H2 = WS_R3 + 184549376;
constexpr size_t R3_HID = WS_R3;
constexpr size_t WS_END = WS_R3 + 301989888;

struct Params { const float* in[25]; float* out; unsigned char* ws; int lo, hi; };

__device__ __forceinline__ float bf2f(bf16_t b) { return __uint_as_float(((unsigned)b) << 16); }
__device__ __forceinline__ bf16_t f2bf(float f) { unsigned u = __float_as_uint(f); u += 0x7FFFu + ((u >> 16) & 1u); return (bf16_t)(u >> 16); }
typedef __bf16 bf16x2_t __attribute__((ext_vector_type(2)));
__device__ __forceinline__ unsigned cvt_pk_bf16(float lo, float hi) { f32x2 v = {lo, hi}; bf16x2_t b = __builtin_convertvector(v, bf16x2_t); return __builtin_bit_cast(unsigned, b); }
__device__ __forceinline__ u32x4 pack8(f32x4 a, f32x4 b) { u32x4 w; w.x = cvt_pk_bf16(a[0], a[1]); w.y = cvt_pk_bf16(a[2], a[3]); w.z = cvt_pk_bf16(b[0], b[1]); w.w = cvt_pk_bf16(b[2], b[3]); return w; }
__device__ __forceinline__ void unpack8(u32x4 w, f32x4& a, f32x4& b) {
    a[0] = __uint_as_float(w.x << 16); a[1] = __uint_as_float(w.x & 0xffff0000u); a[2] = __uint_as_float(w.y << 16); a[3] = __uint_as_float(w.y & 0xffff0000u);
    b[0] = __uint_as_float(w.z << 16); b[1] = __uint_as_float(w.z & 0xffff0000u); b[2] = __uint_as_float(w.w << 16); b[3] = __uint_as_float(w.w & 0xffff0000u); }
__device__ __forceinline__ float sigmoidf_(float x) { return __builtin_amdgcn_rcpf(1.0f + __expf(-x)); }
__device__ __forceinline__ f32x2 gelu_pk(f32x2 v) {
    const f32x2 av = __builtin_elementwise_abs(v), d = av * 0.2316418882f + 1.0f;
    f32x2 t; t.x = __builtin_amdgcn_rcpf(d.x); t.y = __builtin_amdgcn_rcpf(d.y);
    f32x2 q = t * 0.5307027145f + (-0.7265760135f); q = q * t + 0.7107068705f; q = q * t + (-0.142248368f); q = q * t + 0.127414796f; q = q * t;
    const f32x2 s = (v * v) * (-0.72134752044f);
    f32x2 e; e.x = __builtin_amdgcn_exp2f(s.x); e.y = __builtin_amdgcn_exp2f(s.y);
    const f32x2 m = v * (q * e), r = v - m;
    f32x2 o; o.x = v.x < 0.f ? m.x : r.x; o.y = v.y < 0.f ? m.y : r.y; return o;
}
__device__ __forceinline__ f32x4 gelu4(f32x4 v) { f32x2 a = gelu_pk((f32x2){v[0], v[1]}), b = gelu_pk((f32x2){v[2], v[3]}); return (f32x4){a.x, a.y, b.x, b.y}; }

namespace pg8 {
constexpr int BM = 256, BK = 64, HALF = 128, HTB = HALF * BK * 2, STAGE_BYTES = 8 * HTB, NXCD = 8, WGM = 4;
__host__ __device__ __forceinline__ int lds_byte(int r, int c) { const int st = (r >> 4) * 2 + (c >> 5), rr = r & 15, cc = c & 31, ob = rr * 64 + cc * 2; return st * 1024 + (ob ^ (((ob >> 9) & 1) << 5)); }
__host__ __device__ __forceinline__ void stage_rc(int b, int& R, int& C) { const int st = b / 1024, sb = b % 1024, swz = sb ^ (((sb >> 9) & 1) << 5); R = (st >> 1) * 16 + swz / 64; C = (st & 1) * 32 + (swz % 64) / 2; }
__host__ __device__ __forceinline__ int perm32(int rho) { const int n = rho >> 4, i = rho & 15; return 8 * (i >> 2) + 4 * n + (i & 3); }
struct Unit { int pm, pn; };
struct Gemm { const bf16_t* A; const bf16_t* Bt; int M, N, K; };
struct StaticOrder {
    int nM, nN, nwg, G, c, rowmode, wgm;
    __device__ void init(int M, int N, int G_, int c_, int wgm_ = WGM) { nM = M / BM; nN = N / BM; nwg = nM * nN; G = G_; c = c_; rowmode = 0; wgm = wgm_; }
    __device__ bool next(int i, Unit& u) const {
        const long L = (long)i * G + c; if (L >= nwg) return false;
        if (rowmode) { u.pm = i * 32 + (c & 7) * 4 + (c >> 6); u.pn = (c >> 3) & 7; return true; }
        int wgid = (int)L; { const int q = nwg / NXCD, r = nwg % NXCD, xcd = wgid % NXCD, off = wgid / NXCD; wgid = (xcd < r ? xcd * (q + 1) : r * (q + 1) + (xcd - r) * q) + off; }
        const int nig = wgm * nN, gid = wgid / nig, fm = gid * wgm, gsz = (nM - fm) < wgm ? (nM - fm) : wgm;
        u.pm = fm + ((wgid % nig) % gsz); u.pn = (wgid % nig) / gsz; return true;
    }
};

template <class Epi>
__device__ __forceinline__ void gemm_phase(LAS unsigned char* lds, const Gemm g, const StaticOrder& S, const Epi& E) {
    const int tid = threadIdx.x, wid = __builtin_amdgcn_readfirstlane(tid >> 6), lane = tid & 63, wr = wid >> 2, wc = wid & 3, fr = lane & 15, fq = lane >> 4;
    const int K = g.K, nt = K / BK;
    unsigned voffA[2], voffB[2];
#pragma unroll
    for (int i = 0; i < 2; ++i) { int R, C; stage_rc(tid * 16 + i * 8192, R, C); const int Rb = Epi::PERM ? ((R & ~31) + perm32(R & 31)) : R;
        voffA[i] = (unsigned)(R * K + C) * 2u; voffB[i] = (unsigned)(Rb * K + C) * 2u; }
    const size_t kstep = (size_t)(BK * 2);
    const size_t hstep = (size_t)HALF * K * 2;
    const size_t tstep = 2 * hstep;
    const unsigned ldsw = (unsigned)wid * 1024u;
    const int aoff = lds_byte(wr * 64 + fr, fq * 8), boff = lds_byte(wc * 32 + fr, fq * 8);
#define PG8_SA(b, h) (((b) * 2 + (h)) * HTB)
#define PG8_SB(b, h) ((4 + (b) * 2 + (h)) * HTB)
#define PG8_STAGE(bufoff, gbase, voff) do { _Pragma("unroll") for (int _i = 0; _i < 2; ++_i) \
        __builtin_amdgcn_global_load_lds((const unsigned*)((const char*)(gbase) + (voff)[_i]), (LAS unsigned*)(lds + (bufoff) + ldsw + _i * 8192), 16, 0, 0); } while (0)
#define PG8_LDA(dst, b, h) do { _Pragma("unroll") for (int m = 0; m < 4; ++m) _Pragma("unroll") for (int k = 0; k < 2; ++k) dst[m][k] = *(const LAS bf16x8*)(lds + PG8_SA(b, h) + aoff + m * 2048 + k * 1024); } while (0)
#define PG8_LDB(dst, b, h) do { _Pragma("unroll") for (int n = 0; n < 2; ++n) _Pragma("unroll") for (int k = 0; k < 2; ++k) dst[n][k] = *(const LAS bf16x8*)(lds + PG8_SB(b, h) + boff + n * 2048 + k * 1024); } while (0)
#define PG8_MMA(ai, bj, At, Bt) do { __builtin_amdgcn_s_setprio(1); _Pragma("unroll") for (int m = 0; m < 4; ++m) _Pragma("unroll") for (int n = 0; n < 2; ++n) _Pragma("unroll") for (int k = 0; k < 2; ++k) \
        acc[ai][bj][m][n] = __builtin_amdgcn_mfma_f32_16x16x32_bf16(Bt[n][k], At[m][k], acc[ai][bj][m][n], 0, 0, 0); __builtin_amdgcn_s_setprio(0); } while (0)
#define PG8_WAIT_V(n) asm volatile("s_waitcnt vmcnt(" #n ")" ::: "memory")
#define PG8_WAIT_L(n) asm volatile("s_waitcnt lgkmcnt(" #n ")" ::: "memory")
#define PG8_BAR __builtin_amdgcn_s_barrier()
#define PG8_SCHED __builtin_amdgcn_sched_barrier(0)
    Unit cur, nxt; int ui = 0;
    if (!S.next(0, cur)) return;
    f32x4 acc[2][2][4][2];
#pragma unroll
    for (int a = 0; a < 2; ++a)
#pragma unroll
        for (int b = 0; b < 2; ++b)
#pragma unroll
            for (int m = 0; m < 4; ++m)
#pragma unroll
                for (int n = 0; n < 2; ++n) acc[a][b][m][n] = (f32x4){0.f, 0.f, 0.f, 0.f};
    bf16x8 At[4][2], B0[2][2], B1[2][2];
    const char* cA = (const char*)g.A + (size_t)cur.pm * tstep; const char* cB = (const char*)g.Bt + (size_t)cur.pn * tstep;
    PG8_STAGE(PG8_SB(0, 0), cB, voffB); PG8_STAGE(PG8_SB(0, 1), cB + hstep, voffB); PG8_STAGE(PG8_SA(0, 0), cA, voffA); PG8_STAGE(PG8_SA(0, 1), cA + hstep, voffA);
    if (wr == 1) PG8_BAR;
    PG8_WAIT_V(2); PG8_BAR;
    PG8_STAGE(PG8_SB(1, 0), cB + kstep, voffB); PG8_STAGE(PG8_SA(1, 0), cA + kstep, voffA); PG8_STAGE(PG8_SB(1, 1), cB + hstep + kstep, voffB);
    PG8_WAIT_V(6); PG8_BAR;
    for (;;) {
        const bool has_next = S.next(ui + 1, nxt);
        const char* nA = has_next ? (const char*)g.A + (size_t)nxt.pm * tstep : cA; const char* nB = has_next ? (const char*)g.Bt + (size_t)nxt.pn * tstep : cB;
        for (int t = 0; t < nt; t += 2) {
            const bool last = (t == nt - 2);
            const char* a1 = cA + (size_t)(t + 1) * kstep;
            const char* a2 = last ? nA : cA + (size_t)(t + 2) * kstep; const char* b2 = last ? nB : cB + (size_t)(t + 2) * kstep;
            const char* a3 = a2 + kstep; const char* b3 = b2 + kstep;
            PG8_LDB(B0, 0, 0); PG8_LDB(B1, 0, 1); PG8_SCHED; PG8_LDA(At, 0, 0); PG8_STAGE(PG8_SA(1, 1), a1 + hstep, voffA);
            PG8_WAIT_V(8); PG8_WAIT_L(0); PG8_BAR; PG8_MMA(0, 0, At, B0); PG8_MMA(0, 1, At, B1); PG8_BAR; PG8_SCHED;
            PG8_LDA(At, 0, 1); PG8_STAGE(PG8_SB(0, 0), b2, voffB); PG8_STAGE(PG8_SB(0, 1), b2 + hstep, voffB); PG8_STAGE(PG8_SA(0, 0), a2, voffA);
            PG8_WAIT_V(8); PG8_WAIT_L(0); PG8_BAR; PG8_MMA(1, 0, At, B0); PG8_MMA(1, 1, At, B1); PG8_BAR; PG8_SCHED;
            PG8_LDB(B0, 1, 0); PG8_LDB(B1, 1, 1); PG8_SCHED; PG8_LDA(At, 1, 0); PG8_STAGE(PG8_SA(0, 1), a2 + hstep, voffA);
            PG8_WAIT_V(8); PG8_WAIT_L(0); PG8_BAR; PG8_MMA(0, 0, At, B0); PG8_MMA(0, 1, At, B1); PG8_BAR; PG8_SCHED;
            PG8_LDA(At, 1, 1); PG8_STAGE(PG8_SB(1, 0), b3, voffB); PG8_STAGE(PG8_SB(1, 1), b3 + hstep, voffB); PG8_STAGE(PG8_SA(1, 0), a3, voffA);
            PG8_WAIT_V(8); PG8_WAIT_L(0); PG8_BAR; PG8_MMA(1, 0, At, B0); PG8_MMA(1, 1, At, B1); PG8_BAR; PG8_SCHED;
        }
        if (wr == 0) PG8_BAR;
        E(acc, cur, wr, wc, fr, fq);
        if (!has_next) break;
#pragma unroll
        for (int a = 0; a < 2; ++a)
#pragma unroll
            for (int b = 0; b < 2; ++b)
#pragma unroll
                for (int m = 0; m < 4; ++m)
#pragma unroll
                    for (int n = 0; n < 2; ++n) acc[a][b][m][n] = (f32x4){0.f, 0.f, 0.f, 0.f};
        cur = nxt; cA = nA; cB = nB; ++ui;
        if (wr == 1) PG8_BAR;
    }
    PG8_WAIT_V(0);
    PG8_BAR;
#undef PG8_SA
#undef PG8_SB
#undef PG8_STAGE
#undef PG8_LDA
#undef PG8_LDB
#undef PG8_MMA
#undef PG8_WAIT_V
#undef PG8_WAIT_L
#undef PG8_BAR
#undef PG8_SCHED
}
}

typedef f32x4 AccT[2][2][4][2];
#define EROW(ai, m) (u.pm * 256 + (ai) * 128 + wr * 64 + (m) * 16 + fr)
#define ECOL0 (u.pn * 256 + wc * 32 + 8 * fq)

struct Epi1a { static constexpr bool PERM = true; bf16_t* O; int ldc;
    __device__ __forceinline__ void operator()(const AccT& acc, const pg8::Unit& u, int wr, int wc, int fr, int fq) const {
        const int col0 = ECOL0;
#pragma unroll
        for (int ai = 0; ai < 2; ++ai)
#pragma unroll
            for (int m = 0; m < 4; ++m) { bf16_t* rowp = O + (size_t)EROW(ai, m) * ldc + col0;
#pragma unroll
                for (int bj = 0; bj < 2; ++bj) __builtin_nontemporal_store(pack8(acc[ai][bj][m][0], acc[ai][bj][m][1]), (u32x4*)(rowp + bj * 128)); }
    } };
struct Epi1b { static constexpr bool PERM = true; bf16_t* O;
    __device__ __forceinline__ void operator()(const AccT& acc, const pg8::Unit& u, int wr, int wc, int fr, int fq) const {
        const int col0 = ECOL0; const int pn = u.pn;
        if (pn < 8) {
#pragma unroll
            for (int ai = 0; ai < 2; ++ai)
#pragma unroll
                for (int m = 0; m < 4; ++m) { bf16_t* rowp = O + (size_t)EROW(ai, m) * 6144 + col0;
#pragma unroll
                    for (int bj = 0; bj < 2; ++bj) __builtin_nontemporal_store(pack8(gelu4(acc[ai][bj][m][0]), gelu4(acc[ai][bj][m][1])), (u32x4*)(rowp + bj * 128)); }
        } else {
#pragma unroll
            for (int ai = 0; ai < 2; ++ai)
#pragma unroll
                for (int m = 0; m < 4; ++m) { bf16_t* rowp = O + (size_t)EROW(ai, m) * 6144 + col0;
#pragma unroll
                    for (int bj = 0; bj < 2; ++bj) { f32x4 v0 = acc[ai][bj][m][0], v1 = acc[ai][bj][m][1];
#pragma unroll
                        for (int j = 0; j < 4; ++j) { v0[j] = sigmoidf_(v0[j]); v1[j] = sigmoidf_(v1[j]); }
                        __builtin_nontemporal_store(pack8(v0, v1), (u32x4*)(rowp + bj * 128)); } }
        }
    } };
template <bool ADD> struct Epi4 { static constexpr bool PERM = true; bf16_t* O; const bf16_t* gate;
    __device__ __forceinline__ void operator()(const AccT& acc, const pg8::Unit& u, int wr, int wc, int fr, int fq) const {
        const int col0 = ECOL0;
#pragma unroll
        for (int ai = 0; ai < 2; ++ai) {
            u32x4 gt[4][2], pv[4][2];
#pragma unroll
            for (int m = 0; m < 4; ++m) { const int row = EROW(ai, m);
#pragma unroll
                for (int bj = 0; bj < 2; ++bj) { gt[m][bj] = *(const u32x4*)(gate + (size_t)row * 6144 + col0 + bj * 128); if (ADD) pv[m][bj] = *(const u32x4*)(O + (size_t)row * 2048 + col0 + bj * 128); } }
#pragma unroll
            for (int m = 0; m < 4; ++m) { bf16_t* rowp = O + (size_t)EROW(ai, m) * 2048 + col0;
#pragma unroll
                for (int bj = 0; bj < 2; ++bj) { f32x4 g0, g1; unpack8(gt[m][bj], g0, g1);
                    f32x4 v0 = acc[ai][bj][m][0] * g0, v1 = acc[ai][bj][m][1] * g1;
                    if (ADD) { f32x4 p0, p1; unpack8(pv[m][bj], p0, p1); v0 += p0; v1 += p1; }
                    *(u32x4*)(rowp + bj * 128) = pack8(v0, v1); } }
            asm volatile("" ::: "memory"); }
    } };
struct EpiRes { static constexpr bool PERM = true; const float* base; float* X;
    __device__ __forceinline__ void operator()(const AccT& acc, const pg8::Unit& u, int wr, int wc, int fr, int fq) const {
        const int col0 = ECOL0;
#pragma unroll
        for (int ai = 0; ai < 2; ++ai) {
            f32x4 bs[4][2][2];
#pragma unroll
            for (int m = 0; m < 4; ++m) { const size_t off = (size_t)EROW(ai, m) * 2048 + col0;
#pragma unroll
                for (int bj = 0; bj < 2; ++bj) { bs[m][bj][0] = *(const f32x4*)(base + off + bj * 128); bs[m][bj][1] = *(const f32x4*)(base + off + bj * 128 + 4); } }
#pragma unroll
            for (int m = 0; m < 4; ++m) { const size_t off = (size_t)EROW(ai, m) * 2048 + col0;
#pragma unroll
                for (int bj = 0; bj < 2; ++bj) { *(f32x4*)(X + off + bj * 128) = acc[ai][bj][m][0] + bs[m][bj][0]; *(f32x4*)(X + off + bj * 128 + 4) = acc[ai][bj][m][1] + bs[m][bj][1]; } }
            asm volatile("" ::: "memory"); }
    } };
struct Epi7 { static constexpr bool PERM = true; const float* base; float* X; float* ss2; unsigned* cnt; const float* g;
    __device__ __forceinline__ void operator()(AccT& acc, const pg8::Unit& u, int wr, int wc, int fr, int fq) const {
        const int col0 = ECOL0;
#pragma unroll
        for (int ai = 0; ai < 2; ++ai)
#pragma unroll
            for (int mh = 0; mh < 2; ++mh) {
                f32x4 bs[2][2][2];
#pragma unroll
                for (int mm = 0; mm < 2; ++mm) { const size_t off = (size_t)EROW(ai, mh * 2 + mm) * 2048 + col0;
#pragma unroll
                    for (int bj = 0; bj < 2; ++bj) { bs[mm][bj][0] = *(const f32x4*)(base + off + bj * 128); bs[mm][bj][1] = *(const f32x4*)(base + off + bj * 128 + 4); } }
#pragma unroll
                for (int mm = 0; mm < 2; ++mm) { const int m = mh * 2 + mm; const int row = EROW(ai, m); float q = 0.f;
#pragma unroll
                    for (int bj = 0; bj < 2; ++bj) { const f32x4 v0 = acc[ai][bj][m][0] + bs[mm][bj][0], v1 = acc[ai][bj][m][1] + bs[mm][bj][1]; acc[ai][bj][m][0] = v0; acc[ai][bj][m][1] = v1;
                        q += (v0[0] * v0[0] + v0[1] * v0[1]) + (v0[2] * v0[2] + v0[3] * v0[3]) + (v1[0] * v1[0] + v1[1] * v1[1]) + (v1[2] * v1[2] + v1[3] * v1[3]); }
                    q += __shfl_xor(q, 16); q += __shfl_xor(q, 32);
                    if (fq == 0) __hip_atomic_store(ss2 + (size_t)row * 32 + u.pn * 4 + wc, q, __ATOMIC_RELAXED, __HIP_MEMORY_SCOPE_AGENT); }
                asm volatile("" ::: "memory"); }
        asm volatile("s_waitcnt vmcnt(0)" ::: "memory");
        unsigned* cw = cnt + 16 * (u.pm * 2 + wr);
        if ((threadIdx.x & 63) == 0) __hip_atomic_fetch_add(cw, 1u, __ATOMIC_RELAXED, __HIP_MEMORY_SCOPE_AGENT);
        { unsigned spins = 0; while (__hip_atomic_load(cw, __ATOMIC_RELAXED, __HIP_MEMORY_SCOPE_AGENT) < 32u) { __builtin_amdgcn_s_sleep(1); if (++spins > (1u << 22)) break; } }
        f32x4 gv[2][2];
#pragma unroll
        for (int bj = 0; bj < 2; ++bj) { gv[bj][0] = *(const f32x4*)(g + col0 + bj * 128); gv[bj][1] = *(const f32x4*)(g + col0 + bj * 128 + 4); }
#pragma unroll
        for (int ai = 0; ai < 2; ++ai)
#pragma unroll
            for (int m = 0; m < 4; ++m) { const int row = EROW(ai, m); const float* sp = ss2 + (size_t)row * 32 + fq * 8; float pq[8];
#pragma unroll
                for (int k = 0; k < 8; ++k) pq[k] = __hip_atomic_load(sp + k, __ATOMIC_RELAXED, __HIP_MEMORY_SCOPE_AGENT);
                float q = ((pq[0] + pq[1]) + (pq[2] + pq[3])) + ((pq[4] + pq[5]) + (pq[6] + pq[7]));
                q += __shfl_xor(q, 16); q += __shfl_xor(q, 32);
                const float rs = rsqrtf(q * (1.0f / 2048.0f) + EPSV); const size_t off = (size_t)row * 2048 + col0;
#pragma unroll
                for (int bj = 0; bj < 2; ++bj) { *(f32x4*)(X + off + bj * 128) = acc[ai][bj][m][0] * rs * gv[bj][0]; *(f32x4*)(X + off + bj * 128 + 4) = acc[ai][bj][m][1] * rs * gv[bj][1]; } }
    } };
struct Epi5 { static constexpr bool PERM = true; const float* base; float* X; float* ssp; const float* g; bf16_t* Hn;
    __device__ __forceinline__ void operator()(const AccT& acc, const pg8::Unit& u, int wr, int wc, int fr, int fq) const {
        const int col0 = ECOL0;
        f32x4 gv[2][2];
#pragma unroll
        for (int bj = 0; bj < 2; ++bj) { gv[bj][0] = *(const f32x4*)(g + col0 + bj * 128); gv[bj][1] = *(const f32x4*)(g + col0 + bj * 128 + 4); }
#pragma unroll
        for (int ai = 0; ai < 2; ++ai) {
            f32x4 bs[4][2][2];
#pragma unroll
            for (int m = 0; m < 4; ++m) { const size_t off = (size_t)EROW(ai, m) * 2048 + col0;
#pragma unroll
                for (int bj = 0; bj < 2; ++bj) { bs[m][bj][0] = *(const f32x4*)(base + off + bj * 128); bs[m][bj][1] = *(const f32x4*)(base + off + bj * 128 + 4); } }
#pragma unroll
            for (int m = 0; m < 4; ++m) { const int row = EROW(ai, m); const size_t off = (size_t)row * 2048 + col0; float q = 0.f;
#pragma unroll
                for (int bj = 0; bj < 2; ++bj) { const f32x4 v0 = acc[ai][bj][m][0] + bs[m][bj][0], v1 = acc[ai][bj][m][1] + bs[m][bj][1];
                    *(f32x4*)(X + off + bj * 128) = v0; *(f32x4*)(X + off + bj * 128 + 4) = v1;
                    q += (v0[0] * v0[0] + v0[1] * v0[1]) + (v0[2] * v0[2] + v0[3] * v0[3]) + (v1[0] * v1[0] + v1[1] * v1[1]) + (v1[2] * v1[2] + v1[3] * v1[3]);
                    *(u32x4*)(Hn + off + bj * 128) = pack8(v0 * gv[bj][0], v1 * gv[bj][1]); }
                q += __shfl_xor(q, 16); q += __shfl_xor(q, 32);
                if (fq == 0) ssp[(size_t)row * 32 + u.pn * 4 + wc] = q; }
            asm volatile("" ::: "memory"); }
    } };
struct Epi6 { static constexpr bool PERM = true; bf16_t* O; const float* ssp; const LAS float* rsl; int pm0, pm1;
    __device__ __forceinline__ void operator()(const AccT& acc, const pg8::Unit& u, int wr, int wc, int fr, int fq) const {
        const int col0 = u.pn * 128 + wc * 32 + 8 * fq;
        float rsv[2][4];
        if (u.pm == pm0 || u.pm == pm1) { const int tb = (u.pm == pm0) ? 0 : 256;
#pragma unroll
            for (int ai = 0; ai < 2; ++ai)
#pragma unroll
                for (int m = 0; m < 4; ++m) rsv[ai][m] = rsl[tb + ai * 128 + wr * 64 + m * 16 + fr];
        } else {
#pragma unroll
            for (int ai = 0; ai < 2; ++ai)
#pragma unroll
                for (int m = 0; m < 4; ++m) { const int row = EROW(ai, m);
                    const f32x4 p0 = *(const f32x4*)(ssp + (size_t)row * 32 + fq * 8), p1 = *(const f32x4*)(ssp + (size_t)row * 32 + fq * 8 + 4);
                    float q = ((p0[0] + p0[1]) + (p0[2] + p0[3])) + ((p1[0] + p1[1]) + (p1[2] + p1[3]));
                    q += __shfl_xor(q, 16); q += __shfl_xor(q, 32);
                    rsv[ai][m] = rsqrtf(q * (1.0f / 2048.0f) + EPSV); }
        }
#pragma unroll
        for (int ai = 0; ai < 2; ++ai)
#pragma unroll
            for (int m = 0; m < 4; ++m) { const int row = EROW(ai, m); const float rs = rsv[ai][m];
                f32x4 h0, h1;
#pragma unroll
                for (int j = 0; j < 4; ++j) { const float g0 = acc[ai][0][m][0][j] * rs, u0 = acc[ai][1][m][0][j] * rs, g1 = acc[ai][0][m][1][j] * rs, u1 = acc[ai][1][m][1][j] * rs;
                    h0[j] = g0 * sigmoidf_(g0) * u0; h1[j] = g1 * sigmoidf_(g1) * u1; }
                __builtin_nontemporal_store(pack8(h0, h1), (u32x4*)(O + (size_t)row * DFF + col0)); }
    } };

__device__ __forceinline__ float block_sum(float v, float* red, int tid) {
    for (int o = 32; o >= 1; o >>= 1) v += __shfl_xor(v, o);
    __syncthreads();
    if ((tid & 63) == 0) red[tid >> 6] = v;
    __syncthreads();
    float s = 0.f;
#pragma unroll
    for (int i = 0; i < 8; ++i) s += red[i];
    return s;
}

__device__ __forceinline__ void tr_tile(const float* __restrict__ src, int N, int K, bf16_t* __restrict__ dst, int k0, int n0, int drow0, float* tile, int tid) {
#pragma unroll
    for (int i = 0; i < 2; ++i) { const int kk = (tid >> 4) + i * 32, n4 = (tid & 15) * 4;
        const f32x4 v = *(const f32x4*)(src + (size_t)(k0 + kk) * N + n0 + n4);
        tile[kk * 65 + n4 + 0] = v[0]; tile[kk * 65 + n4 + 1] = v[1]; tile[kk * 65 + n4 + 2] = v[2]; tile[kk * 65 + n4 + 3] = v[3]; }
    __syncthreads();
    const int n = tid >> 3, kg = tid & 7; f32x4 a, b;
#pragma unroll
    for (int j = 0; j < 4; ++j) { a[j] = tile[(kg * 8 + j) * 65 + n]; b[j] = tile[(kg * 8 + 4 + j) * 65 + n]; }
    *(u32x4*)(dst + (size_t)(drow0 + n) * K + k0 + kg * 8) = pack8(a, b);
    __syncthreads();
}

__device__ __forceinline__ float sconv(const bf16_t* __restrict__ row, int b, int s, float w0, float w1, float w2, float bias) {
    const bf16_t* p = row + b * 2048 + s;
    const float c = bf2f(p[0]); const float l = s > 0 ? bf2f(p[-1]) : 0.f; const float r = s < 2047 ? bf2f(p[1]) : 0.f;
    return w0 * l + w1 * c + w2 * r + bias;
}

#define XB_TMO      128
#define XB_XCNT(j)  (256  + 64 * (j))
#define XB_XSUB(j)  (1280 + 64 * (j))
#define XB_XGEN(j)  (2304 + 64 * (j))
#define XB_TOP      3328
#define XB_TOPGEN   3392
#define XCD_BAR_WORDS 3456
#define XB_SPIN_CAP (1u << 22)

__device__ __forceinline__ unsigned xb_ld(unsigned* p)              { return __hip_atomic_load(p, __ATOMIC_RELAXED, __HIP_MEMORY_SCOPE_AGENT); }
__device__ __forceinline__ unsigned xb_add(unsigned* p, unsigned v) { return __hip_atomic_fetch_add(p, v, __ATOMIC_RELAXED, __HIP_MEMORY_SCOPE_AGENT); }
__device__ __forceinline__ unsigned xb_xcc_id() { return (unsigned)__builtin_amdgcn_s_getreg((3 << 11) | 20) & 0xFu; }
#define XB_SPIN(cond, bar) do { unsigned _sp = 0; while (cond) { __builtin_amdgcn_s_sleep(1); \
    if ((++_sp & 255u) == 0u) { if (xb_ld(&(bar)[XB_TMO])) break; if (_sp > XB_SPIN_CAP) { atomicAdd(&(bar)[XB_TMO], 1u); break; } } } } while (0)

struct XcdBarrier {
    unsigned* bar; unsigned x;
    volatile LAS unsigned* st;
};

__device__ __forceinline__ XcdBarrier xcd_barrier_post(unsigned* bar, volatile LAS unsigned* st) {
    XcdBarrier b; b.bar = bar; b.x = xb_xcc_id(); b.st = st;
    if (threadIdx.x == 0) (void)xb_add(&bar[XB_XCNT(b.x)], 1u);
    return b;
}
__device__ __forceinline__ void xcd_barrier_complete(unsigned* bar, unsigned x, unsigned& nloc, unsigned& nx) {
    const unsigned G = gridDim.x * gridDim.y * gridDim.z;
    unsigned sum, cnt, mine, sp = 0u;
    for (;;) {
        sum = 0u; cnt = 0u; mine = 0u;
#pragma unroll
        for (unsigned j = 0; j < 16; ++j) { const unsigned c = xb_ld(&bar[XB_XCNT(j)]); sum += c; cnt += (c > 0u) ? 1u : 0u; mine = (j == x) ? c : mine; }
        if (sum == G) break;
        __builtin_amdgcn_s_sleep(1);
        if ((++sp & 255u) == 0u) { if (xb_ld(&bar[XB_TMO])) break; if (sp > XB_SPIN_CAP) { atomicAdd(&bar[XB_TMO], 1u); break; } }
    }
    nloc = mine > 0u ? mine : 1u; nx = cnt > 0u ? cnt : 1u;
}

__device__ __forceinline__ void xcd_barrier(const XcdBarrier& b) {
    asm volatile("s_waitcnt vmcnt(0)" ::: "memory");
    __syncthreads();
    if (threadIdx.x == 0) {
        unsigned* bar = b.bar;
        __builtin_amdgcn_s_waitcnt(0);
        unsigned nloc = b.st[0], nx = b.st[1];
        if (nloc == 0u) { xcd_barrier_complete(bar, b.x, nloc, nx); b.st[0] = nloc; b.st[1] = nx; }
        const unsigned old = xb_add(&bar[XB_XSUB(b.x)], 1u);
        const unsigned gen = old / nloc;
        if (old + 1u == (gen + 1u) * nloc) {
            __builtin_amdgcn_fence(__ATOMIC_RELEASE, "agent");
            asm volatile("s_waitcnt vmcnt(0)" ::: "memory");
            const unsigned og = xb_add(&bar[XB_TOP], 1u);
            const unsigned tg = og / nx;
            if (og + 1u == (tg + 1u) * nx) xb_add(&bar[XB_TOPGEN], 1u);
            else XB_SPIN(xb_ld(&bar[XB_TOPGEN]) == tg, bar);
            __builtin_amdgcn_fence(__ATOMIC_ACQUIRE, "agent");
            xb_add(&bar[XB_XGEN(b.x)], 1u);
            asm volatile("s_waitcnt vmcnt(0)" ::: "memory");
        } else {
            XB_SPIN(xb_ld(&bar[XB_XGEN(b.x)]) == gen, bar);
            __builtin_amdgcn_fence(__ATOMIC_ACQUIRE, "agent");
            asm volatile("s_waitcnt vmcnt(0)" ::: "memory");
        }
    }
    __syncthreads();
}


__device__ __forceinline__ void my_barrier(unsigned* bar, unsigned target) {
    asm volatile("s_waitcnt vmcnt(0)" ::: "memory");
    __syncthreads();
    if (threadIdx.x == 0) {
        __builtin_amdgcn_fence(__ATOMIC_RELEASE, "agent");
        asm volatile("s_waitcnt vmcnt(0)" ::: "memory");
        __hip_atomic_fetch_add(bar, 1u, __ATOMIC_RELAXED, __HIP_MEMORY_SCOPE_AGENT);
        while (__hip_atomic_load(bar, __ATOMIC_RELAXED, __HIP_MEMORY_SCOPE_AGENT) < target) __builtin_amdgcn_s_sleep(2);
        __builtin_amdgcn_fence(__ATOMIC_ACQUIRE, "agent");
        asm volatile("s_waitcnt vmcnt(0)" ::: "memory");
    }
    __syncthreads();
}

template <bool TOBF> __device__ __forceinline__ void rmsnorm_rows(const float* x, const float* __restrict__ g, bf16_t* ob, float* of, int bid, int G, int wave, int lane) {
    for (int row = bid * 8 + wave; row < NTOK; row += G * 8) {
        const float* xr = x + (size_t)row * DM; f32x4 v[8]; float q = 0.f;
#pragma unroll
        for (int i = 0; i < 8; ++i) { v[i] = *(const f32x4*)(xr + lane * 4 + i * 256); q += (v[i][0] * v[i][0] + v[i][1] * v[i][1]) + (v[i][2] * v[i][2] + v[i][3] * v[i][3]); }
        for (int o = 32; o >= 1; o >>= 1) q += __shfl_xor(q, o);
        const float rs = rsqrtf(q * (1.0f / 2048.0f) + EPSV);
#pragma unroll
        for (int i = 0; i < 8; ++i) { const f32x4 gg = *(const f32x4*)(g + lane * 4 + i * 256); const f32x4 y = v[i] * rs * gg;
            if (TOBF) { u32x2 w; w.x = cvt_pk_bf16(y[0], y[1]); w.y = cvt_pk_bf16(y[2], y[3]); *(u32x2*)(ob + (size_t)row * DM + lane * 4 + i * 256) = w; }
            else *(f32x4*)(of + (size_t)row * DM + lane * 4 + i * 256) = y; }
    }
}


#ifdef SELFCHK
__device__ __forceinline__ unsigned hsh(unsigned x) { x ^= x >> 16; x *= 0x7feb352du; x ^= x >> 15; x *= 0x846ca68bu; x ^= x >> 16; return x; }
__device__ __forceinline__ float wdot(const bf16_t* a, const bf16_t* b, int K, int lane) { float s = 0.f; for (int k = lane; k < K; k += 64) s += bf2f(a[k]) * bf2f(b[k]); for (int o = 32; o >= 1; o >>= 1) s += __shfl_xor(s, o); return s; }
__device__ __forceinline__ void chk_flag(unsigned* flags, bool bad, unsigned bit) { if (__any(bad) && (threadIdx.x & 63) == 0) atomicOr(flags, bit); }
__device__ __forceinline__ bool far(float got, float ref) { return !(fabsf(got - ref) <= 0.02f * fabsf(ref) + 0.02f); }
#define CHK(...) do { __VA_ARGS__ } while (0)
#else
#define CHK(...) do { } while (0)
#endif

__global__ void __launch_bounds__(NTHR, 2) fwd_megakernel(Params P) {
    extern __shared__ __attribute__((aligned(16))) unsigned char smem[];
    cg::grid_group grid = cg::this_grid();
    const int tid = threadIdx.x, lane = tid & 63, wave = tid >> 6;
    const int G = gridDim.x, bid = blockIdx.x;
    unsigned char* ws = P.ws;
    LAS unsigned char* lds = (LAS unsigned char*)smem;
    const int lo = P.lo, hi = P.hi;
#define IN(k) (lo <= (k) && (k) < hi)
#define SEAM(k) do { if ((k) + 1 < hi) { if (lo > (k) + 1000) grid.sync();   xcd_barrier(xb); } } while (0)

    { volatile LAS unsigned* stw = (volatile LAS unsigned*)(lds + 146400); if (tid < 2) stw[tid] = 0u; __syncthreads(); }
    const XcdBarrier xb = xcd_barrier_post((unsigned*)(ws + WS_BAR + 16384), (volatile LAS unsigned*)(lds + 146400));
    float* stats = (float*)(ws + WS_STATS); float* ss1 = (float*)(ws + WS_SS1); float* ss2 = (float*)(ws + WS_SS2); float* h3 = (float*)(ws + WS_H3);
    bf16_t* WinT = (bf16_t*)(ws + W_IN); bf16_t* WbhT = (bf16_t*)(ws + W_BH); bf16_t* WbsT = (bf16_t*)(ws + W_BS); bf16_t* WoutT = (bf16_t*)(ws + W_OUT);
    bf16_t* WfiT = (bf16_t*)(ws + W_FI); bf16_t* WfoT = (bf16_t*)(ws + W_FO);
    bf16_t* Hn = (bf16_t*)(ws + WS_R2); bf16_t* Yhy = (bf16_t*)(ws + WS_R2); bf16_t* Ysgu = (bf16_t*)(ws + WS_R2 + 33554432);
    bf16_t* PT = (bf16_t*)(ws + R3_PT); bf16_t* PROJ2 = (bf16_t*)(ws + R3_PROJ2); bf16_t* MERGED = (bf16_t*)(ws + R3_MERGED); bf16_t* H2 = (bf16_t*)(ws + R3_H2); bf16_t* HID = (bf16_t*)(ws + R3_HID);
    float* SSP = (float*)(ws + WS_R2);
    float* KF = P.out; bf16_t* YT = (bf16_t*)((unsigned char*)P.out + 33554432);

    auto weight_tiles = [&](int t_lo, int t_hi) {
            float* tile = (float*)smem;
            struct TJ { const float* src; bf16_t* dst; int K, N, k0, n0, mode; };
            auto decode = [&](int ti, TJ& j) {
                int li, ntl; j.mode = 0;
                if (ti < 1152) { j.src = P.in[2]; j.dst = WinT; j.K = 2048; j.N = 9216; li = ti; ntl = 36; }
                else if (ti < 1280) { j.src = P.in[18]; j.dst = WbhT; j.K = 1024; j.N = 2048; li = ti - 1152; ntl = 8; }
                else if (ti < 1408) { j.src = P.in[19]; j.dst = WbsT; j.K = 1024; j.N = 2048; li = ti - 1280; ntl = 8; }
                else if (ti < 1664) { j.src = P.in[20]; j.dst = WoutT; j.K = 2048; j.N = 2048; li = ti - 1408; ntl = 8; }
                else if (ti < 3072) { j.src = P.in[22]; j.dst = WfiT; j.K = 2048; j.N = 11264; li = ti - 1664; ntl = 44; j.mode = 1; }
                else { j.src = P.in[23]; j.dst = WfoT; j.K = 5632; j.N = 2048; li = ti - 3072; ntl = 8; }
                j.k0 = (li / ntl) * 64; j.n0 = (li % ntl) * 256; };
            f32x4 v[8]; TJ cur, nxt; int ti = t_lo + bid; bool have = ti < t_hi;
            if (have) { decode(ti, cur);
#pragma unroll
                for (int i = 0; i < 8; ++i) { const int idx = tid + i * NTHR, kk = idx >> 6, n4 = (idx & 63) * 4; v[i] = *(const f32x4*)(cur.src + (size_t)(cur.k0 + kk) * cur.N + cur.n0 + n4); } }
            while (have) {
#pragma unroll
                for (int i = 0; i < 8; ++i) { const int idx = tid + i * NTHR, kk = idx >> 6, n4 = (idx & 63) * 4; *(f32x4*)(tile + kk * 260 + (n4 ^ (((kk >> 3) & 7) << 2))) = v[i]; }
                __syncthreads();
                const int nti = ti + G; const bool hn = nti < t_hi;
                if (hn) { decode(nti, nxt);
#pragma unroll
                    for (int i = 0; i < 8; ++i) { const int idx = tid + i * NTHR, kk = idx >> 6, n4 = (idx & 63) * 4; v[i] = *(const f32x4*)(nxt.src + (size_t)(nxt.k0 + kk) * nxt.N + nxt.n0 + n4); } }
#pragma unroll
                for (int i = 0; i < 4; ++i) { const int item = tid + i * NTHR, n = item >> 3, kg = item & 7; f32x4 a, b;
#pragma unroll
                    for (int j = 0; j < 4; ++j) { a[j] = tile[(kg * 8 + j) * 260 + (n ^ (kg << 2))]; b[j] = tile[(kg * 8 + 4 + j) * 260 + (n ^ (kg << 2))]; }
                    int drow = cur.n0 + n;
                    if (cur.mode == 1) { const int up = drow >= DFF; const int jj = up ? drow - DFF : drow; drow = 256 * (jj >> 7) + (up ? 128 : 0) + (jj & 127); }
                    *(u32x4*)(cur.dst + (size_t)drow * cur.K + cur.k0 + kg * 8) = pack8(a, b); }
                __syncthreads();
                ti = nti; have = hn; cur = nxt;
            }
        __syncthreads();
    };
    if (((PHASE_MASK >> 0) & 1) && IN(0)) {
        weight_tiles(0, 1152);
        rmsnorm_rows<true>(P.in[0], P.in[1], Hn, nullptr, bid, G, wave, lane);
        {
            float* zf = (float*)smem; float* ha = zf + 8 * 40; float* hb = ha + 8 * 64;
            const float* w1 = P.in[5]; const float* b1 = P.in[6]; const float* w2 = P.in[7]; const float* b2 = P.in[8]; const float* w3 = P.in[9]; const float* b3 = P.in[10]; const float* fq_ = P.in[11];
            for (int pg = bid; pg < 256; pg += G) {
                const int pos = pg * 8 + wave;
                __syncthreads();
                if (lane < 33) {
                    float z;
                    if (lane == 0) z = (float)pos / 2047.0f;
                    else { const int mband = (lane - 1) & 15; const float f = 1e-4f + (float)mband * ((15.0f - 1e-4f) / 15.0f); const float w = (6.2831855f * (float)pos) / 2048.0f; const float a = f * w;
                        z = lane < 17 ? __cosf(a) : -__sinf(a); }
                    zf[wave * 40 + lane] = z;
                }
                __syncthreads();
                const float fr = fq_[lane];
                float a = b1[lane];
#pragma unroll 3
                for (int i = 0; i < 33; ++i) a += zf[wave * 40 + i] * w1[i * 64 + lane];
                ha[wave * 64 + lane] = __sinf(fr * a);
                __syncthreads();
                a = b2[lane];
#pragma unroll 8
                for (int i = 0; i < 64; ++i) a += ha[wave * 64 + i] * w2[i * 64 + lane];
                hb[wave * 64 + lane] = __sinf(fr * a);
                __syncthreads();
                a = b3[lane];
#pragma unroll 8
                for (int i = 0; i < 64; ++i) a += hb[wave * 64 + i] * w3[i * 64 + lane];
                h3[pos * 64 + lane] = __sinf(fr * a);
            }
            __syncthreads();
        }
        SEAM(0);
    }

    if (((PHASE_MASK >> 1) & 1) && IN(1)) {
        CHK(
            { const unsigned sid = bid * 8 + wave; unsigned* flags = (unsigned*)(ws + WS_BAR + 64); bool bad = false;
              { const int n = hsh(sid * 7 + 1) % 9216, k = (hsh(sid * 7 + 2) + lane) % 2048; bad |= WinT[(size_t)n * 2048 + k] != f2bf(P.in[2][(size_t)k * 9216 + n]); }
              { const int j = hsh(sid * 7 + 3) % 5632, k = (hsh(sid * 7 + 4) + lane) % 2048; const int rg = 256 * (j >> 7) + (j & 127);
                bad |= WfiT[(size_t)rg * 2048 + k] != f2bf(P.in[22][(size_t)k * 11264 + j]); bad |= WfiT[(size_t)(rg + 128) * 2048 + k] != f2bf(P.in[22][(size_t)k * 11264 + 5632 + j]); }
              { const int n = hsh(sid * 7 + 5) % 2048, k = (hsh(sid * 7 + 6) + lane) % 5632; bad |= WfoT[(size_t)n * 5632 + k] != f2bf(P.in[23][(size_t)k * 2048 + n]); }
              { const int n = hsh(sid * 7 + 5) % 2048, k = (hsh(sid * 7 + 6) + lane) % 1024; bad |= WbhT[(size_t)n * 1024 + k] != f2bf(P.in[18][(size_t)k * 2048 + n]); bad |= WbsT[(size_t)n * 1024 + k] != f2bf(P.in[19][(size_t)k * 2048 + n]); }
              { const int n = hsh(sid * 7 + 5) % 2048, k = (hsh(sid * 7 + 6) + lane) % 2048; bad |= WoutT[(size_t)n * 2048 + k] != f2bf(P.in[20][(size_t)k * 2048 + n]); }
              chk_flag(flags, bad, 1u); }
        );
        {
            const float* w4 = P.in[12]; float* Wl = (float*)smem;
            for (int cb = bid; cb < 256; cb += G) {
                __syncthreads();
                for (int idx = tid; idx < 1024; idx += NTHR) { const int cc = idx & 15, j = idx >> 4; Wl[cc * 64 + j] = w4[(size_t)j * 4096 + cb * 16 + cc]; }
                __syncthreads();
                for (int pp2 = 0; pp2 < 2; ++pp2) {
                    const int pos0 = (wave * 4 + pp2 * 2) * 64 + lane, pos1 = pos0 + 64;
                    float h0[64], h1[64];
#pragma unroll
                    for (int j4 = 0; j4 < 16; ++j4) { const f32x4 t0 = *(const f32x4*)(h3 + pos0 * 64 + j4 * 4), t1 = *(const f32x4*)(h3 + pos1 * 64 + j4 * 4);
#pragma unroll
                        for (int k = 0; k < 4; ++k) { h0[j4 * 4 + k] = t0[k]; h1[j4 * 4 + k] = t1[k]; } }
                    const float tt0 = (float)pos0 / 2047.0f, tt1 = (float)pos1 / 2047.0f;
                    for (int cc = 0; cc < 16; ++cc) {
                        const int col = cb * 16 + cc; const int dir = col >> 11, o = (col >> 10) & 1, c = col & 1023;
                        float a0 = 0.f, a1 = 0.f;
#pragma unroll
                        for (int j4 = 0; j4 < 16; ++j4) { const f32x4 w = *(const f32x4*)(Wl + cc * 64 + j4 * 4);
#pragma unroll
                            for (int k = 0; k < 4; ++k) { a0 += h0[j4 * 4 + k] * w[k]; a1 += h1[j4 * 4 + k] * w[k]; } }
                        const float ad = 3.0701134573f + (float)c * ((15.3505672866f - 3.0701134573f) / 1023.0f);
                        const float v0 = a0 * __expf(-tt0 * ad), v1 = a1 * __expf(-tt1 * ad);
                        float* kr = KF + (size_t)(o * 1024 + c) * 4096;
                        if (dir == 0) { kr[2048 + pos0] = v0; kr[2048 + pos1] = v1; }
                        else { if (pos0 >= 1) kr[2048 - pos0] = v0; else kr[0] = 0.f; kr[2048 - pos1] = v1; }
                    }
                }
            }
            __syncthreads();
        }
        {
            pg8::Gemm g{WinT, Hn, 3072, NTOK, DM}; pg8::StaticOrder S; S.init(3072, NTOK, G, bid);
            Epi1a E{PT, NTOK}; pg8::gemm_phase<Epi1a>(lds, g, S, E);
        }
        {
            pg8::Gemm g{Hn, WinT + (size_t)3072 * DM, NTOK, 6144, DM}; pg8::StaticOrder S; S.init(NTOK, 6144, G, bid);
            Epi1b E{PROJ2}; pg8::gemm_phase<Epi1b>(lds, g, S, E);
        }
        SEAM(1);
    }

    if (((PHASE_MASK >> 2) & 1) && IN(2)) {
        CHK(
            { const unsigned sid = bid * 8 + wave; unsigned* flags = (unsigned*)(ws + WS_BAR + 64);
              { const int ch = hsh(sid * 5 + 11) % 3072, tok = hsh(sid * 5 + 12) % 8192; const float ref = wdot(WinT + (size_t)ch * 2048, Hn + (size_t)tok * 2048, 2048, lane);
                chk_flag(flags, far(bf2f(PT[(size_t)ch * NTOK + tok]), ref), 2u); }
              { const int col = hsh(sid * 5 + 13) % 6144, tok = hsh(sid * 5 + 14) % 8192; const float r0 = wdot(Hn + (size_t)tok * 2048, WinT + (size_t)(3072 + col) * 2048, 2048, lane);
                const float ref = col < 2048 ? 0.5f * r0 * (1.0f + erff(r0 * 0.70710678f)) : 1.0f / (1.0f + expf(-r0));
                chk_flag(flags, far(bf2f(PROJ2[(size_t)tok * 6144 + col]), ref), 4u); } }
        );
        const int wgrp = (bid & 7) % 3;
        if (wgrp == 0) weight_tiles(1152, 3776);
        {
            unsigned char* Z1 = smem;
            unsigned char* Z2 = smem + 34816;
            unsigned char* KS = smem + 69632;
            bf16_t* KR = (bf16_t*)(smem + 137472);
            float* red = (float*)(smem + 145696);
            const float* scw = P.in[3]; const float* scb = P.in[4]; const float* hbias = P.in[13];
            for (int i = tid; i < 1024; i += NTHR) { const int buf = i >> 9, w = i & 511; const int off = (w < 256 ? 0 : 66 * 512 - 1024) + w * 4; *(unsigned*)((buf ? Z2 : Z1) + off) = 0u; }
            const int pp = wave & 1, gg = wave >> 1, li = lane & 15, lq = lane >> 4, bb = li & 7, jsel = li >> 3;
            const unsigned boff = (unsigned)(jsel * 512 + bb * 64 + ((lq ^ ((bb >> 2) << 1)) * 16));
            const int rcp_ = 7 - (li & 7); const int ksl = rcp_ * 8448 + 48 * (rcp_ & 3) + 2 * (2040 - 16 * pp - 8 * (li >> 3) + 8 * lq);
            float kv[8];
            if (bid < DH) { const float* kr0 = KF + (size_t)bid * 4096;
#pragma unroll
                for (int j = 0; j < 8; ++j) kv[j] = kr0[tid + j * NTHR]; }
            for (int c = bid; c < DH; c += G) {
                __syncthreads();
                {   const float w0 = scw[c], w1 = scw[3072 + c], w2 = scw[6144 + c], bs = scb[c];
                    for (int ch = tid; ch < 2048; ch += NTHR) { const int b = ch >> 8, s = (ch & 255) * 8; const bf16_t* src = PT + (size_t)c * NTOK + b * 2048 + s;
                        f32x4 fa, fb; unpack8(*(const u32x4*)src, fa, fb); const float fl = s > 0 ? bf2f(src[-1]) : 0.f, fr_ = s + 8 < 2048 ? bf2f(src[8]) : 0.f;
                        f32x4 oa, ob;
                        oa[0] = w0 * fl + w1 * fa[0] + w2 * fa[1] + bs; oa[1] = w0 * fa[0] + w1 * fa[1] + w2 * fa[2] + bs; oa[2] = w0 * fa[1] + w1 * fa[2] + w2 * fa[3] + bs; oa[3] = w0 * fa[2] + w1 * fa[3] + w2 * fb[0] + bs;
                        ob[0] = w0 * fa[3] + w1 * fb[0] + w2 * fb[1] + bs; ob[1] = w0 * fb[0] + w1 * fb[1] + w2 * fb[2] + bs; ob[2] = w0 * fb[1] + w1 * fb[2] + w2 * fb[3] + bs; ob[3] = w0 * fb[2] + w1 * fb[3] + w2 * fr_ + bs;
                        const int J = s >> 5, chunk = (s & 31) >> 3;
                        *(u32x4*)(Z1 + ((J + 2) * 8 + b) * 64 + ((chunk ^ ((b >> 2) << 1)) * 16)) = pack8(oa, ob); } }
                for (int o = 0; o < 2; ++o) {
                    float part = 0.f;
#pragma unroll
                    for (int j = 0; j < 8; ++j) { part += fabsf(kv[j]); KR[4095 - (tid + j * NTHR)] = f2bf(kv[j]); }
                    if (tid < 8) KR[4096 + tid] = 0;
                    const float scale = 1.0f / block_sum(part, red, tid);
                    {   const u32x4 c0 = *(const u32x4*)(KR + tid * 8), c1 = *(const u32x4*)(KR + tid * 8 + 8);
                        const unsigned D[8] = {c0.x, c0.y, c0.z, c0.w, c1.x, c1.y, c1.z, c1.w};
#pragma unroll
                        for (int r = 0; r < 8; ++r) { u32x4 w; const int sft = r >> 1;
                            if (r & 1) { w.x = __builtin_amdgcn_alignbit(D[sft + 1], D[sft], 16); w.y = __builtin_amdgcn_alignbit(D[sft + 2], D[sft + 1], 16); w.z = __builtin_amdgcn_alignbit(D[sft + 3], D[sft + 2], 16); w.w = __builtin_amdgcn_alignbit(D[sft + 4], D[sft + 3], 16); }
                            else { w.x = D[sft]; w.y = D[sft + 1]; w.z = D[sft + 2]; w.w = D[sft + 3]; }
                            *(u32x4*)(KS + r * 8448 + 48 * (r & 3) + tid * 16) = w; } }
                    __syncthreads();
                    {
                        const int nc = o == 0 ? c : c + G, no = o == 0 ? 1 : 0;
                        if (nc < DH) { const float* krn = KF + (size_t)(no * 1024 + nc) * 4096;
#pragma unroll
                            for (int j = 0; j < 8; ++j) kv[j] = krn[tid + j * NTHR]; } }
                    const unsigned char* Zin = o ? Z2 : Z1;
                    const int chx = (o == 0 ? 1024 : 2048) + c;
                    u32x2 xwv[8]; unsigned short xlv[8], xrv[8];
#pragma unroll
                    for (int a = 0; a < 8; ++a) { const int I = pp + 2 * (16 * gg + 2 * a + jsel); const int t0 = 16 * I + 4 * lq; const bf16_t* src = PT + (size_t)chx * NTOK + bb * 2048 + t0;
                        xwv[a] = *(const u32x2*)src; xlv[a] = t0 > 0 ? src[-1] : (unsigned short)0; xrv[a] = t0 + 4 < 2048 ? src[4] : (unsigned short)0; }
                    f32x4 acc[8];
#pragma unroll
                    for (int a = 0; a < 8; ++a) acc[a] = (f32x4){0.f, 0.f, 0.f, 0.f};
#define HY_LA(E) (*(const bf16x8*)(KS + ksl - 64 * (E)))
#define HY_LBJ(J0) (*(const bf16x8*)(Zin + (((J0) >= -1 && (J0) <= 63) ? ((J0) + 2) : 0) * 512 + boff))
                    {
                        bf16x8 aE[8], aO[8];
                        const int e0 = 16 * gg - 63;
#pragma unroll
                        for (int a2 = 0; a2 < 8; ++a2) { aE[a2] = HY_LA(e0 + 2 * a2); aO[a2] = HY_LA(e0 + 1 + 2 * a2); }
                        bf16x8 bfe = HY_LBJ(63);
                        for (int ib = 0; ib < 64; ib += 16) {
#pragma unroll
                            for (int k = 0; k < 8; ++k) { const int i = ib + 2 * k;
                                const bf16x8 bfo = HY_LBJ(62 - i);
#pragma unroll
                                for (int a2 = 0; a2 < 8; ++a2) acc[a2] = __builtin_amdgcn_mfma_f32_16x16x32_bf16(aE[(a2 + k) & 7], bfe, acc[a2], 0, 0, 0);
                                aE[k & 7] = HY_LA(e0 + i + 16);
                                bfe = HY_LBJ(61 - i);
#pragma unroll
                                for (int a2 = 0; a2 < 8; ++a2) acc[a2] = __builtin_amdgcn_mfma_f32_16x16x32_bf16(aO[(a2 + k) & 7], bfo, acc[a2], 0, 0, 0);
                                aO[k & 7] = HY_LA(e0 + i + 17);
                            }
                        }
#pragma unroll
                        for (int a2 = 0; a2 < 8; ++a2) acc[a2] = __builtin_amdgcn_mfma_f32_16x16x32_bf16(aE[a2], bfe, acc[a2], 0, 0, 0);
                    }
#undef HY_LA
#undef HY_LBJ
                    const float bo = hbias[o * 1024 + c];
                    const float w0 = scw[chx], w1 = scw[3072 + chx], w2 = scw[6144 + chx], bs = scb[chx];
#pragma unroll
                    for (int a = 0; a < 8; ++a) { const int I = pp + 2 * (16 * gg + 2 * a + jsel); const int t0 = 16 * I + 4 * lq;
                        const int zaddr = ((t0 >> 5) + 2) * 512 + bb * 64 + ((((t0 & 31) >> 3) ^ ((bb >> 2) << 1)) * 16) + (t0 & 7) * 2;
                        const u32x2 zw = *(const u32x2*)(Zin + zaddr);
                        const float z0 = __uint_as_float(zw.x << 16), z1 = __uint_as_float(zw.x & 0xffff0000u), z2 = __uint_as_float(zw.y << 16), z3 = __uint_as_float(zw.y & 0xffff0000u);
                        const u32x2 xw = xwv[a];
                        const float x0 = __uint_as_float(xw.x << 16), x1 = __uint_as_float(xw.x & 0xffff0000u), x2 = __uint_as_float(xw.y << 16), x3 = __uint_as_float(xw.y & 0xffff0000u);
                        const float xl = bf2f(xlv[a]), xr = bf2f(xrv[a]);
                        const float r0 = (w0 * xl + w1 * x0 + w2 * x1 + bs) * (acc[a][0] * scale + z0 * bo), r1 = (w0 * x0 + w1 * x1 + w2 * x2 + bs) * (acc[a][1] * scale + z1 * bo);
                        const float r2 = (w0 * x1 + w1 * x2 + w2 * x3 + bs) * (acc[a][2] * scale + z2 * bo), r3 = (w0 * x2 + w1 * x3 + w2 * xr + bs) * (acc[a][3] * scale + z3 * bo);
                        u32x2 w; w.x = cvt_pk_bf16(r0, r1); w.y = cvt_pk_bf16(r2, r3);
                        if (o == 0) *(u32x2*)(Z2 + zaddr) = w; else *(u32x2*)(YT + (size_t)c * NTOK + bb * 2048 + t0) = w; }
                    __syncthreads();
                }
            }
        }
        if (wgrp == 1) weight_tiles(1152, 3776);
        {
            bf16_t* Wl = (bf16_t*)smem;
            bf16_t* Vl = (bf16_t*)(smem + 36864);
            float* stl = (float*)(smem + 73728);
            const float* lng = P.in[14]; const float* lnb = P.in[15]; const float* w_s = P.in[16]; const float* b_s = P.in[17];
            const int li = lane & 15, lq = lane >> 4;
            for (int item = bid; item < 256; item += G) {
              const int bn = item >> 1, tok0 = bn * 128;
              __syncthreads();
              for (int qb = 0; qb < 4; ++qb) {
                  u32x4 raw[4][2];
#pragma unroll
                  for (int k = 0; k < 4; ++k) { const bf16_t* vp = PROJ2 + (size_t)(tok0 + wave * 16 + qb * 4 + k) * 6144 + 1024 + lane * 16; raw[k][0] = *(const u32x4*)vp; raw[k][1] = *(const u32x4*)(vp + 8); }
#pragma unroll
                  for (int k = 0; k < 4; ++k) { const int q = wave * 16 + qb * 4 + k;
                      f32x4 a0, a1, a2, a3; unpack8(raw[k][0], a0, a1); unpack8(raw[k][1], a2, a3);
                      float sm = 0.f, sq = 0.f;
#pragma unroll
                      for (int j = 0; j < 4; ++j) { sm += (a0[j] + a1[j]) + (a2[j] + a3[j]); sq += (a0[j] * a0[j] + a1[j] * a1[j]) + (a2[j] * a2[j] + a3[j] * a3[j]); }
                      for (int o = 32; o >= 1; o >>= 1) { sm += __shfl_xor(sm, o); sq += __shfl_xor(sq, o); }
                      if (lane == 0) { const float mean = sm * (1.0f / 1024.0f); const float var = sq * (1.0f / 1024.0f) - mean * mean; stl[2 * q] = mean; stl[2 * q + 1] = rsqrtf(var + EPSV); } }
              }
              for (int hh = 0; hh < 4; ++hh) {
                const int h = (item & 1) * 4 + hh;
                __syncthreads();
                for (int ch = tid; ch < 2048; ch += NTHR) {
                    { const int p = ch >> 4, q8 = (ch & 15) * 8; const float* wp = w_s + (size_t)h * 16384 + p * 128 + q8;
                      *(u32x4*)(Wl + p * 144 + q8) = pack8(*(const f32x4*)wp, *(const f32x4*)(wp + 4)); }
                    { const int q = ch >> 4, c8 = (ch & 15) * 8; const float sm = stl[2 * q], rstd = stl[2 * q + 1];
                      f32x4 va, vb; unpack8(*(const u32x4*)(PROJ2 + (size_t)(tok0 + q) * 6144 + 1024 + h * 128 + c8), va, vb);
                      const f32x4 ga = *(const f32x4*)(lng + h * 128 + c8), gb = *(const f32x4*)(lng + h * 128 + c8 + 4), ba = *(const f32x4*)(lnb + h * 128 + c8), bb_ = *(const f32x4*)(lnb + h * 128 + c8 + 4);
                      va = (va - sm) * rstd * ga + ba; vb = (vb - sm) * rstd * gb + bb_;
#pragma unroll
                      for (int j = 0; j < 4; ++j) { Vl[(c8 + j) * 144 + q] = f2bf(va[j]); Vl[(c8 + 4 + j) * 144 + q] = f2bf(vb[j]); } }
                }
                __syncthreads();
                f32x4 acc[8];
#pragma unroll
                for (int ct = 0; ct < 8; ++ct) acc[ct] = (f32x4){0.f, 0.f, 0.f, 0.f};
#pragma unroll
                for (int kk = 0; kk < 4; ++kk) { const bf16x8 wf = *(const bf16x8*)(Wl + (wave * 16 + li) * 144 + kk * 32 + lq * 8);
#pragma unroll
                    for (int ct = 0; ct < 8; ++ct) { const bf16x8 vf = *(const bf16x8*)(Vl + (ct * 16 + li) * 144 + kk * 32 + lq * 8);
                        acc[ct] = __builtin_amdgcn_mfma_f32_16x16x32_bf16(vf, wf, acc[ct], 0, 0, 0); } }
                {   const int p = wave * 16 + li, tok = tok0 + p; const float bs = b_s[h * 128 + p];
#pragma unroll
                    for (int ct = 0; ct < 8; ++ct) { const int cc = h * 128 + ct * 16 + lq * 4; const u32x2 uw = *(const u32x2*)(PROJ2 + (size_t)tok * 6144 + cc);
                        const float u0 = __uint_as_float(uw.x << 16), u1 = __uint_as_float(uw.x & 0xffff0000u), u2 = __uint_as_float(uw.y << 16), u3 = __uint_as_float(uw.y & 0xffff0000u);
                        u32x2 w; w.x = cvt_pk_bf16(u0 * (acc[ct][0] + bs), u1 * (acc[ct][1] + bs)); w.y = cvt_pk_bf16(u2 * (acc[ct][2] + bs), u3 * (acc[ct][3] + bs));
                        *(u32x2*)(Ysgu + (size_t)tok * 1024 + cc) = w; } }
              }
            }
            __syncthreads();
        }
        if (wgrp == 2) weight_tiles(1152, 3776);
        SEAM(2);
    }

    if (((PHASE_MASK >> 3) & 1) && IN(3)) {
        auto ytrans = [&]() {
        bf16_t* tile = (bf16_t*)smem;
        u32x4 v[4]; int ti = bid; bool have = ti < 1024;
        if (have) { const int c0 = (ti & 15) * 64, t0 = (ti >> 4) * 256;
#pragma unroll
            for (int i = 0; i < 4; ++i) { const int idx = tid + i * NTHR, cr = idx >> 5, tg = idx & 31; v[i] = *(const u32x4*)(YT + (size_t)(c0 + cr) * NTOK + t0 + tg * 8); } }
        while (have) {
            const int c0 = (ti & 15) * 64, t0 = (ti >> 4) * 256;
#pragma unroll
            for (int i = 0; i < 4; ++i) { const int idx = tid + i * NTHR, cr = idx >> 5, tg = idx & 31; *(u32x4*)(tile + cr * 264 + tg * 8) = v[i]; }
            __syncthreads();
            const int nti = ti + G; const bool hn = nti < 1024;
            if (hn) { const int nc0 = (nti & 15) * 64, nt0 = (nti >> 4) * 256;
#pragma unroll
                for (int i = 0; i < 4; ++i) { const int idx = tid + i * NTHR, cr = idx >> 5, tg = idx & 31; v[i] = *(const u32x4*)(YT + (size_t)(nc0 + cr) * NTOK + nt0 + tg * 8); } }
#pragma unroll
            for (int i = 0; i < 4; ++i) { const int item = tid + i * NTHR, tr = item >> 3, cg8 = item & 7; unsigned short e[8];
#pragma unroll
                for (int j = 0; j < 8; ++j) e[j] = tile[(cg8 * 8 + j) * 264 + tr];
                u32x4 w; w.x = e[0] | ((unsigned)e[1] << 16); w.y = e[2] | ((unsigned)e[3] << 16); w.z = e[4] | ((unsigned)e[5] << 16); w.w = e[6] | ((unsigned)e[7] << 16);
                *(u32x4*)(Yhy + (size_t)(t0 + tr) * 1024 + c0 + cg8 * 8) = w; }
            __syncthreads();
            ti = nti; have = hn;
        }
        };
        if (bid & 1) ytrans();
        {   pg8::Gemm g{Ysgu, WbsT, NTOK, DM, DH}; pg8::StaticOrder S; S.init(NTOK, DM, G, bid);
            Epi4<false> E{MERGED, PROJ2 + 4096}; pg8::gemm_phase<Epi4<false>>(lds, g, S, E); }
        if (!(bid & 1)) ytrans();
        SEAM(3);
    }
#ifdef DBG_CUT3
    {
        for (size_t i = (size_t)bid * NTHR + tid; i < (size_t)NTOK * 2048; i += (size_t)G * NTHR) { const int row = (int)(i >> 11), c = (int)(i & 2047);
            P.out[i] = c < 1024 ? bf2f(Yhy[(size_t)row * 1024 + c]) : bf2f(Ysgu[(size_t)row * 1024 + c - 1024]); }
        return;
    }
#endif
    if (((PHASE_MASK >> 4) & 1) && IN(4)) {
        {   pg8::Gemm g{Yhy, WbhT, NTOK, DM, DH}; pg8::StaticOrder S; S.init(NTOK, DM, G, bid);
            Epi4<true> E{MERGED, PROJ2 + 2048}; pg8::gemm_phase<Epi4<true>>(lds, g, S, E); }
        SEAM(4);
    }

    if (((PHASE_MASK >> 5) & 1) && IN(5)) {
        pg8::Gemm g{MERGED, WoutT, NTOK, DM, DM}; pg8::StaticOrder S; S.init(NTOK, DM, G, bid);
        Epi5 E{P.in[0], P.out, SSP, P.in[21], H2}; pg8::gemm_phase<Epi5>(lds, g, S, E);
        SEAM(5);
    }
    if (((PHASE_MASK >> 6) & 1) && IN(6)) {
        pg8::Gemm g{H2, WfiT, NTOK, 2 * DFF, DM}; pg8::StaticOrder S; S.init(NTOK, 2 * DFF, G, bid, 8);
        pg8::Unit u0, u1; S.next(0, u0); u1 = u0; for (int i = 1; ; ++i) { pg8::Unit t; if (!S.next(i, t)) break; u1 = t; }
        {   float* rst = (float*)(smem + 131072);
            for (int r = tid; r < 512; r += NTHR) { const int pmr = r < 256 ? u0.pm : u1.pm; const float* sp = SSP + (size_t)(pmr * 256 + (r & 255)) * 32; float q4[4];
#pragma unroll
                for (int k = 0; k < 4; ++k) { const f32x4 p0 = *(const f32x4*)(sp + k * 8), p1 = *(const f32x4*)(sp + k * 8 + 4); q4[k] = ((p0[0] + p0[1]) + (p0[2] + p0[3])) + ((p1[0] + p1[1]) + (p1[2] + p1[3])); }
                rst[r] = rsqrtf(((q4[0] + q4[1]) + (q4[2] + q4[3])) * (1.0f / 2048.0f) + EPSV); }
            __syncthreads(); }
        Epi6 E{HID, SSP, (const LAS float*)(smem + 131072), u0.pm, u1.pm}; pg8::gemm_phase<Epi6>(lds, g, S, E);
        SEAM(6);
    }
    const bool fuse78 = (G == 256);
    if (((PHASE_MASK >> 7) & 1) && IN(7)) {
        pg8::Gemm g{HID, WfoT, NTOK, DM, DFF}; pg8::StaticOrder S; S.init(NTOK, DM, G, bid);
        if (fuse78) { S.rowmode = 1; Epi7 E{P.out, P.out, (float*)(ws + WS_R2 + 4194304), (unsigned*)(ws + WS_BAR + 1024), P.in[24]}; pg8::gemm_phase<Epi7>(lds, g, S, E); }
        else { EpiRes E{P.out, P.out}; pg8::gemm_phase<EpiRes>(lds, g, S, E); SEAM(7); }
    }
    if (((PHASE_MASK >> 8) & 1) && IN(8) && !fuse78) {
        rmsnorm_rows<false>(P.out, P.in[24], nullptr, P.out, bid, G, wave, lane);
    }
#undef IN
#undef SEAM
}

extern "C" void kernel_launch(void* const* d_in, const int* in_sizes, int n_in, void* d_out, int out_size, void* d_ws, size_t ws_size, hipStream_t stream) {
    static int grid_blocks = 0;
    if (grid_blocks == 0) {
        if (n_in != 25 || out_size != NTOK * DM || ws_size < WS_END) { fprintf(stderr, "kernel_launch: unexpected shapes n_in %d out %d ws %zu (need %zu)\n", n_in, out_size, ws_size, (size_t)WS_END); grid_blocks = -1; return; }
        int dev = 0, cus = 0, per_cu = 0;
        hipGetDevice(&dev);
        hipDeviceGetAttribute(&cus, hipDeviceAttributeMultiprocessorCount, dev);
        if (hipFuncSetAttribute((const void*)fwd_megakernel, hipFuncAttributeMaxDynamicSharedMemorySize, LDS_BYTES) != hipSuccess) { fprintf(stderr, "kernel_launch: hipFuncSetAttribute failed\n"); grid_blocks = -1; return; }
        if (hipOccupancyMaxActiveBlocksPerMultiprocessor(&per_cu, (const void*)fwd_megakernel, NTHR, LDS_BYTES) != hipSuccess || per_cu < 1) { fprintf(stderr, "kernel_launch: occupancy query gave %d\n", per_cu); per_cu = 1; }
        (void)hipGetLastError();
        grid_blocks = cus * per_cu;
    }
    if (grid_blocks < 0) return;
    if (hipMemsetAsync((char*)d_ws + WS_BAR, 0, 32768, stream) != hipSuccess) { fprintf(stderr, "kernel_launch: memset failed\n"); return; }
    Params p{};
    for (int i = 0; i < 25; ++i) p.in[i] = (const float*)d_in[i];
    p.out = (float*)d_out; p.ws = (unsigned char*)d_ws; p.lo = 0; p.hi = 9;
    void* args[] = {&p};
    hipError_t e = hipLaunchCooperativeKernel((const void*)fwd_megakernel, dim3(grid_blocks), dim3(NTHR), args, LDS_BYTES, stream);
    if (e != hipSuccess) fprintf(stderr, "cooperative launch failed: %s (grid %d)\n", hipGetErrorString(e), grid_blocks);
}
```

```cpp
#include <hip/hip_runtime.h>
#include <hip/hip_cooperative_groups.h>
#include <cstdio>
namespace cg = cooperative_groups;

#define LAS __attribute__((address_space(3)))
typedef unsigned short bf16_t;
typedef short bf16x8 __attribute__((ext_vector_type(8)));
typedef float f32x4 __attribute__((ext_vector_type(4)));
typedef float f32x2 __attribute__((ext_vector_type(2)));
typedef unsigned u32x4 __attribute__((ext_vector_type(4)));
typedef unsigned u32x2 __attribute__((ext_vector_type(2)));

constexpr int NTOK = 16384, DM = 2048, DH = 1024, DFF = 5632, SEQ = 2048;
constexpr float EPSV = 1e-6f;
constexpr int NTHR = 512;
#ifndef PHASE_MASK
#define PHASE_MASK 0x3ff
#endif
constexpr int LDS_BYTES = 146432;

constexpr size_t WS_STATS = 0;
constexpr size_t WS_SS1 = 131072;
constexpr size_t WS_SS2 = 196608;
constexpr size_t WS_H3 = 262144;
constexpr size_t WS_BAR = 917504;
constexpr size_t WS_W = 1048576;
constexpr size_t W_IN = WS_W;
constexpr size_t W_BH = W_IN + 37748736;
constexpr size_t W_BS = W_BH + 4194304;
constexpr size_t W_OUT = W_BS + 4194304;
constexpr size_t W_FI = W_OUT + 8388608;
constexpr size_t W_FO = W_FI + 46137344;
constexpr size_t WS_R2 = W_FO + 23068672;
constexpr size_t WS_R3 = WS_R2 + 67108864;
constexpr size_t R3_PT = WS_R3;
constexpr size_t R3_PROJ2 = WS_R3 + 100663296;
constexpr size_t R3_MERGED = WS_R3;
constexpr size_t R3_H2 = WS_R3 + 184549376;
constexpr size_t R3_HID = WS_R3;
constexpr size_t WS_END = WS_R3 + 301989888;

struct Params { const float* in[25]; float* out; unsigned char* ws; int lo, hi; };

__device__ __forceinline__ float bf2f(bf16_t b) { return __uint_as_float(((unsigned)b) << 16); }
__device__ __forceinline__ bf16_t f2bf(float f) { unsigned u = __float_as_uint(f); u += 0x7FFFu + ((u >> 16) & 1u); return (bf16_t)(u >> 16); }
typedef __bf16 bf16x2_t __attribute__((ext_vector_type(2)));
__device__ __forceinline__ unsigned cvt_pk_bf16(float lo, float hi) { f32x2 v = {lo, hi}; bf16x2_t b = __builtin_convertvector(v, bf16x2_t); return __builtin_bit_cast(unsigned, b); }
__device__ __forceinline__ u32x4 pack8(f32x4 a, f32x4 b) { u32x4 w; w.x = cvt_pk_bf16(a[0], a[1]); w.y = cvt_pk_bf16(a[2], a[3]); w.z = cvt_pk_bf16(b[0], b[1]); w.w = cvt_pk_bf16(b[2], b[3]); return w; }
__device__ __forceinline__ void unpack8(u32x4 w, f32x4& a, f32x4& b) {
    a[0] = __uint_as_float(w.x << 16); a[1] = __uint_as_float(w.x & 0xffff0000u); a[2] = __uint_as_float(w.y << 16); a[3] = __uint_as_float(w.y & 0xffff0000u);
    b[0] = __uint_as_float(w.z << 16); b[1] = __uint_as_float(w.z & 0xffff0000u); b[2] = __uint_as_float(w.w << 16); b[3] = __uint_as_float(w.w & 0xffff0000u); }
__device__ __forceinline__ float sigmoidf_(float x) { return __builtin_amdgcn_rcpf(1.0f + __expf(-x)); }
__device__ __forceinline__ f32x2 gelu_pk(f32x2 v) {
    const f32x2 av = __builtin_elementwise_abs(v), d = av * 0.2316418882f + 1.0f;
    f32x2 t; t.x = __builtin_amdgcn_rcpf(d.x); t.y = __builtin_amdgcn_rcpf(d.y);
    f32x2 q = t * 0.5307027145f + (-0.7265760135f); q = q * t + 0.7107068705f; q = q * t + (-0.142248368f); q = q * t + 0.127414796f; q = q * t;
    const f32x2 s = (v * v) * (-0.72134752044f);
    f32x2 e; e.x = __builtin_amdgcn_exp2f(s.x); e.y = __builtin_amdgcn_exp2f(s.y);
    const f32x2 m = v * (q * e), r = v - m;
    f32x2 o; o.x = v.x < 0.f ? m.x : r.x; o.y = v.y < 0.f ? m.y : r.y; return o;
}
__device__ __forceinline__ f32x4 gelu4(f32x4 v) { f32x2 a = gelu_pk((f32x2){v[0], v[1]}), b = gelu_pk((f32x2){v[2], v[3]}); return (f32x4){a.x, a.y, b.x, b.y}; }

namespace pg8 {
constexpr int BM = 256, BK = 64, HALF = 128, HTB = HALF * BK * 2, STAGE_BYTES = 8 * HTB, NXCD = 8, WGM = 4;
__host__ __device__ __forceinline__ int lds_byte(int r, int c) { const int st = (r >> 4) * 2 + (c >> 5), rr = r & 15, cc = c & 31, ob = rr * 64 + cc * 2; return st * 1024 + (ob ^ (((ob >> 9) & 1) << 5)); }
__host__ __device__ __forceinline__ void stage_rc(int b, int& R, int& C) { const int st = b / 1024, sb = b % 1024, swz = sb ^ (((sb >> 9) & 1) << 5); R = (st >> 1) * 16 + swz / 64; C = (st & 1) * 32 + (swz % 64) / 2; }
__host__ __device__ __forceinline__ int perm32(int rho) { const int n = rho >> 4, i = rho & 15; return 8 * (i >> 2) + 4 * n + (i & 3); }
struct Unit { int pm, pn; };
struct Gemm { const bf16_t* A; const bf16_t* Bt; int M, N, K; };
struct StaticOrder {
    int nM, nN, nwg, G, c, rowmode, wgm;
    __device__ void init(int M, int N, int G_, int c_, int wgm_ = WGM) { nM = M / BM; nN = N / BM; nwg = nM * nN; G = G_; c = c_; rowmode = 0; wgm = wgm_; }
    __device__ bool next(int i, Unit& u) const {
        const long L = (long)i * G + c; if (L >= nwg) return false;
        if (rowmode) { u.pm = i * 32 + (c & 7) * 4 + (c >> 6); u.pn = (c >> 3) & 7; return true; }
        int wgid = (int)L; { const int q = nwg / NXCD, r = nwg % NXCD, xcd = wgid % NXCD, off = wgid / NXCD; wgid = (xcd < r ? xcd * (q + 1) : r * (q + 1) + (xcd - r) * q) + off; }
        const int nig = wgm * nN, gid = wgid / nig, fm = gid * wgm, gsz = (nM - fm) < wgm ? (nM - fm) : wgm;
        u.pm = fm + ((wgid % nig) % gsz); u.pn = (wgid % nig) / gsz; return true;
    }
};

template <class Epi>
__device__ __forceinline__ void gemm_phase(LAS unsigned char* lds, const Gemm g, const StaticOrder& S, const Epi& E) {
    const int tid = threadIdx.x, wid = __builtin_amdgcn_readfirstlane(tid >> 6), lane = tid & 63, wr = wid >> 2, wc = wid & 3, fr = lane & 15, fq = lane >> 4;
    const int K = g.K, nt = K / BK;
    unsigned voffA[2], voffB[2];
#pragma unroll
    for (int i = 0; i < 2; ++i) { int R, C; stage_rc(tid * 16 + i * 8192, R, C); const int Rb = Epi::PERM ? ((R & ~31) + perm32(R & 31)) : R;
        voffA[i] = (unsigned)(R * K + C) * 2u; voffB[i] = (unsigned)(Rb * K + C) * 2u; }
    const size_t kstep = (size_t)(BK * 2);
    const size_t hstep = (size_t)HALF * K * 2;
    const size_t tstep = 2 * hstep;
    const unsigned ldsw = (unsigned)wid * 1024u;
    const int aoff = lds_byte(wr * 64 + fr, fq * 8), boff = lds_byte(wc * 32 + fr, fq * 8);
#define PG8_SA(b, h) (((b) * 2 + (h)) * HTB)
#define PG8_SB(b, h) ((4 + (b) * 2 + (h)) * HTB)
#define PG8_STAGE(bufoff, gbase, voff) do { _Pragma("unroll") for (int _i = 0; _i < 2; ++_i) \
        __builtin_amdgcn_global_load_lds((const unsigned*)((const char*)(gbase) + (voff)[_i]), (LAS unsigned*)(lds + (bufoff) + ldsw + _i * 8192), 16, 0, 0); } while (0)
#define PG8_LDA(dst, b, h) do { _Pragma("unroll") for (int m = 0; m < 4; ++m) _Pragma("unroll") for (int k = 0; k < 2; ++k) dst[m][k] = *(const LAS bf16x8*)(lds + PG8_SA(b, h) + aoff + m * 2048 + k * 1024); } while (0)
#define PG8_LDB(dst, b, h) do { _Pragma("unroll") for (int n = 0; n < 2; ++n) _Pragma("unroll") for (int k = 0; k < 2; ++k) dst[n][k] = *(const LAS bf16x8*)(lds + PG8_SB(b, h) + boff + n * 2048 + k * 1024); } while (0)
#define PG8_MMA(ai, bj, At, Bt) do { __builtin_amdgcn_s_setprio(1); _Pragma("unroll") for (int m = 0; m < 4; ++m) _Pragma("unroll") for (int n = 0; n < 2; ++n) _Pragma("unroll") for (int k = 0; k < 2; ++k) \
        acc[ai][bj][m][n] = __builtin_amdgcn_mfma_f32_16x16x32_bf16(Bt[n][k], At[m][k], acc[ai][bj][m][n], 0, 0, 0); __builtin_amdgcn_s_setprio(0); } while (0)
#define PG8_WAIT_V(n) asm volatile("s_waitcnt vmcnt(" #n ")" ::: "memory")
#define PG8_WAIT_L(n) asm volatile("s_waitcnt lgkmcnt(" #n ")" ::: "memory")
#define PG8_BAR __builtin_amdgcn_s_barrier()
#define PG8_SCHED __builtin_amdgcn_sched_barrier(0)
    Unit cur, nxt; int ui = 0;
    if (!S.next(0, cur)) return;
    f32x4 acc[2][2][4][2];
#pragma unroll
    for (int a = 0; a < 2; ++a)
#pragma unroll
        for (int b = 0; b < 2; ++b)
#pragma unroll
            for (int m = 0; m < 4; ++m)
#pragma unroll
                for (int n = 0; n < 2; ++n) acc[a][b][m][n] = (f32x4){0.f, 0.f, 0.f, 0.f};
    bf16x8 At[4][2], B0[2][2], B1[2][2];
    const char* cA = (const char*)g.A + (size_t)cur.pm * tstep; const char* cB = (const char*)g.Bt + (size_t)cur.pn * tstep;
    PG8_STAGE(PG8_SB(0, 0), cB, voffB); PG8_STAGE(PG8_SB(0, 1), cB + hstep, voffB); PG8_STAGE(PG8_SA(0, 0), cA, voffA); PG8_STAGE(PG8_SA(0, 1), cA + hstep, voffA);
    if (wr == 1) PG8_BAR;
    PG8_WAIT_V(2); PG8_BAR;
    PG8_STAGE(PG8_SB(1, 0), cB + kstep, voffB); PG8_STAGE(PG8_SA(1, 0), cA + kstep, voffA); PG8_STAGE(PG8_SB(1, 1), cB + hstep + kstep, voffB);
    PG8_WAIT_V(6); PG8_BAR;
    for (;;) {
        const bool has_next = S.next(ui + 1, nxt);
        const char* nA = has_next ? (const char*)g.A + (size_t)nxt.pm * tstep : cA; const char* nB = has_next ? (const char*)g.Bt + (size_t)nxt.pn * tstep : cB;
        for (int t = 0; t < nt; t += 2) {
            const bool last = (t == nt - 2);
            const char* a1 = cA + (size_t)(t + 1) * kstep;
            const char* a2 = last ? nA : cA + (size_t)(t + 2) * kstep; const char* b2 = last ? nB : cB + (size_t)(t + 2) * kstep;
            const char* a3 = a2 + kstep; const char* b3 = b2 + kstep;
            PG8_LDB(B0, 0, 0); PG8_LDB(B1, 0, 1); PG8_SCHED; PG8_LDA(At, 0, 0); PG8_STAGE(PG8_SA(1, 1), a1 + hstep, voffA);
            PG8_WAIT_V(8); PG8_WAIT_L(0); PG8_BAR; PG8_MMA(0, 0, At, B0); PG8_MMA(0, 1, At, B1); PG8_BAR; PG8_SCHED;
            PG8_LDA(At, 0, 1); PG8_STAGE(PG8_SB(0, 0), b2, voffB); PG8_STAGE(PG8_SB(0, 1), b2 + hstep, voffB); PG8_STAGE(PG8_SA(0, 0), a2, voffA);
            PG8_WAIT_V(8); PG8_WAIT_L(0); PG8_BAR; PG8_MMA(1, 0, At, B0); PG8_MMA(1, 1, At, B1); PG8_BAR; PG8_SCHED;
            PG8_LDB(B0, 1, 0); PG8_LDB(B1, 1, 1); PG8_SCHED; PG8_LDA(At, 1, 0); PG8_STAGE(PG8_SA(0, 1), a2 + hstep, voffA);
            PG8_WAIT_V(8); PG8_WAIT_L(0); PG8_BAR; PG8_MMA(0, 0, At, B0); PG8_MMA(0, 1, At, B1); PG8_BAR; PG8_SCHED;
            PG8_LDA(At, 1, 1); PG8_STAGE(PG8_SB(1, 0), b3, voffB); PG8_STAGE(PG8_SB(1, 1), b3 + hstep, voffB); PG8_STAGE(PG8_SA(1, 0), a3, voffA);
            PG8_WAIT_V(8); PG8_WAIT_L(0); PG8_BAR; PG8_MMA(1, 0, At, B0); PG8_MMA(1, 1, At, B1); PG8_BAR; PG8_SCHED;
        }
        if (wr == 0) PG8_BAR;
        E(acc, cur, wr, wc, fr, fq);
        if (!has_next) break;
#pragma unroll
        for (int a = 0; a < 2; ++a)
#pragma unroll
            for (int b = 0; b < 2; ++b)
#pragma unroll
                for (int m = 0; m < 4; ++m)
#pragma unroll
                    for (int n = 0; n < 2; ++n) acc[a][b][m][n] = (f32x4){0.f, 0.f, 0.f, 0.f};
        cur = nxt; cA = nA; cB = nB; ++ui;
        if (wr == 1) PG8_BAR;
    }
    PG8_WAIT_V(0);
    PG8_BAR;
#undef PG8_SA
#undef PG8_SB
#undef PG8_STAGE
#undef PG8_LDA
#undef PG8_LDB
#undef PG8_MMA
#undef PG8_WAIT_V
#undef PG8_WAIT_L
#undef PG8_BAR
#undef PG8_SCHED
}
}

typedef f32x4 AccT[2][2][4][2];
#define EROW(ai, m) (u.pm * 256 + (ai) * 128 + wr * 64 + (m) * 16 + fr)
#define ECOL0 (u.pn * 256 + wc * 32 + 8 * fq)

struct Epi1a { static constexpr bool PERM = true; bf16_t* O; int ldc;
    __device__ __forceinline__ void operator()(const AccT& acc, const pg8::Unit& u, int wr, int wc, int fr, int fq) const {
        const int col0 = ECOL0;
#pragma unroll
        for (int ai = 0; ai < 2; ++ai)
#pragma unroll
            for (int m = 0; m < 4; ++m) { bf16_t* rowp = O + (size_t)EROW(ai, m) * ldc + col0;
#pragma unroll
                for (int bj = 0; bj < 2; ++bj) __builtin_nontemporal_store(pack8(acc[ai][bj][m][0], acc[ai][bj][m][1]), (u32x4*)(rowp + bj * 128)); }
    } };
struct Epi1b { static constexpr bool PERM = true; bf16_t* O;
    __device__ __forceinline__ void operator()(const AccT& acc, const pg8::Unit& u, int wr, int wc, int fr, int fq) const {
        const int col0 = ECOL0; const int pn = u.pn;
        if (pn < 8) {
#pragma unroll
            for (int ai = 0; ai < 2; ++ai)
#pragma unroll
                for (int m = 0; m < 4; ++m) { bf16_t* rowp = O + (size_t)EROW(ai, m) * 6144 + col0;
#pragma unroll
                    for (int bj = 0; bj < 2; ++bj) __builtin_nontemporal_store(pack8(gelu4(acc[ai][bj][m][0]), gelu4(acc[ai][bj][m][1])), (u32x4*)(rowp + bj * 128)); }
        } else {
#pragma unroll
            for (int ai = 0; ai < 2; ++ai)
#pragma unroll
                for (int m = 0; m < 4; ++m) { bf16_t* rowp = O + (size_t)EROW(ai, m) * 6144 + col0;
#pragma unroll
                    for (int bj = 0; bj < 2; ++bj) { f32x4 v0 = acc[ai][bj][m][0], v1 = acc[ai][bj][m][1];
#pragma unroll
                        for (int j = 0; j < 4; ++j) { v0[j] = sigmoidf_(v0[j]); v1[j] = sigmoidf_(v1[j]); }
                        __builtin_nontemporal_store(pack8(v0, v1), (u32x4*)(rowp + bj * 128)); } }
        }
    } };
template <bool ADD> struct Epi4 { static constexpr bool PERM = true; bf16_t* O; const bf16_t* gate;
    __device__ __forceinline__ void operator()(const AccT& acc, const pg8::Unit& u, int wr, int wc, int fr, int fq) const {
        const int col0 = ECOL0;
#pragma unroll
        for (int ai = 0; ai < 2; ++ai) {
            u32x4 gt[4][2], pv[4][2];
#pragma unroll
            for (int m = 0; m < 4; ++m) { const int row = EROW(ai, m);
#pragma unroll
                for (int bj = 0; bj < 2; ++bj) { gt[m][bj] = *(const u32x4*)(gate + (size_t)row * 6144 + col0 + bj * 128); if (ADD) pv[m][bj] = *(const u32x4*)(O + (size_t)row * 2048 + col0 + bj * 128); } }
#pragma unroll
            for (int m = 0; m < 4; ++m) { bf16_t* rowp = O + (size_t)EROW(ai, m) * 2048 + col0;
#pragma unroll
                for (int bj = 0; bj < 2; ++bj) { f32x4 g0, g1; unpack8(gt[m][bj], g0, g1);
                    f32x4 v0 = acc[ai][bj][m][0] * g0, v1 = acc[ai][bj][m][1] * g1;
                    if (ADD) { f32x4 p0, p1; unpack8(pv[m][bj], p0, p1); v0 += p0; v1 += p1; }
                    *(u32x4*)(rowp + bj * 128) = pack8(v0, v1); } }
            asm volatile("" ::: "memory"); }
    } };
struct EpiRes { static constexpr bool PERM = true; const float* base; float* X;
    __device__ __forceinline__ void operator()(const AccT& acc, const pg8::Unit& u, int wr, int wc, int fr, int fq) const {
        const int col0 = ECOL0;
#pragma unroll
        for (int ai = 0; ai < 2; ++ai) {
            f32x4 bs[4][2][2];
#pragma unroll
            for (int m = 0; m < 4; ++m) { const size_t off = (size_t)EROW(ai, m) * 2048 + col0;
#pragma unroll
                for (int bj = 0; bj < 2; ++bj) { bs[m][bj][0] = *(const f32x4*)(base + off + bj * 128); bs[m][bj][1] = *(const f32x4*)(base + off + bj * 128 + 4); } }
#pragma unroll
            for (int m = 0; m < 4; ++m) { const size_t off = (size_t)EROW(ai, m) * 2048 + col0;
#pragma unroll
                for (int bj = 0; bj < 2; ++bj) { *(f32x4*)(X + off + bj * 128) = acc[ai][bj][m][0] + bs[m][bj][0]; *(f32x4*)(X + off + bj * 128 + 4) = acc[ai][bj][m][1] + bs[m][bj][1]; } }
            asm volatile("" ::: "memory"); }
    } };
struct Epi7 { static constexpr bool PERM = true; const float* base; float* X; float* ss2; unsigned* cnt; const float* g;
    __device__ __forceinline__ void operator()(AccT& acc, const pg8::Unit& u, int wr, int wc, int fr, int fq) const {
        const int col0 = ECOL0;
#pragma unroll
        for (int ai = 0; ai < 2; ++ai)
#pragma unroll
            for (int mh = 0; mh < 2; ++mh) {
                f32x4 bs[2][2][2];
#pragma unroll
                for (int mm = 0; mm < 2; ++mm) { const size_t off = (size_t)EROW(ai, mh * 2 + mm) * 2048 + col0;
#pragma unroll
                    for (int bj = 0; bj < 2; ++bj) { bs[mm][bj][0] = *(const f32x4*)(base + off + bj * 128); bs[mm][bj][1] = *(const f32x4*)(base + off + bj * 128 + 4); } }
#pragma unroll
                for (int mm = 0; mm < 2; ++mm) { const int m = mh * 2 + mm; const int row = EROW(ai, m); float q = 0.f;
#pragma unroll
                    for (int bj = 0; bj < 2; ++bj) { const f32x4 v0 = acc[ai][bj][m][0] + bs[mm][bj][0], v1 = acc[ai][bj][m][1] + bs[mm][bj][1]; acc[ai][bj][m][0] = v0; acc[ai][bj][m][1] = v1;
                        q += (v0[0] * v0[0] + v0[1] * v0[1]) + (v0[2] * v0[2] + v0[3] * v0[3]) + (v1[0] * v1[0] + v1[1] * v1[1]) + (v1[2] * v1[2] + v1[3] * v1[3]); }
                    q += __shfl_xor(q, 16); q += __shfl_xor(q, 32);
                    if (fq == 0) __hip_atomic_store(ss2 + (size_t)row * 32 + u.pn * 4 + wc, q, __ATOMIC_RELAXED, __HIP_MEMORY_SCOPE_AGENT); }
                asm volatile("" ::: "memory"); }
        asm volatile("s_waitcnt vmcnt(0)" ::: "memory");
        unsigned* cw = cnt + 16 * (u.pm * 2 + wr);
        if ((threadIdx.x & 63) == 0) __hip_atomic_fetch_add(cw, 1u, __ATOMIC_RELAXED, __HIP_MEMORY_SCOPE_AGENT);
        { unsigned spins = 0; while (__hip_atomic_load(cw, __ATOMIC_RELAXED, __HIP_MEMORY_SCOPE_AGENT) < 32u) { __builtin_amdgcn_s_sleep(1); if (++spins > (1u << 22)) break; } }
        f32x4 gv[2][2];
#pragma unroll
        for (int bj = 0; bj < 2; ++bj) { gv[bj][0] = *(const f32x4*)(g + col0 + bj * 128); gv[bj][1] = *(const f32x4*)(g + col0 + bj * 128 + 4); }
#pragma unroll
        for (int ai = 0; ai < 2; ++ai)
#pragma unroll
            for (int m = 0; m < 4; ++m) { const int row = EROW(ai, m); const float* sp = ss2 + (size_t)row * 32 + fq * 8; float pq[8];
#pragma unroll
                for (int k = 0; k < 8; ++k) pq[k] = __hip_atomic_load(sp + k, __ATOMIC_RELAXED, __HIP_MEMORY_SCOPE_AGENT);
                float q = ((pq[0] + pq[1]) + (pq[2] + pq[3])) + ((pq[4] + pq[5]) + (pq[6] + pq[7]));
                q += __shfl_xor(q, 16); q += __shfl_xor(q, 32);
                const float rs = rsqrtf(q * (1.0f / 2048.0f) + EPSV); const size_t off = (size_t)row * 2048 + col0;
#pragma unroll
                for (int bj = 0; bj < 2; ++bj) { *(f32x4*)(X + off + bj * 128) = acc[ai][bj][m][0] * rs * gv[bj][0]; *(f32x4*)(X + off + bj * 128 + 4) = acc[ai][bj][m][1] * rs * gv[bj][1]; } }
    } };
struct Epi5 { static constexpr bool PERM = true; const float* base; float* X; float* ssp; const float* g; bf16_t* Hn;
    __device__ __forceinline__ void operator()(const AccT& acc, const pg8::Unit& u, int wr, int wc, int fr, int fq) const {
        const int col0 = ECOL0;
        f32x4 gv[2][2];
#pragma unroll
        for (int bj = 0; bj < 2; ++bj) { gv[bj][0] = *(const f32x4*)(g + col0 + bj * 128); gv[bj][1] = *(const f32x4*)(g + col0 + bj * 128 + 4); }
#pragma unroll
        for (int ai = 0; ai < 2; ++ai) {
            f32x4 bs[4][2][2];
#pragma unroll
            for (int m = 0; m < 4; ++m) { const size_t off = (size_t)EROW(ai, m) * 2048 + col0;
#pragma unroll
                for (int bj = 0; bj < 2; ++bj) { bs[m][bj][0] = *(const f32x4*)(base + off + bj * 128); bs[m][bj][1] = *(const f32x4*)(base + off + bj * 128 + 4); } }
#pragma unroll
            for (int m = 0; m < 4; ++m) { const int row = EROW(ai, m); const size_t off = (size_t)row * 2048 + col0; float q = 0.f;
#pragma unroll
                for (int bj = 0; bj < 2; ++bj) { const f32x4 v0 = acc[ai][bj][m][0] + bs[m][bj][0], v1 = acc[ai][bj][m][1] + bs[m][bj][1];
                    *(f32x4*)(X + off + bj * 128) = v0; *(f32x4*)(X + off + bj * 128 + 4) = v1;
                    q += (v0[0] * v0[0] + v0[1] * v0[1]) + (v0[2] * v0[2] + v0[3] * v0[3]) + (v1[0] * v1[0] + v1[1] * v1[1]) + (v1[2] * v1[2] + v1[3] * v1[3]);
                    *(u32x4*)(Hn + off + bj * 128) = pack8(v0 * gv[bj][0], v1 * gv[bj][1]); }
                q += __shfl_xor(q, 16); q += __shfl_xor(q, 32);
                if (fq == 0) ssp[(size_t)row * 32 + u.pn * 4 + wc] = q; }
            asm volatile("" ::: "memory"); }
    } };
struct Epi6 { static constexpr bool PERM = true; bf16_t* O; const float* ssp; const LAS float* rsl; int pm0, pm1;
    __device__ __forceinline__ void operator()(const AccT& acc, const pg8::Unit& u, int wr, int wc, int fr, int fq) const {
        const int col0 = u.pn * 128 + wc * 32 + 8 * fq;
        float rsv[2][4];
        if (u.pm == pm0 || u.pm == pm1) { const int tb = (u.pm == pm0) ? 0 : 256;
#pragma unroll
            for (int ai = 0; ai < 2; ++ai)
#pragma unroll
                for (int m = 0; m < 4; ++m) rsv[ai][m] = rsl[tb + ai * 128 + wr * 64 + m * 16 + fr];
        } else {
#pragma unroll
            for (int ai = 0; ai < 2; ++ai)
#pragma unroll
                for (int m = 0; m < 4; ++m) { const int row = EROW(ai, m);
                    const f32x4 p0 = *(const f32x4*)(ssp + (size_t)row * 32 + fq * 8), p1 = *(const f32x4*)(ssp + (size_t)row * 32 + fq * 8 + 4);
                    float q = ((p0[0] + p0[1]) + (p0[2] + p0[3])) + ((p1[0] + p1[1]) + (p1[2] + p1[3]));
                    q += __shfl_xor(q, 16); q += __shfl_xor(q, 32);
                    rsv[ai][m] = rsqrtf(q * (1.0f / 2048.0f) + EPSV); }
        }
#pragma unroll
        for (int ai = 0; ai < 2; ++ai)
#pragma unroll
            for (int m = 0; m < 4; ++m) { const int row = EROW(ai, m); const float rs = rsv[ai][m];
                f32x4 h0, h1;
#pragma unroll
                for (int j = 0; j < 4; ++j) { const float g0 = acc[ai][0][m][0][j] * rs, u0 = acc[ai][1][m][0][j] * rs, g1 = acc[ai][0][m][1][j] * rs, u1 = acc[ai][1][m][1][j] * rs;
                    h0[j] = g0 * sigmoidf_(g0) * u0; h1[j] = g1 * sigmoidf_(g1) * u1; }
                __builtin_nontemporal_store(pack8(h0, h1), (u32x4*)(O + (size_t)row * DFF + col0)); }
    } };

__device__ __forceinline__ float block_sum(float v, float* red, int tid) {
    for (int o = 32; o >= 1; o >>= 1) v += __shfl_xor(v, o);
    __syncthreads();
    if ((tid & 63) == 0) red[tid >> 6] = v;
    __syncthreads();
    float s = 0.f;
#pragma unroll
    for (int i = 0; i < 8; ++i) s += red[i];
    return s;
}

__device__ __forceinline__ void tr_tile(const float* __restrict__ src, int N, int K, bf16_t* __restrict__ dst, int k0, int n0, int drow0, float* tile, int tid) {
#pragma unroll
    for (int i = 0; i < 2; ++i) { const int kk = (tid >> 4) + i * 32, n4 = (tid & 15) * 4;
        const f32x4 v = *(const f32x4*)(src + (size_t)(k0 + kk) * N + n0 + n4);
        tile[kk * 65 + n4 + 0] = v[0]; tile[kk * 65 + n4 + 1] = v[1]; tile[kk * 65 + n4 + 2] = v[2]; tile[kk * 65 + n4 + 3] = v[3]; }
    __syncthreads();
    const int n = tid >> 3, kg = tid & 7; f32x4 a, b;
#pragma unroll
    for (int j = 0; j < 4; ++j) { a[j] = tile[(kg * 8 + j) * 65 + n]; b[j] = tile[(kg * 8 + 4 + j) * 65 + n]; }
    *(u32x4*)(dst + (size_t)(drow0 + n) * K + k0 + kg * 8) = pack8(a, b);
    __syncthreads();
}

__device__ __forceinline__ float sconv(const bf16_t* __restrict__ row, int b, int s, float w0, float w1, float w2, float bias) {
    const bf16_t* p = row + b * 2048 + s;
    const float c = bf2f(p[0]); const float l = s > 0 ? bf2f(p[-1]) : 0.f; const float r = s < 2047 ? bf2f(p[1]) : 0.f;
    return w0 * l + w1 * c + w2 * r + bias;
}

#define XB_TMO      128
#define XB_XCNT(j)  (256  + 64 * (j))
#define XB_XSUB(j)  (1280 + 64 * (j))
#define XB_XGEN(j)  (2304 + 64 * (j))
#define XB_TOP      3328
#define XB_TOPGEN   3392
#define XCD_BAR_WORDS 3456
#define XB_SPIN_CAP (1u << 22)

__device__ __forceinline__ unsigned xb_ld(unsigned* p)              { return __hip_atomic_load(p, __ATOMIC_RELAXED, __HIP_MEMORY_SCOPE_AGENT); }
__device__ __forceinline__ unsigned xb_add(unsigned* p, unsigned v) { return __hip_atomic_fetch_add(p, v, __ATOMIC_RELAXED, __HIP_MEMORY_SCOPE_AGENT); }
__device__ __forceinline__ unsigned xb_xcc_id() { return (unsigned)__builtin_amdgcn_s_getreg((3 << 11) | 20) & 0xFu; }
#define XB_SPIN(cond, bar) do { unsigned _sp = 0; while (cond) { __builtin_amdgcn_s_sleep(1); \
    if ((++_sp & 255u) == 0u) { if (xb_ld(&(bar)[XB_TMO])) break; if (_sp > XB_SPIN_CAP) { atomicAdd(&(bar)[XB_TMO], 1u); break; } } } } while (0)

struct XcdBarrier {
    unsigned* bar; unsigned x;
    volatile LAS unsigned* st;
};

__device__ __forceinline__ XcdBarrier xcd_barrier_post(unsigned* bar, volatile LAS unsigned* st) {
    XcdBarrier b; b.bar = bar; b.x = xb_xcc_id(); b.st = st;
    if (threadIdx.x == 0) (void)xb_add(&bar[XB_XCNT(b.x)], 1u);
    return b;
}
__device__ __forceinline__ void xcd_barrier_complete(unsigned* bar, unsigned x, unsigned& nloc, unsigned& nx) {
    const unsigned G = gridDim.x * gridDim.y * gridDim.z;
    unsigned sum, cnt, mine, sp = 0u;
    for (;;) {
        sum = 0u; cnt = 0u; mine = 0u;
#pragma unroll
        for (unsigned j = 0; j < 16; ++j) { const unsigned c = xb_ld(&bar[XB_XCNT(j)]); sum += c; cnt += (c > 0u) ? 1u : 0u; mine = (j == x) ? c : mine; }
        if (sum == G) break;
        __builtin_amdgcn_s_sleep(1);
        if ((++sp & 255u) == 0u) { if (xb_ld(&bar[XB_TMO])) break; if (sp > XB_SPIN_CAP) { atomicAdd(&bar[XB_TMO], 1u); break; } }
    }
    nloc = mine > 0u ? mine : 1u; nx = cnt > 0u ? cnt : 1u;
}

__device__ __forceinline__ void xcd_barrier(const XcdBarrier& b) {
    asm volatile("s_waitcnt vmcnt(0)" ::: "memory");
    __syncthreads();
    if (threadIdx.x == 0) {
        unsigned* bar = b.bar;
        __builtin_amdgcn_s_waitcnt(0);
        unsigned nloc = b.st[0], nx = b.st[1];
        if (nloc == 0u) { xcd_barrier_complete(bar, b.x, nloc, nx); b.st[0] = nloc; b.st[1] = nx; }
        const unsigned old = xb_add(&bar[XB_XSUB(b.x)], 1u);
        const unsigned gen = old / nloc;
        if (old + 1u == (gen + 1u) * nloc) {
            __builtin_amdgcn_fence(__ATOMIC_RELEASE, "agent");
            asm volatile("s_waitcnt vmcnt(0)" ::: "memory");
            const unsigned og = xb_add(&bar[XB_TOP], 1u);
            const unsigned tg = og / nx;
            if (og + 1u == (tg + 1u) * nx) xb_add(&bar[XB_TOPGEN], 1u);
            else XB_SPIN(xb_ld(&bar[XB_TOPGEN]) == tg, bar);
            __builtin_amdgcn_fence(__ATOMIC_ACQUIRE, "agent");
            xb_add(&bar[XB_XGEN(b.x)], 1u);
            asm volatile("s_waitcnt vmcnt(0)" ::: "memory");
        } else {
            XB_SPIN(xb_ld(&bar[XB_XGEN(b.x)]) == gen, bar);
            __builtin_amdgcn_fence(__ATOMIC_ACQUIRE, "agent");
            asm volatile("s_waitcnt vmcnt(0)" ::: "memory");
        }
    }
    __syncthreads();
}


__device__ __forceinline__ void my_barrier(unsigned* bar, unsigned target) {
    asm volatile("s_waitcnt vmcnt(0)" ::: "memory");
    __syncthreads();
    if (threadIdx.x == 0) {
        __builtin_amdgcn_fence(__ATOMIC_RELEASE, "agent");
        asm volatile("s_waitcnt vmcnt(0)" ::: "memory");
        __hip_atomic_fetch_add(bar, 1u, __ATOMIC_RELAXED, __HIP_MEMORY_SCOPE_AGENT);
        while (__hip_atomic_load(bar, __ATOMIC_RELAXED, __HIP_MEMORY_SCOPE_AGENT) < target) __builtin_amdgcn_s_sleep(2);
        __builtin_amdgcn_fence(__ATOMIC_ACQUIRE, "agent");
        asm volatile("s_waitcnt vmcnt(0)" ::: "memory");
    }
    __syncthreads();
}

template <bool TOBF> __device__ __forceinline__ void rmsnorm_rows(const float* x, const float* __restrict__ g, bf16_t* ob, float* of, int bid, int G, int wave, int lane) {
    for (int row = bid * 8 + wave; row < NTOK; row += G * 8) {
        const float* xr = x + (size_t)row * DM; f32x4 v[8]; float q = 0.f;
#pragma unroll
        for (int i = 0; i < 8; ++i) { v[i] = *(const f32x4*)(xr + lane * 4 + i * 256); q += (v[i][0] * v[i][0] + v[i][1] * v[i][1]) + (v[i][2] * v[i][2] + v[i][3] * v[i][3]); }
        for (int o = 32; o >= 1; o >>= 1) q += __shfl_xor(q, o);
        const float rs = rsqrtf(q * (1.0f / 2048.0f) + EPSV);
#pragma unroll
        for (int i = 0; i < 8; ++i) { const f32x4 gg = *(const f32x4*)(g + lane * 4 + i * 256); const f32x4 y = v[i] * rs * gg;
            if (TOBF) { u32x2 w; w.x = cvt_pk_bf16(y[0], y[1]); w.y = cvt_pk_bf16(y[2], y[3]); *(u32x2*)(ob + (size_t)row * DM + lane * 4 + i * 256) = w; }
            else *(f32x4*)(of + (size_t)row * DM + lane * 4 + i * 256) = y; }
    }
}


#ifdef SELFCHK
__device__ __forceinline__ unsigned hsh(unsigned x) { x ^= x >> 16; x *= 0x7feb352du; x ^= x >> 15; x *= 0x846ca68bu; x ^= x >> 16; return x; }
__device__ __forceinline__ float wdot(const bf16_t* a, const bf16_t* b, int K, int lane) { float s = 0.f; for (int k = lane; k < K; k += 64) s += bf2f(a[k]) * bf2f(b[k]); for (int o = 32; o >= 1; o >>= 1) s += __shfl_xor(s, o); return s; }
__device__ __forceinline__ void chk_flag(unsigned* flags, bool bad, unsigned bit) { if (__any(bad) && (threadIdx.x & 63) == 0) atomicOr(flags, bit); }
__device__ __forceinline__ bool far(float got, float ref) { return !(fabsf(got - ref) <= 0.02f * fabsf(ref) + 0.02f); }
#define CHK(...) do { __VA_ARGS__ } while (0)
#else
#define CHK(...) do { } while (0)
#endif

__global__ void __launch_bounds__(NTHR, 2) fwd_megakernel(Params P) {
    extern __shared__ __attribute__((aligned(16))) unsigned char smem[];
    cg::grid_group grid = cg::this_grid();
    const int tid = threadIdx.x, lane = tid & 63, wave = tid >> 6;
    const int G = gridDim.x, bid = blockIdx.x;
    unsigned char* ws = P.ws;
    LAS unsigned char* lds = (LAS unsigned char*)smem;
    const int lo = P.lo, hi = P.hi;
#define IN(k) (lo <= (k) && (k) < hi)
#define SEAM(k) do { if ((k) + 1 < hi) { if (lo > (k) + 1000) grid.sync();   xcd_barrier(xb); } } while (0)

    { volatile LAS unsigned* stw = (volatile LAS unsigned*)(lds + 146400); if (tid < 2) stw[tid] = 0u; __syncthreads(); }
    const XcdBarrier xb = xcd_barrier_post((unsigned*)(ws + WS_BAR + 16384), (volatile LAS unsigned*)(lds + 146400));
    float* stats = (float*)(ws + WS_STATS); float* ss1 = (float*)(ws + WS_SS1); float* ss2 = (float*)(ws + WS_SS2); float* h3 = (float*)(ws + WS_H3);
    bf16_t* WinT = (bf16_t*)(ws + W_IN); bf16_t* WbhT = (bf16_t*)(ws + W_BH); bf16_t* WbsT = (bf16_t*)(ws + W_BS); bf16_t* WoutT = (bf16_t*)(ws + W_OUT);
    bf16_t* WfiT = (bf16_t*)(ws + W_FI); bf16_t* WfoT = (bf16_t*)(ws + W_FO);
    bf16_t* Hn = (bf16_t*)(ws + WS_R2); bf16_t* Yhy = (bf16_t*)(ws + WS_R2); bf16_t* Ysgu = (bf16_t*)(ws + WS_R2 + 33554432);
    bf16_t* PT = (bf16_t*)(ws + R3_PT); bf16_t* PROJ2 = (bf16_t*)(ws + R3_PROJ2); bf16_t* MERGED = (bf16_t*)(ws + R3_MERGED); bf16_t* H2 = (bf16_t*)(ws + R3_H2); bf16_t* HID = (bf16_t*)(ws + R3_HID);
    float* SSP = (float*)(ws + WS_R2);
    float* KF = P.out; bf16_t* YT = (bf16_t*)((unsigned char*)P.out + 33554432);

    auto weight_tiles = [&](int t_lo, int t_hi) {
            float* tile = (float*)smem;
            struct TJ { const float* src; bf16_t* dst; int K, N, k0, n0, mode; };
            auto decode = [&](int ti, TJ& j) {
                int li, ntl; j.mode = 0;
                if (ti < 1152) { j.src = P.in[2]; j.dst = WinT; j.K = 2048; j.N = 9216; li = ti; ntl = 36; }
                else if (ti < 1280) { j.src = P.in[18]; j.dst = WbhT; j.K = 1024; j.N = 2048; li = ti - 1152; ntl = 8; }
                else if (ti < 1408) { j.src = P.in[19]; j.dst = WbsT; j.K = 1024; j.N = 2048; li = ti - 1280; ntl = 8; }
                else if (ti < 1664) { j.src = P.in[20]; j.dst = WoutT; j.K = 2048; j.N = 2048; li = ti - 1408; ntl = 8; }
                else if (ti < 3072) { j.src = P.in[22]; j.dst = WfiT; j.K = 2048; j.N = 11264; li = ti - 1664; ntl = 44; j.mode = 1; }
                else { j.src = P.in[23]; j.dst = WfoT; j.K = 5632; j.N = 2048; li = ti - 3072; ntl = 8; }
                j.k0 = (li / ntl) * 64; j.n0 = (li % ntl) * 256; };
            f32x4 v[8]; TJ cur, nxt; int ti = t_lo + bid; bool have = ti < t_hi;
            if (have) { decode(ti, cur);
#pragma unroll
                for (int i = 0; i < 8; ++i) { const int idx = tid + i * NTHR, kk = idx >> 6, n4 = (idx & 63) * 4; v[i] = *(const f32x4*)(cur.src + (size_t)(cur.k0 + kk) * cur.N + cur.n0 + n4); } }
            while (have) {
#pragma unroll
                for (int i = 0; i < 8; ++i) { const int idx = tid + i * NTHR, kk = idx >> 6, n4 = (idx & 63) * 4; *(f32x4*)(tile + kk * 260 + (n4 ^ (((kk >> 3) & 7) << 2))) = v[i]; }
                __syncthreads();
                const int nti = ti + G; const bool hn = nti < t_hi;
                if (hn) { decode(nti, nxt);
#pragma unroll
                    for (int i = 0; i < 8; ++i) { const int idx = tid + i * NTHR, kk = idx >> 6, n4 = (idx & 63) * 4; v[i] = *(const f32x4*)(nxt.src + (size_t)(nxt.k0 + kk) * nxt.N + nxt.n0 + n4); } }
#pragma unroll
                for (int i = 0; i < 4; ++i) { const int item = tid + i * NTHR, n = item >> 3, kg = item & 7; f32x4 a, b;
#pragma unroll
                    for (int j = 0; j < 4; ++j) { a[j] = tile[(kg * 8 + j) * 260 + (n ^ (kg << 2))]; b[j] = tile[(kg * 8 + 4 + j) * 260 + (n ^ (kg << 2))]; }
                    int drow = cur.n0 + n;
                    if (cur.mode == 1) { const int up = drow >= DFF; const int jj = up ? drow - DFF : drow; drow = 256 * (jj >> 7) + (up ? 128 : 0) + (jj & 127); }
                    *(u32x4*)(cur.dst + (size_t)drow * cur.K + cur.k0 + kg * 8) = pack8(a, b); }
                __syncthreads();
                ti = nti; have = hn; cur = nxt;
            }
        __syncthreads();
    };
    if (((PHASE_MASK >> 0) & 1) && IN(0)) {
        weight_tiles(0, 1152);
        rmsnorm_rows<true>(P.in[0], P.in[1], Hn, nullptr, bid, G, wave, lane);
        {
            float* zf = (float*)smem; float* ha = zf + 8 * 40; float* hb = ha + 8 * 64;
            const float* w1 = P.in[5]; const float* b1 = P.in[6]; const float* w2 = P.in[7]; const float* b2 = P.in[8]; const float* w3 = P.in[9]; const float* b3 = P.in[10]; const float* fq_ = P.in[11];
            for (int pg = bid; pg < 256; pg += G) {
                const int pos = pg * 8 + wave;
                __syncthreads();
                if (lane < 33) {
                    float z;
                    if (lane == 0) z = (float)pos / 2047.0f;
                    else { const int mband = (lane - 1) & 15; const float f = 1e-4f + (float)mband * ((15.0f - 1e-4f) / 15.0f); const float w = (6.2831855f * (float)pos) / 2048.0f; const float a = f * w;
                        z = lane < 17 ? __cosf(a) : -__sinf(a); }
                    zf[wave * 40 + lane] = z;
                }
                __syncthreads();
                const float fr = fq_[lane];
                float a = b1[lane];
#pragma unroll 3
                for (int i = 0; i < 33; ++i) a += zf[wave * 40 + i] * w1[i * 64 + lane];
                ha[wave * 64 + lane] = __sinf(fr * a);
                __syncthreads();
                a = b2[lane];
#pragma unroll 8
                for (int i = 0; i < 64; ++i) a += ha[wave * 64 + i] * w2[i * 64 + lane];
                hb[wave * 64 + lane] = __sinf(fr * a);
                __syncthreads();
                a = b3[lane];
#pragma unroll 8
                for (int i = 0; i < 64; ++i) a += hb[wave * 64 + i] * w3[i * 64 + lane];
                h3[pos * 64 + lane] = __sinf(fr * a);
            }
            __syncthreads();
        }
        SEAM(0);
    }

    if (((PHASE_MASK >> 1) & 1) && IN(1)) {
        CHK(
            { const unsigned sid = bid * 8 + wave; unsigned* flags = (unsigned*)(ws + WS_BAR + 64); bool bad = false;
              { const int n = hsh(sid * 7 + 1) % 9216, k = (hsh(sid * 7 + 2) + lane) % 2048; bad |= WinT[(size_t)n * 2048 + k] != f2bf(P.in[2][(size_t)k * 9216 + n]); }
              { const int j = hsh(sid * 7 + 3) % 5632, k = (hsh(sid * 7 + 4) + lane) % 2048; const int rg = 256 * (j >> 7) + (j & 127);
                bad |= WfiT[(size_t)rg * 2048 + k] != f2bf(P.in[22][(size_t)k * 11264 + j]); bad |= WfiT[(size_t)(rg + 128) * 2048 + k] != f2bf(P.in[22][(size_t)k * 11264 + 5632 + j]); }
              { const int n = hsh(sid * 7 + 5) % 2048, k = (hsh(sid * 7 + 6) + lane) % 5632; bad |= WfoT[(size_t)n * 5632 + k] != f2bf(P.in[23][(size_t)k * 2048 + n]); }
              { const int n = hsh(sid * 7 + 5) % 2048, k = (hsh(sid * 7 + 6) + lane) % 1024; bad |= WbhT[(size_t)n * 1024 + k] != f2bf(P.in[18][(size_t)k * 2048 + n]); bad |= WbsT[(size_t)n * 1024 + k] != f2bf(P.in[19][(size_t)k * 2048 + n]); }
              { const int n = hsh(sid * 7 + 5) % 2048, k = (hsh(sid * 7 + 6) + lane) % 2048; bad |= WoutT[(size_t)n * 2048 + k] != f2bf(P.in[20][(size_t)k * 2048 + n]); }
              chk_flag(flags, bad, 1u); }
        );
        {
            const float* w4 = P.in[12]; bf16_t* Wb = (bf16_t*)smem;
            const int li = lane & 15, lq = lane >> 4;
            for (int cb = bid; cb < 256; cb += G) {
                __syncthreads();
                for (int idx = tid; idx < 1024; idx += NTHR) { const int cc = idx & 15, j = idx >> 4; Wb[cc * 72 + j] = f2bf(w4[(size_t)j * 4096 + cb * 16 + cc]); }
                __syncthreads();
                const int col0 = cb * 16; const int dir = col0 >> 11, o = (col0 >> 10) & 1, c = (col0 & 1023) + li;
                const bf16x8 wf0 = *(const bf16x8*)(Wb + li * 72 + lq * 8), wf1 = *(const bf16x8*)(Wb + li * 72 + 32 + lq * 8);
                const float ad = 3.0701134573f + (float)c * ((15.3505672866f - 3.0701134573f) / 1023.0f);
                float* kr = KF + (size_t)(o * 1024 + c) * 4096;
                for (int rt = 0; rt < 16; ++rt) {
                    const int pbase = (wave * 16 + rt) * 16;
                    const float* hp = h3 + (pbase + li) * 64 + lq * 8;
                    const u32x4 a0 = pack8(*(const f32x4*)hp, *(const f32x4*)(hp + 4)), a1 = pack8(*(const f32x4*)(hp + 32), *(const f32x4*)(hp + 36));
                    f32x4 d = {0.f, 0.f, 0.f, 0.f};
                    d = __builtin_amdgcn_mfma_f32_16x16x32_bf16(__builtin_bit_cast(bf16x8, a0), wf0, d, 0, 0, 0);
                    d = __builtin_amdgcn_mfma_f32_16x16x32_bf16(__builtin_bit_cast(bf16x8, a1), wf1, d, 0, 0, 0);
                    const int pos4 = pbase + lq * 4; f32x4 v;
#pragma unroll
                    for (int r = 0; r < 4; ++r) v[r] = d[r] * __expf(-((float)(pos4 + r) / 2047.0f) * ad);
                    if (dir == 0) *(f32x4*)(kr + 2048 + pos4) = v;
                    else {
#pragma unroll
                        for (int r = 0; r < 4; ++r) { const int pos = pos4 + r; if (pos >= 1) kr[2048 - pos] = v[r]; else kr[0] = 0.f; } }
                }
            }
            __syncthreads();
        }
        {
            pg8::Gemm g{WinT, Hn, 3072, NTOK, DM}; pg8::StaticOrder S; S.init(3072, NTOK, G, bid);
            Epi1a E{PT, NTOK}; pg8::gemm_phase<Epi1a>(lds, g, S, E);
        }
        {
            pg8::Gemm g{Hn, WinT + (size_t)3072 * DM, NTOK, 6144, DM}; pg8::StaticOrder S; S.init(NTOK, 6144, G, bid);
            Epi1b E{PROJ2}; pg8::gemm_phase<Epi1b>(lds, g, S, E);
        }
        SEAM(1);
    }

    if (((PHASE_MASK >> 2) & 1) && IN(2)) {
        CHK(
            { const unsigned sid = bid * 8 + wave; unsigned* flags = (unsigned*)(ws + WS_BAR + 64);
              { const int ch = hsh(sid * 5 + 11) % 3072, tok = hsh(sid * 5 + 12) % 8192; const float ref = wdot(WinT + (size_t)ch * 2048, Hn + (size_t)tok * 2048, 2048, lane);
                chk_flag(flags, far(bf2f(PT[(size_t)ch * NTOK + tok]), ref), 2u); }
              { const int col = hsh(sid * 5 + 13) % 6144, tok = hsh(sid * 5 + 14) % 8192; const float r0 = wdot(Hn + (size_t)tok * 2048, WinT + (size_t)(3072 + col) * 2048, 2048, lane);
                const float ref = col < 2048 ? 0.5f * r0 * (1.0f + erff(r0 * 0.70710678f)) : 1.0f / (1.0f + expf(-r0));
                chk_flag(flags, far(bf2f(PROJ2[(size_t)tok * 6144 + col]), ref), 4u); } }
        );
        const int wgrp = (bid & 7) % 3;
        if (wgrp == 0) weight_tiles(1152, 3776);
        {
            unsigned char* Z1 = smem;
            unsigned char* Z2 = smem + 34816;
            unsigned char* KS = smem + 69632;
            bf16_t* KR = (bf16_t*)(smem + 137472);
            float* red = (float*)(smem + 145696);
            const float* scw = P.in[3]; const float* scb = P.in[4]; const float* hbias = P.in[13];
            for (int i = tid; i < 1024; i += NTHR) { const int buf = i >> 9, w = i & 511; const int off = (w < 256 ? 0 : 66 * 512 - 1024) + w * 4; *(unsigned*)((buf ? Z2 : Z1) + off) = 0u; }
            const int pp = wave & 1, gg = wave >> 1, li = lane & 15, lq = lane >> 4, bb = li & 7, jsel = li >> 3;
            const unsigned boff = (unsigned)(jsel * 512 + bb * 64 + ((lq ^ ((bb >> 2) << 1)) * 16));
            const int rcp_ = 7 - (li & 7); const int ksl = rcp_ * 8448 + 48 * (rcp_ & 3) + 2 * (2040 - 16 * pp - 8 * (li >> 3) + 8 * lq);
            float kv[8];
            if (bid < DH) { const float* kr0 = KF + (size_t)bid * 4096;
#pragma unroll
                for (int j = 0; j < 8; ++j) kv[j] = kr0[tid + j * NTHR]; }
            for (int c = bid; c < DH; c += G) {
                __syncthreads();
                {   const float w0 = scw[c], w1 = scw[3072 + c], w2 = scw[6144 + c], bs = scb[c];
                    for (int ch = tid; ch < 2048; ch += NTHR) { const int b = ch >> 8, s = (ch & 255) * 8; const bf16_t* src = PT + (size_t)c * NTOK + b * 2048 + s;
                        f32x4 fa, fb; unpack8(*(const u32x4*)src, fa, fb); const float fl = s > 0 ? bf2f(src[-1]) : 0.f, fr_ = s + 8 < 2048 ? bf2f(src[8]) : 0.f;
                        f32x4 oa, ob;
                        oa[0] = w0 * fl + w1 * fa[0] + w2 * fa[1] + bs; oa[1] = w0 * fa[0] + w1 * fa[1] + w2 * fa[2] + bs; oa[2] = w0 * fa[1] + w1 * fa[2] + w2 * fa[3] + bs; oa[3] = w0 * fa[2] + w1 * fa[3] + w2 * fb[0] + bs;
                        ob[0] = w0 * fa[3] + w1 * fb[0] + w2 * fb[1] + bs; ob[1] = w0 * fb[0] + w1 * fb[1] + w2 * fb[2] + bs; ob[2] = w0 * fb[1] + w1 * fb[2] + w2 * fb[3] + bs; ob[3] = w0 * fb[2] + w1 * fb[3] + w2 * fr_ + bs;
                        const int J = s >> 5, chunk = (s & 31) >> 3;
                        *(u32x4*)(Z1 + ((J + 2) * 8 + b) * 64 + ((chunk ^ ((b >> 2) << 1)) * 16)) = pack8(oa, ob); } }
                for (int o = 0; o < 2; ++o) {
                    float part = 0.f;
#pragma unroll
                    for (int j = 0; j < 8; ++j) { part += fabsf(kv[j]); KR[4095 - (tid + j * NTHR)] = f2bf(kv[j]); }
                    if (tid < 8) KR[4096 + tid] = 0;
                    const float scale = 1.0f / block_sum(part, red, tid);
                    {   const u32x4 c0 = *(const u32x4*)(KR + tid * 8), c1 = *(const u32x4*)(KR + tid * 8 + 8);
                        const unsigned D[8] = {c0.x, c0.y, c0.z, c0.w, c1.x, c1.y, c1.z, c1.w};
#pragma unroll
                        for (int r = 0; r < 8; ++r) { u32x4 w; const int sft = r >> 1;
                            if (r & 1) { w.x = __builtin_amdgcn_alignbit(D[sft + 1], D[sft], 16); w.y = __builtin_amdgcn_alignbit(D[sft + 2], D[sft + 1], 16); w.z = __builtin_amdgcn_alignbit(D[sft + 3], D[sft + 2], 16); w.w = __builtin_amdgcn_alignbit(D[sft + 4], D[sft + 3], 16); }
                            else { w.x = D[sft]; w.y = D[sft + 1]; w.z = D[sft + 2]; w.w = D[sft + 3]; }
                            *(u32x4*)(KS + r * 8448 + 48 * (r & 3) + tid * 16) = w; } }
                    __syncthreads();
                    {
                        const int nc = o == 0 ? c : c + G, no = o == 0 ? 1 : 0;
                        if (nc < DH) { const float* krn = KF + (size_t)(no * 1024 + nc) * 4096;
#pragma unroll
                            for (int j = 0; j < 8; ++j) kv[j] = krn[tid + j * NTHR]; } }
                    const unsigned char* Zin = o ? Z2 : Z1;
                    const int chx = (o == 0 ? 1024 : 2048) + c;
                    u32x2 xwv[8]; unsigned short xlv[8], xrv[8];
#pragma unroll
                    for (int a = 0; a < 8; ++a) { const int I = pp + 2 * (16 * gg + 2 * a + jsel); const int t0 = 16 * I + 4 * lq; const bf16_t* src = PT + (size_t)chx * NTOK + bb * 2048 + t0;
                        xwv[a] = *(const u32x2*)src; xlv[a] = t0 > 0 ? src[-1] : (unsigned short)0; xrv[a] = t0 + 4 < 2048 ? src[4] : (unsigned short)0; }
                    f32x4 acc[8];
#pragma unroll
                    for (int a = 0; a < 8; ++a) acc[a] = (f32x4){0.f, 0.f, 0.f, 0.f};
#define HY_LA(E) (*(const bf16x8*)(KS + ksl - 64 * (E)))
#define HY_LBJ(J0) (*(const bf16x8*)(Zin + (((J0) >= -1 && (J0) <= 63) ? ((J0) + 2) : 0) * 512 + boff))
                    {
                        bf16x8 aE[8], aO[8];
                        const int e0 = 16 * gg - 63;
#pragma unroll
                        for (int a2 = 0; a2 < 8; ++a2) { aE[a2] = HY_LA(e0 + 2 * a2); aO[a2] = HY_LA(e0 + 1 + 2 * a2); }
                        bf16x8 bfe = HY_LBJ(63);
                        for (int ib = 0; ib < 64; ib += 16) {
#pragma unroll
                            for (int k = 0; k < 8; ++k) { const int i = ib + 2 * k;
                                const bf16x8 bfo = HY_LBJ(62 - i);
#pragma unroll
                                for (int a2 = 0; a2 < 8; ++a2) acc[a2] = __builtin_amdgcn_mfma_f32_16x16x32_bf16(aE[(a2 + k) & 7], bfe, acc[a2], 0, 0, 0);
                                aE[k & 7] = HY_LA(e0 + i + 16);
                                bfe = HY_LBJ(61 - i);
#pragma unroll
                                for (int a2 = 0; a2 < 8; ++a2) acc[a2] = __builtin_amdgcn_mfma_f32_16x16x32_bf16(aO[(a2 + k) & 7], bfo, acc[a2], 0, 0, 0);
                                aO[k & 7] = HY_LA(e0 + i + 17);
                            }
                        }
#pragma unroll
                        for (int a2 = 0; a2 < 8; ++a2) acc[a2] = __builtin_amdgcn_mfma_f32_16x16x32_bf16(aE[a2], bfe, acc[a2], 0, 0, 0);
                    }
#undef HY_LA
#undef HY_LBJ
                    const float bo = hbias[o * 1024 + c];
                    const float w0 = scw[chx], w1 = scw[3072 + chx], w2 = scw[6144 + chx], bs = scb[chx];
#pragma unroll
                    for (int a = 0; a < 8; ++a) { const int I = pp + 2 * (16 * gg + 2 * a + jsel); const int t0 = 16 * I + 4 * lq;
                        const int zaddr = ((t0 >> 5) + 2) * 512 + bb * 64 + ((((t0 & 31) >> 3) ^ ((bb >> 2) << 1)) * 16) + (t0 & 7) * 2;
                        const u32x2 zw = *(const u32x2*)(Zin + zaddr);
                        const float z0 = __uint_as_float(zw.x << 16), z1 = __uint_as_float(zw.x & 0xffff0000u), z2 = __uint_as_float(zw.y << 16), z3 = __uint_as_float(zw.y & 0xffff0000u);
                        const u32x2 xw = xwv[a];
                        const float x0 = __uint_as_float(xw.x << 16), x1 = __uint_as_float(xw.x & 0xffff0000u), x2 = __uint_as_float(xw.y << 16), x3 = __uint_as_float(xw.y & 0xffff0000u);
                        const float xl = bf2f(xlv[a]), xr = bf2f(xrv[a]);
                        const float r0 = (w0 * xl + w1 * x0 + w2 * x1 + bs) * (acc[a][0] * scale + z0 * bo), r1 = (w0 * x0 + w1 * x1 + w2 * x2 + bs) * (acc[a][1] * scale + z1 * bo);
                        const float r2 = (w0 * x1 + w1 * x2 + w2 * x3 + bs) * (acc[a][2] * scale + z2 * bo), r3 = (w0 * x2 + w1 * x3 + w2 * xr + bs) * (acc[a][3] * scale + z3 * bo);
                        u32x2 w; w.x = cvt_pk_bf16(r0, r1); w.y = cvt_pk_bf16(r2, r3);
                        if (o == 0) *(u32x2*)(Z2 + zaddr) = w; else *(u32x2*)(YT + (size_t)c * NTOK + bb * 2048 + t0) = w; }
                    __syncthreads();
                }
            }
        }
        if (wgrp == 1) weight_tiles(1152, 3776);
        {
            bf16_t* Wl = (bf16_t*)smem;
            bf16_t* Vl = (bf16_t*)(smem + 36864);
            float* stl = (float*)(smem + 73728);
            const float* lng = P.in[14]; const float* lnb = P.in[15]; const float* w_s = P.in[16]; const float* b_s = P.in[17];
            const int li = lane & 15, lq = lane >> 4;
            for (int item = bid; item < 256; item += G) {
              const int bn = item >> 1, tok0 = bn * 128;
              __syncthreads();
              for (int qb = 0; qb < 4; ++qb) {
                  u32x4 raw[4][2];
#pragma unroll
                  for (int k = 0; k < 4; ++k) { const bf16_t* vp = PROJ2 + (size_t)(tok0 + wave * 16 + qb * 4 + k) * 6144 + 1024 + lane * 16; raw[k][0] = *(const u32x4*)vp; raw[k][1] = *(const u32x4*)(vp + 8); }
#pragma unroll
                  for (int k = 0; k < 4; ++k) { const int q = wave * 16 + qb * 4 + k;
                      f32x4 a0, a1, a2, a3; unpack8(raw[k][0], a0, a1); unpack8(raw[k][1], a2, a3);
                      float sm = 0.f, sq = 0.f;
#pragma unroll
                      for (int j = 0; j < 4; ++j) { sm += (a0[j] + a1[j]) + (a2[j] + a3[j]); sq += (a0[j] * a0[j] + a1[j] * a1[j]) + (a2[j] * a2[j] + a3[j] * a3[j]); }
                      for (int o = 32; o >= 1; o >>= 1) { sm += __shfl_xor(sm, o); sq += __shfl_xor(sq, o); }
                      if (lane == 0) { const float mean = sm * (1.0f / 1024.0f); const float var = sq * (1.0f / 1024.0f) - mean * mean; stl[2 * q] = mean; stl[2 * q + 1] = rsqrtf(var + EPSV); } }
              }
              for (int hh = 0; hh < 4; ++hh) {
                const int h = (item & 1) * 4 + hh;
                __syncthreads();
                for (int ch = tid; ch < 2048; ch += NTHR) {
                    { const int p = ch >> 4, q8 = (ch & 15) * 8; const float* wp = w_s + (size_t)h * 16384 + p * 128 + q8;
                      *(u32x4*)(Wl + p * 144 + q8) = pack8(*(const f32x4*)wp, *(const f32x4*)(wp + 4)); }
                    { const int q = ch >> 4, c8 = (ch & 15) * 8; const float sm = stl[2 * q], rstd = stl[2 * q + 1];
                      f32x4 va, vb; unpack8(*(const u32x4*)(PROJ2 + (size_t)(tok0 + q) * 6144 + 1024 + h * 128 + c8), va, vb);
                      const f32x4 ga = *(const f32x4*)(lng + h * 128 + c8), gb = *(const f32x4*)(lng + h * 128 + c8 + 4), ba = *(const f32x4*)(lnb + h * 128 + c8), bb_ = *(const f32x4*)(lnb + h * 128 + c8 + 4);
                      va = (va - sm) * rstd * ga + ba; vb = (vb - sm) * rstd * gb + bb_;
#pragma unroll
                      for (int j = 0; j < 4; ++j) { Vl[(c8 + j) * 144 + q] = f2bf(va[j]); Vl[(c8 + 4 + j) * 144 + q] = f2bf(vb[j]); } }
                }
                __syncthreads();
                f32x4 acc[8];
#pragma unroll
                for (int ct = 0; ct < 8; ++ct) acc[ct] = (f32x4){0.f, 0.f, 0.f, 0.f};
#pragma unroll
                for (int kk = 0; kk < 4; ++kk) { const bf16x8 wf = *(const bf16x8*)(Wl + (wave * 16 + li) * 144 + kk * 32 + lq * 8);
#pragma unroll
                    for (int ct = 0; ct < 8; ++ct) { const bf16x8 vf = *(const bf16x8*)(Vl + (ct * 16 + li) * 144 + kk * 32 + lq * 8);
                        acc[ct] = __builtin_amdgcn_mfma_f32_16x16x32_bf16(vf, wf, acc[ct], 0, 0, 0); } }
                {   const int p = wave * 16 + li, tok = tok0 + p; const float bs = b_s[h * 128 + p];
#pragma unroll
                    for (int ct = 0; ct < 8; ++ct) { const int cc = h * 128 + ct * 16 + lq * 4; const u32x2 uw = *(const u32x2*)(PROJ2 + (size_t)tok * 6144 + cc);
                        const float u0 = __uint_as_float(uw.x << 16), u1 = __uint_as_float(uw.x & 0xffff0000u), u2 = __uint_as_float(uw.y << 16), u3 = __uint_as_float(uw.y & 0xffff0000u);
                        u32x2 w; w.x = cvt_pk_bf16(u0 * (acc[ct][0] + bs), u1 * (acc[ct][1] + bs)); w.y = cvt_pk_bf16(u2 * (acc[ct][2] + bs), u3 * (acc[ct][3] + bs));
                        *(u32x2*)(Ysgu + (size_t)tok * 1024 + cc) = w; } }
              }
            }
            __syncthreads();
        }
        if (wgrp == 2) weight_tiles(1152, 3776);
        SEAM(2);
    }

    if (((PHASE_MASK >> 3) & 1) && IN(3)) {
        auto ytrans = [&]() {
        bf16_t* tile = (bf16_t*)smem;
        u32x4 v[4]; int ti = bid; bool have = ti < 1024;
        if (have) { const int c0 = (ti & 15) * 64, t0 = (ti >> 4) * 256;
#pragma unroll
            for (int i = 0; i < 4; ++i) { const int idx = tid + i * NTHR, cr = idx >> 5, tg = idx & 31; v[i] = *(const u32x4*)(YT + (size_t)(c0 + cr) * NTOK + t0 + tg * 8); } }
        while (have) {
            const int c0 = (ti & 15) * 64, t0 = (ti >> 4) * 256;
#pragma unroll
            for (int i = 0; i < 4; ++i) { const int idx = tid + i * NTHR, cr = idx >> 5, tg = idx & 31; *(u32x4*)(tile + cr * 264 + tg * 8) = v[i]; }
            __syncthreads();
            const int nti = ti + G; const bool hn = nti < 1024;
            if (hn) { const int nc0 = (nti & 15) * 64, nt0 = (nti >> 4) * 256;
#pragma unroll
                for (int i = 0; i < 4; ++i) { const int idx = tid + i * NTHR, cr = idx >> 5, tg = idx & 31; v[i] = *(const u32x4*)(YT + (size_t)(nc0 + cr) * NTOK + nt0 + tg * 8); } }
#pragma unroll
            for (int i = 0; i < 4; ++i) { const int item = tid + i * NTHR, tr = item >> 3, cg8 = item & 7; unsigned short e[8];
#pragma unroll
                for (int j = 0; j < 8; ++j) e[j] = tile[(cg8 * 8 + j) * 264 + tr];
                u32x4 w; w.x = e[0] | ((unsigned)e[1] << 16); w.y = e[2] | ((unsigned)e[3] << 16); w.z = e[4] | ((unsigned)e[5] << 16); w.w = e[6] | ((unsigned)e[7] << 16);
                *(u32x4*)(Yhy + (size_t)(t0 + tr) * 1024 + c0 + cg8 * 8) = w; }
            __syncthreads();
            ti = nti; have = hn;
        }
        };
        if (bid & 1) ytrans();
        {   pg8::Gemm g{Ysgu, WbsT, NTOK, DM, DH}; pg8::StaticOrder S; S.init(NTOK, DM, G, bid);
            Epi4<false> E{MERGED, PROJ2 + 4096}; pg8::gemm_phase<Epi4<false>>(lds, g, S, E); }
        if (!(bid & 1)) ytrans();
        SEAM(3);
    }
#ifdef DBG_CUT3
    {
        for (size_t i = (size_t)bid * NTHR + tid; i < (size_t)NTOK * 2048; i += (size_t)G * NTHR) { const int row = (int)(i >> 11), c = (int)(i & 2047);
            P.out[i] = c < 1024 ? bf2f(Yhy[(size_t)row * 1024 + c]) : bf2f(Ysgu[(size_t)row * 1024 + c - 1024]); }
        return;
    }
#endif
    if (((PHASE_MASK >> 4) & 1) && IN(4)) {
        {   pg8::Gemm g{Yhy, WbhT, NTOK, DM, DH}; pg8::StaticOrder S; S.init(NTOK, DM, G, bid);
            Epi4<true> E{MERGED, PROJ2 + 2048}; pg8::gemm_phase<Epi4<true>>(lds, g, S, E); }
        SEAM(4);
    }

    if (((PHASE_MASK >> 5) & 1) && IN(5)) {
        pg8::Gemm g{MERGED, WoutT, NTOK, DM, DM}; pg8::StaticOrder S; S.init(NTOK, DM, G, bid);
        Epi5 E{P.in[0], P.out, SSP, P.in[21], H2}; pg8::gemm_phase<Epi5>(lds, g, S, E);
        SEAM(5);
    }
    if (((PHASE_MASK >> 6) & 1) && IN(6)) {
        pg8::Gemm g{H2, WfiT, NTOK, 2 * DFF, DM}; pg8::StaticOrder S; S.init(NTOK, 2 * DFF, G, bid, 8);
        pg8::Unit u0, u1; S.next(0, u0); u1 = u0; for (int i = 1; ; ++i) { pg8::Unit t; if (!S.next(i, t)) break; u1 = t; }
        {   float* rst = (float*)(smem + 131072);
            for (int r = tid; r < 512; r += NTHR) { const int pmr = r < 256 ? u0.pm : u1.pm; const float* sp = SSP + (size_t)(pmr * 256 + (r & 255)) * 32; float q4[4];
#pragma unroll
                for (int k = 0; k < 4; ++k) { const f32x4 p0 = *(const f32x4*)(sp + k * 8), p1 = *(const f32x4*)(sp + k * 8 + 4); q4[k] = ((p0[0] + p0[1]) + (p0[2] + p0[3])) + ((p1[0] + p1[1]) + (p1[2] + p1[3])); }
                rst[r] = rsqrtf(((q4[0] + q4[1]) + (q4[2] + q4[3])) * (1.0f / 2048.0f) + EPSV); }
            __syncthreads(); }
        Epi6 E{HID, SSP, (const LAS float*)(smem + 131072), u0.pm, u1.pm}; pg8::gemm_phase<Epi6>(lds, g, S, E);
        SEAM(6);
    }
    const bool fuse78 = (G == 256);
    if (((PHASE_MASK >> 7) & 1) && IN(7)) {
        pg8::Gemm g{HID, WfoT, NTOK, DM, DFF}; pg8::StaticOrder S; S.init(NTOK, DM, G, bid);
        if (fuse78) { S.rowmode = 1; Epi7 E{P.out, P.out, (float*)(ws + WS_R2 + 4194304), (unsigned*)(ws + WS_BAR + 1024), P.in[24]}; pg8::gemm_phase<Epi7>(lds, g, S, E); }
        else { EpiRes E{P.out, P.out}; pg8::gemm_phase<EpiRes>(lds, g, S, E); SEAM(7); }
    }
    if (((PHASE_MASK >> 8) & 1) && IN(8) && !fuse78) {
        rmsnorm_rows<false>(P.out, P.in[24], nullptr, P.out, bid, G, wave, lane);
    }
#undef IN
#undef SEAM
}

extern "C" void kernel_launch(void* const* d_in, const int* in_sizes, int n_in, void* d_out, int out_size, void* d_ws, size_t ws_size, hipStream_t stream) {
    static int grid_blocks = 0;
    if (grid_blocks == 0) {
        if (n_in != 25 || out_size != NTOK * DM || ws_size < WS_END) { fprintf(stderr, "kernel_launch: unexpected shapes n_in %d out %d ws %zu (need %zu)\n", n_in, out_size, ws_size, (size_t)WS_END); grid_blocks = -1; return; }
        int dev = 0, cus = 0, per_cu = 0;
        hipGetDevice(&dev);
        hipDeviceGetAttribute(&cus, hipDeviceAttributeMultiprocessorCount, dev);
        if (hipFuncSetAttribute((const void*)fwd_megakernel, hipFuncAttributeMaxDynamicSharedMemorySize, LDS_BYTES) != hipSuccess) { fprintf(stderr, "kernel_launch: hipFuncSetAttribute failed\n"); grid_blocks = -1; return; }
        if (hipOccupancyMaxActiveBlocksPerMultiprocessor(&per_cu, (const void*)fwd_megakernel, NTHR, LDS_BYTES) != hipSuccess || per_cu < 1) { fprintf(stderr, "kernel_launch: occupancy query gave %d\n", per_cu); per_cu = 1; }
        (void)hipGetLastError();
        grid_blocks = cus * per_cu;
    }
    if (grid_blocks < 0) return;
    if (hipMemsetAsync((char*)d_ws + WS_BAR, 0, 32768, stream) != hipSuccess) { fprintf(stderr, "kernel_launch: memset failed\n"); return; }
    Params p{};
    for (int i = 0; i < 25; ++i) p.in[i] = (const float*)d_in[i];
    p.out = (float*)d_out; p.ws = (unsigned char*)d_ws; p.lo = 0; p.hi = 9;
    void* args[] = {&p};
    hipError_t e = hipLaunchCooperativeKernel((const void*)fwd_megakernel, dim3(grid_blocks), dim3(NTHR), args, LDS_BYTES, stream);
    if (e != hipSuccess) fprintf(stderr, "cooperative launch failed: %s (grid %d)\n", hipGetErrorString(e), grid_blocks);
}
```
